# Optimizing an MI355X kernel written in HIP

```python
import numpy as np
import jax
import jax.numpy as jnp
from jax import lax

D_MODEL = 2048
BATCH = 4
SEQ = 4096
DEPTH = 2

NORM_EPS = 1e-6
BLOCK_Q = 128

SB_HEADS = 16
SB_HEAD_DIM = 64
SB_WIDTH = SB_HEADS * SB_HEAD_DIM

RWKV_HEADS = 16
RWKV_HEAD_DIM = 64
RWKV_WIDTH = RWKV_HEADS * RWKV_HEAD_DIM
RWKV_DECAY_LORA = 96
RWKV_ICLR_LORA = 96
RWKV_VRES_LORA = 64
RWKV_GATE_LORA = 256
RWKV_GN_EPS = 64e-5
RWKV_COLS = 3 * RWKV_WIDTH + RWKV_DECAY_LORA + RWKV_ICLR_LORA + RWKV_GATE_LORA

MLA_HEADS = 16
MLA_Q_LORA = 768
MLA_KV_LORA = 256
MLA_NOPE_DIM = 64
MLA_ROPE_DIM = 32
MLA_V_DIM = 64
MLA_WIDTH = MLA_HEADS * MLA_V_DIM
MLA_COLS = MLA_Q_LORA + MLA_KV_LORA + MLA_ROPE_DIM
ROPE_THETA = 10000.0

N_BRANCHES = 3
N_IN = 3 * SB_WIDTH + RWKV_COLS + MLA_COLS + N_BRANCHES * D_MODEL

N_GROUPS = 8
EXPERTS_PER_GROUP = 8
N_EXPERTS = N_GROUPS * EXPERTS_PER_GROUP
TOP_K_IN_GROUP = 2
EXPERT_FF = 512
MOE_BLOCK = 128

kernel_name = 'hybrid_stickbreak_rwkv7_mla_hiermoe'


def _split(t, sizes):
    return jnp.split(t, np.cumsum(sizes)[:-1].tolist(), axis=-1)


def _rms_norm(x, g, eps=NORM_EPS):
    xf = x.astype(jnp.float32)
    y = xf * lax.rsqrt(jnp.mean(xf * xf, axis=-1, keepdims=True) + eps)
    return (y * g.astype(jnp.float32)).astype(x.dtype)


def _rope_tables(positions):
    inv_freq = ROPE_THETA ** (-jnp.arange(0, MLA_ROPE_DIM, 2, dtype=jnp.float32) / MLA_ROPE_DIM)
    ang = positions.astype(jnp.float32)[..., None] * inv_freq
    return jnp.cos(ang), jnp.sin(ang)


def _rope(x, cos, sin):
    xf = x.astype(jnp.float32)
    x1, x2 = jnp.split(xf, 2, axis=-1)
    return jnp.concatenate([x1 * cos - x2 * sin, x2 * cos + x1 * sin], axis=-1).astype(x.dtype)


def _sweep_query_blocks(block_fn, q):
    B, S, H, d = q.shape
    nb = S // BLOCK_Q
    qb = q.reshape(B, nb, BLOCK_Q, H, d).transpose(1, 0, 3, 2, 4)
    o = lax.map(block_fn, (qb, jnp.arange(nb)))
    return o.transpose(1, 0, 3, 2, 4).reshape(B, S, H * o.shape[-1])


def _stick_breaking_attention(q, k, v):
    S, d = q.shape[1], q.shape[-1]
    scale = d ** -0.5
    kh = k.transpose(0, 2, 1, 3)
    vh = v.transpose(0, 2, 1, 3)
    key_pos = jnp.arange(S)

    def block(args):
        qb, i = args
        q_pos = i * BLOCK_Q + jnp.arange(BLOCK_Q)
        before = key_pos[None, :] < q_pos[:, None]
        z = jnp.einsum('bhqd,bhkd->bhqk', qb, kh).astype(jnp.float32) * scale
        log_keep = jnp.where(before, jax.nn.log_sigmoid(-z), 0.0)
        log_after = lax.cumsum(log_keep, axis=3, reverse=True) - log_keep
        w = jnp.where(before, jnp.exp(jax.nn.log_sigmoid(z) + log_after), 0.0)
        return jnp.einsum('bhqk,bhkd->bhqd', w.astype(vh.dtype), vh)

    return _sweep_query_blocks(block, q)


def _causal_softmax_attention(q, k, v, scale):
    S = q.shape[1]
    kh = k.transpose(0, 2, 1, 3)
    vh = v.transpose(0, 2, 1, 3)
    key_pos = jnp.arange(S)

    def block(args):
        qb, i = args
        q_pos = i * BLOCK_Q + jnp.arange(BLOCK_Q)
        s = jnp.einsum('bhqd,bhkd->bhqk', qb, kh).astype(jnp.float32) * scale
        s = jnp.where(key_pos[None, :] <= q_pos[:, None], s, -jnp.inf)
        p = jax.nn.softmax(s, axis=-1)
        return jnp.einsum('bhqk,bhkd->bhqd', p.astype(vh.dtype), vh)

    return _sweep_query_blocks(block, q)


def _rwkv7_scan(r, w, k, v, a, b):
    B, S, H, N = r.shape

    def step(state, inp):
        r_t, w_t, k_t, v_t, a_t, b_t = inp
        sa = jnp.einsum('bhvk,bhk->bhv', state, a_t)
        state = (state * w_t[:, :, None, :] + sa[..., None] * b_t[:, :, None, :]
                 + v_t[..., None] * k_t[:, :, None, :])
        return state, jnp.einsum('bhvk,bhk->bhv', state, r_t)

    xs = tuple(t.transpose(1, 0, 2, 3) for t in (r, w, k, v, a, b))
    _, y = lax.scan(step, jnp.zeros((B, H, N, N), jnp.float32), xs)
    return y.transpose(1, 0, 2, 3)


def _rwkv7_branch(cols, mu, w0, w2, a0, a2, g2, k_k, k_a, r_k, ln_g, ln_b, v_first, v_res):
    B, S, _ = cols.shape
    f32 = jnp.float32
    heads = lambda t: t.reshape(B, S, RWKV_HEADS, RWKV_HEAD_DIM)
    prev = jnp.concatenate([jnp.zeros_like(cols[:, :1]), cols[:, :-1]], axis=1)
    cols = cols + (prev - cols) * mu
    r, k, v, wd, ad, gd = _split(cols, [RWKV_WIDTH] * 3 + [RWKV_DECAY_LORA, RWKV_ICLR_LORA, RWKV_GATE_LORA])
    w = -jax.nn.softplus(-(w0 + jnp.tanh(wd) @ w2).astype(f32)) - 0.5
    decay = jnp.exp(-jnp.exp(w))
    a = jax.nn.sigmoid((a0 + ad @ a2).astype(f32))
    g = jax.nn.sigmoid(gd) @ g2
    if v_res is None:
        v_first = v
    else:
        v0, v1, v2 = v_res
        v = v + (v_first - v) * jax.nn.sigmoid(v0 + (v @ v1) @ v2)
    kk = heads((k * k_k).astype(f32))
    kk = kk / jnp.maximum(jnp.sqrt(jnp.sum(kk * kk, axis=-1, keepdims=True)), 1e-12)
    k = k.astype(f32) * (1.0 + (a - 1.0) * k_a)
    rh, kh, vh, ah = heads(r.astype(f32)), heads(k), heads(v.astype(f32)), heads(a)
    y = _rwkv7_scan(rh, heads(decay), kh, vh, -kk, kk * ah)
    mean = jnp.mean(y, axis=-1, keepdims=True)
    var = jnp.mean(jnp.square(y - mean), axis=-1, keepdims=True)
    y = ((y - mean) * lax.rsqrt(var + RWKV_GN_EPS)).reshape(B, S, RWKV_WIDTH) * ln_g + ln_b
    bonus = jnp.sum(rh * kh * r_k, axis=-1, keepdims=True) * vh
    y = (y + bonus.reshape(B, S, RWKV_WIDTH)) * g
    return y.astype(cols.dtype), v_first


def _mla_branch(cols, cos, sin, q_norm_g, w_uq, kv_norm_g, w_ukv):
    B, S, _ = cols.shape
    c_q, c_kv, k_pe = _split(cols, [MLA_Q_LORA, MLA_KV_LORA, MLA_ROPE_DIM])
    q = (_rms_norm(c_q, q_norm_g) @ w_uq).reshape(B, S, MLA_HEADS, MLA_NOPE_DIM + MLA_ROPE_DIM)
    kv = (_rms_norm(c_kv, kv_norm_g) @ w_ukv).reshape(B, S, MLA_HEADS, MLA_NOPE_DIM + MLA_V_DIM)
    q_nope, q_pe = q[..., :MLA_NOPE_DIM], q[..., MLA_NOPE_DIM:]
    k_nope, v = kv[..., :MLA_NOPE_DIM], kv[..., MLA_NOPE_DIM:]
    q_pe = _rope(q_pe, cos[:, :, None], sin[:, :, None])
    k_pe = _rope(k_pe, cos, sin)
    q = jnp.concatenate([q_nope, q_pe], axis=-1)
    k = jnp.concatenate([k_nope, jnp.broadcast_to(k_pe[:, :, None], (B, S, MLA_HEADS, MLA_ROPE_DIM))], axis=-1)
    return _causal_softmax_attention(q, k, v, (MLA_NOPE_DIM + MLA_ROPE_DIM) ** -0.5)


def _hier_moe(h, rg_w, rg_b, re_w, re_b, w_gate, w_up, w_down):
    B, S, D = h.shape
    T = B * S
    A = T * TOP_K_IN_GROUP
    f32 = jnp.float32
    ht = h.reshape(T, D)
    tok = jnp.arange(T)
    g_logits = (ht @ rg_w).astype(f32) + rg_b.astype(f32)
    grp = jnp.argmax(g_logits, axis=-1)
    p_grp = jax.nn.softmax(g_logits, axis=-1)[tok, grp]
    e_logits = ((ht @ re_w).astype(f32) + re_b.astype(f32)).reshape(T, N_GROUPS, EXPERTS_PER_GROUP)
    p_in, idx_in = lax.top_k(jax.nn.softmax(e_logits[tok, grp], axis=-1), TOP_K_IN_GROUP)
    gate = p_grp[:, None] * p_in / jnp.sum(p_in, axis=-1, keepdims=True)
    expert = grp[:, None] * EXPERTS_PER_GROUP + idx_in
    flat_e = expert.reshape(A)
    order = jnp.argsort(flat_e)
    se = flat_e[order]
    st = jnp.repeat(tok, TOP_K_IN_GROUP)[order].astype(jnp.int32)
    sw = gate.reshape(A)[order]
    counts = jnp.bincount(flat_e, length=N_EXPERTS)
    padded = (counts + MOE_BLOCK - 1) // MOE_BLOCK * MOE_BLOCK
    start = jnp.cumsum(counts) - counts
    pend = jnp.cumsum(padded)
    pstart = pend - padded
    dest = pstart[se] + jnp.arange(A) - start[se]
    nb = -(-A // MOE_BLOCK) + N_EXPERTS
    P = nb * MOE_BLOCK
    row_tok = jnp.full((P,), T, jnp.int32).at[dest].set(st)
    row_w = jnp.zeros((P,), f32).at[dest].set(sw)
    block_e = jnp.minimum(jnp.searchsorted(pend, jnp.arange(nb) * MOE_BLOCK, side='right'), N_EXPERTS - 1)
    xb = jnp.concatenate([ht, jnp.zeros((1, D), ht.dtype)], axis=0)[row_tok].reshape(nb, MOE_BLOCK, D)

    def block(args):
        xe, e = args
        return (jax.nn.silu(xe @ w_gate[e]) * (xe @ w_up[e])) @ w_down[e]

    yb = lax.map(block, (xb, block_e)).reshape(P, D)
    out = jnp.zeros((T + 1, D), f32).at[row_tok].add(yb.astype(f32) * row_w[:, None])
    return out[:T].reshape(B, S, D).astype(h.dtype)


def setup_inputs(seed: int = 0) -> dict:
    key = jax.random.key(seed)
    keys = iter(jax.random.split(key, 40))
    f32 = jnp.float32
    L = DEPTH

    def nrm(shape, scale):
        return jax.random.normal(next(keys), shape, f32) * scale

    def unif(shape, lo, hi):
        return jax.random.uniform(next(keys), shape, f32, lo, hi)

    def gain(shape):
        return 1.0 + nrm(shape, 0.05)

    x = nrm((BATCH, SEQ, D_MODEL), 1.0)
    positions = (jax.random.randint(next(keys), (BATCH, 1), 0, 1024, dtype=jnp.int32)
                 + jnp.arange(SEQ, dtype=jnp.int32)[None, :])
    return {
        'x': x,
        'positions': positions,
        'attn_norm_g': gain((L, D_MODEL)),
        'w_in': nrm((L, D_MODEL, N_IN), D_MODEL ** -0.5),
        'rwkv_mu': unif((L, RWKV_COLS), 0.0, 1.0),
        'rwkv_w0': unif((L, RWKV_WIDTH), -5.0, 0.5),
        'rwkv_w2': nrm((L, RWKV_DECAY_LORA, RWKV_WIDTH), 0.1 * RWKV_DECAY_LORA ** -0.5),
        'rwkv_a0': nrm((L, RWKV_WIDTH), 0.5),
        'rwkv_a2': nrm((L, RWKV_ICLR_LORA, RWKV_WIDTH), 0.5 * RWKV_ICLR_LORA ** -0.5),
        'rwkv_g2': nrm((L, RWKV_GATE_LORA, RWKV_WIDTH), RWKV_GATE_LORA ** -0.5),
        'rwkv_k_k': 0.85 + nrm((L, RWKV_WIDTH), 0.05),
        'rwkv_k_a': gain((L, RWKV_WIDTH)),
        'rwkv_r_k': nrm((L, RWKV_HEADS, RWKV_HEAD_DIM), 0.1),
        'rwkv_ln_g': gain((L, RWKV_WIDTH)),
        'rwkv_ln_b': nrm((L, RWKV_WIDTH), 0.02),
        'rwkv_v0': 1.0 + nrm((L - 1, RWKV_WIDTH), 0.1),
        'rwkv_v1': nrm((L - 1, RWKV_WIDTH, RWKV_VRES_LORA), RWKV_WIDTH ** -0.5),
        'rwkv_v2': nrm((L - 1, RWKV_VRES_LORA, RWKV_WIDTH), 0.5 * RWKV_VRES_LORA ** -0.5),
        'mla_q_norm_g': gain((L, MLA_Q_LORA)),
        'mla_w_uq': nrm((L, MLA_Q_LORA, MLA_HEADS * (MLA_NOPE_DIM + MLA_ROPE_DIM)), MLA_Q_LORA ** -0.5),
        'mla_kv_norm_g': gain((L, MLA_KV_LORA)),
        'mla_w_ukv': nrm((L, MLA_KV_LORA, MLA_HEADS * (MLA_NOPE_DIM + MLA_V_DIM)), MLA_KV_LORA ** -0.5),
        'w_br_sb': nrm((L, SB_WIDTH, D_MODEL), SB_WIDTH ** -0.5),
        'w_br_rwkv': nrm((L, RWKV_WIDTH, D_MODEL), RWKV_WIDTH ** -0.5),
        'w_br_mla': nrm((L, MLA_WIDTH, D_MODEL), MLA_WIDTH ** -0.5),
        'w_out': nrm((L, D_MODEL, D_MODEL), D_MODEL ** -0.5),
        'ffn_norm_g': gain((L, D_MODEL)),
        'router_group_w': nrm((L, D_MODEL, N_GROUPS), D_MODEL ** -0.5),
        'router_group_b': nrm((L, N_GROUPS), 0.01),
        'router_expert_w': nrm((L, D_MODEL, N_EXPERTS), D_MODEL ** -0.5),
        'router_expert_b': nrm((L, N_EXPERTS), 0.01),
        'expert_w_gate': nrm((L, N_EXPERTS, D_MODEL, EXPERT_FF), D_MODEL ** -0.5),
        'expert_w_up': nrm((L, N_EXPERTS, D_MODEL, EXPERT_FF), D_MODEL ** -0.5),
        'expert_w_down': nrm((L, N_EXPERTS, EXPERT_FF, D_MODEL), EXPERT_FF ** -0.5),
        'final_norm_g': gain((D_MODEL,)),
    }


def reference(x, positions, attn_norm_g, w_in, rwkv_mu, rwkv_w0, rwkv_w2, rwkv_a0, rwkv_a2,
              rwkv_g2, rwkv_k_k, rwkv_k_a, rwkv_r_k, rwkv_ln_g, rwkv_ln_b, rwkv_v0, rwkv_v1,
              rwkv_v2, mla_q_norm_g, mla_w_uq, mla_kv_norm_g, mla_w_ukv, w_br_sb, w_br_rwkv,
              w_br_mla, w_out, ffn_norm_g, router_group_w, router_group_b, router_expert_w,
              router_expert_b, expert_w_gate, expert_w_up, expert_w_down, final_norm_g):
    B, S, _ = x.shape
    cos, sin = _rope_tables(positions)
    sb_heads = lambda t: t.reshape(B, S, SB_HEADS, SB_HEAD_DIM)
    v_first = None
    for l in range(DEPTH):
        h = _rms_norm(x, attn_norm_g[l])
        proj = h @ w_in[l]
        sb_q, sb_k, sb_v, rwkv_cols, mla_cols, gate_cols = _split(
            proj, [SB_WIDTH] * 3 + [RWKV_COLS, MLA_COLS, N_BRANCHES * D_MODEL])
        o_sb = _stick_breaking_attention(sb_heads(sb_q), sb_heads(sb_k), sb_heads(sb_v))
        v_res = None if l == 0 else (rwkv_v0[l - 1], rwkv_v1[l - 1], rwkv_v2[l - 1])
        o_rwkv, v_first = _rwkv7_branch(rwkv_cols, rwkv_mu[l], rwkv_w0[l], rwkv_w2[l], rwkv_a0[l],
                                        rwkv_a2[l], rwkv_g2[l], rwkv_k_k[l], rwkv_k_a[l], rwkv_r_k[l],
                                        rwkv_ln_g[l], rwkv_ln_b[l], v_first, v_res)
        o_mla = _mla_branch(mla_cols, cos, sin, mla_q_norm_g[l], mla_w_uq[l], mla_kv_norm_g[l], mla_w_ukv[l])
        g_sb, g_rwkv, g_mla = jnp.split(jax.nn.sigmoid(gate_cols), N_BRANCHES, axis=-1)
        merged = (g_sb * (o_sb @ w_br_sb[l]) + g_rwkv * (o_rwkv @ w_br_rwkv[l])
                  + g_mla * (o_mla @ w_br_mla[l]))
        x = x + merged @ w_out[l]
        h = _rms_norm(x, ffn_norm_g[l])
        x = x + _hier_moe(h, router_group_w[l], router_group_b[l], router_expert_w[l], router_expert_b[l],
                          expert_w_gate[l], expert_w_up[l], expert_w_down[l])
    return _rms_norm(x, final_norm_g)
```

```cpp
#include <hip/hip_runtime.h>
#include <cstdio>
#include <cstdint>

#define LAS __attribute__((address_space(3)))
#define GAS __attribute__((address_space(1)))
typedef unsigned short bf16_t;
typedef short bf16x8 __attribute__((ext_vector_type(8)));
typedef short s16x4 __attribute__((ext_vector_type(4)));
typedef short v4i16_t __attribute__((ext_vector_type(4)));
typedef float f32x4 __attribute__((ext_vector_type(4)));
typedef float f32x2 __attribute__((ext_vector_type(2)));
typedef float f32x16 __attribute__((ext_vector_type(16)));
typedef unsigned u32x4 __attribute__((ext_vector_type(4)));
typedef unsigned u32x2 __attribute__((ext_vector_type(2)));
typedef GAS unsigned gu32;
#define RLX_AGENT __ATOMIC_RELAXED, __HIP_MEMORY_SCOPE_AGENT

constexpr int T = 16384, SEQ = 4096, NBATCH = 4, DM = 2048, DEPTH = 2;
constexpr int NHEAD = 16;
constexpr int N_IN_SRC = 13792;
constexpr int NPROJ = 13824;
constexpr int PC_SBQ = 0, PC_SBK = 1024, PC_SBV = 2048, PC_RR = 3072, PC_RK = 4096, PC_RV = 5120;
constexpr int PC_WD = 6144, PC_AD = 6240, PC_KPE = 6336, PC_GD = 6400, PC_CQ = 6656, PC_CKV = 7424, PC_GATE = 7680;
constexpr int GATE_TILE0 = PC_GATE / 256;
constexpr int RWKV_COLS = 3520;
constexpr float NORM_EPS = 1e-6f, GN_EPS = 64e-5f;
constexpr float LOG2E = 1.4426950408889634f;
constexpr int MOE_MAXBLK = 192;
constexpr int MOE_ROWS = MOE_MAXBLK * 256;

__device__ __forceinline__ unsigned f2bf(float f) { unsigned u = __builtin_bit_cast(unsigned, f); return (u + 0x7fffu + ((u >> 16) & 1u)) >> 16; }
__device__ __forceinline__ unsigned pk2(float lo, float hi) { return f2bf(lo) | (f2bf(hi) << 16); }
__device__ __forceinline__ float bf2f(unsigned b) { return __builtin_bit_cast(float, b << 16); }
__device__ __forceinline__ float bflo(unsigned w) { return __builtin_bit_cast(float, w << 16); }
__device__ __forceinline__ float bfhi(unsigned w) { return __builtin_bit_cast(float, w & 0xffff0000u); }
typedef __bf16 bf16x2_t __attribute__((ext_vector_type(2)));
__device__ __forceinline__ unsigned cvt_pk_bf16(float lo, float hi) { const f32x2 v = {lo, hi}; const bf16x2_t b = __builtin_convertvector(v, bf16x2_t); return __builtin_bit_cast(unsigned, b); }
__device__ __forceinline__ float fast_sigmoid(float v) { return __builtin_amdgcn_rcpf(1.0f + __expf(-v)); }
template <int CTRL> __device__ __forceinline__ float dpp_mov(float v) { return __builtin_bit_cast(float, __builtin_amdgcn_update_dpp(0, __builtin_bit_cast(int, v), CTRL, 0xF, 0xF, false)); }
__device__ __forceinline__ float sum8(float v) {
    v += dpp_mov<0xB1>(v);
    v += dpp_mov<0x4E>(v);
    v += dpp_mov<0x141>(v);
    return v;
}
__device__ __forceinline__ float wave_sum(float v) {
    v = sum8(v); v += dpp_mov<0x140>(v);
    const float a = __builtin_bit_cast(float, __builtin_amdgcn_readlane(__builtin_bit_cast(int, v), 0)), b = __builtin_bit_cast(float, __builtin_amdgcn_readlane(__builtin_bit_cast(int, v), 16)),
                c = __builtin_bit_cast(float, __builtin_amdgcn_readlane(__builtin_bit_cast(int, v), 32)), d = __builtin_bit_cast(float, __builtin_amdgcn_readlane(__builtin_bit_cast(int, v), 48));
    return (a + b) + (c + d);
}
__device__ __forceinline__ void store8_bf16(bf16_t* p, f32x4 v0, f32x4 v1) {
    u32x4 w; w.x = cvt_pk_bf16(v0[0], v0[1]); w.y = cvt_pk_bf16(v0[2], v0[3]); w.z = cvt_pk_bf16(v1[0], v1[1]); w.w = cvt_pk_bf16(v1[2], v1[3]);
    *(u32x4*)p = w;
}
__device__ __forceinline__ void store4_bf16(bf16_t* p, f32x4 v) { u32x2 w; w.x = cvt_pk_bf16(v[0], v[1]); w.y = cvt_pk_bf16(v[2], v[3]); *(u32x2*)p = w; }
__device__ __forceinline__ f32x4 load4_bf16(const bf16_t* p) { const u32x2 w = *(const u32x2*)p; return (f32x4){bflo(w.x), bfhi(w.x), bflo(w.y), bfhi(w.y)}; }
__device__ __forceinline__ void load8f(const bf16_t* p, float (&o)[8]) { const u32x4 w = *(const u32x4*)p; o[0] = bflo(w.x); o[1] = bfhi(w.x); o[2] = bflo(w.y); o[3] = bfhi(w.y); o[4] = bflo(w.z); o[5] = bfhi(w.z); o[6] = bflo(w.w); o[7] = bfhi(w.w); }
__device__ __forceinline__ void unpack8(const u32x4& w, float (&o)[8]) { o[0] = bflo(w.x); o[1] = bfhi(w.x); o[2] = bflo(w.y); o[3] = bfhi(w.y); o[4] = bflo(w.z); o[5] = bfhi(w.z); o[6] = bflo(w.w); o[7] = bfhi(w.w); }
__device__ __forceinline__ void store8f(bf16_t* p, const float (&v)[8]) { u32x4 w; w.x = pk2(v[0], v[1]); w.y = pk2(v[2], v[3]); w.z = pk2(v[4], v[5]); w.w = pk2(v[6], v[7]); *(u32x4*)p = w; }

namespace pg8 {
constexpr int BM = 256, BK = 64, HALF = 128, HTB = HALF * BK * 2  , STAGE_BYTES = 8 * HTB, NXCD = 8, WGM = 8;
__host__ __device__ __forceinline__ int lds_byte(int r, int c) { const int st = (r >> 4) * 2 + (c >> 5), rr = r & 15, cc = c & 31, ob = rr * 64 + cc * 2; return st * 1024 + (ob ^ (((ob >> 9) & 1) << 5)); }
__host__ __device__ __forceinline__ void stage_rc(int b, int& R, int& C) { const int st = b / 1024, sb = b % 1024, swz = sb ^ (((sb >> 9) & 1) << 5); R = (st >> 1) * 16 + swz / 64; C = (st & 1) * 32 + (swz % 64) / 2; }
__host__ __device__ __forceinline__ int perm32(int rho) { const int n = rho >> 4, i = rho & 15; return 8 * (i >> 2) + 4 * n + (i & 3); }

struct Unit { int pm, pn, am, bn, akoff, bkoff, z; };
struct Gemm { const bf16_t* A; const bf16_t* Bt; int lda, ldb, K; };

struct StaticOrder {
    int nM, nN, nwg, G, c;
    __device__ __forceinline__ void init(int nM_, int nN_, int G_, int c_) { nM = nM_; nN = nN_; nwg = nM * nN; G = G_; c = c_; }
    __device__ __forceinline__ bool tile(int i, int& pm, int& pn) const {
        const long L = (long)i * G + c; if (L >= nwg) return false;
        int wgid = (int)L; { const int q = nwg / NXCD, r = nwg % NXCD, xcd = wgid % NXCD, off = wgid / NXCD; wgid = (xcd < r ? xcd * (q + 1) : r * (q + 1) + (xcd - r) * q) + off; }
        const int nig = WGM * nN, gid = wgid / nig, fm = gid * WGM, gsz = (nM - fm) < WGM ? (nM - fm) : WGM;
        pm = fm + ((wgid % nig) % gsz); pn = (wgid % nig) / gsz; return true;
    }
    __device__ __forceinline__ bool next(int i, Unit& u) const { if (!tile(i, u.pm, u.pn)) return false; u.am = u.pm; u.bn = u.pn; u.akoff = 0; u.bkoff = 0; u.z = 0; return true; }
};

template <class E> constexpr auto epi_chain(int) -> decltype(E::CHAIN) { return E::CHAIN; }
template <class E> constexpr bool epi_chain(long) { return false; }
template <class Epi, class Sched, bool ALIGN_EPI, bool GATHER = false>
__device__ __forceinline__ void gemm_phase(LAS unsigned char* lds, const int tid, const Gemm g, const Sched& S, const Epi& E) {
    const int wid = __builtin_amdgcn_readfirstlane(tid >> 6), lane = tid & 63, wr = wid >> 2, wc = wid & 3, fr = lane & 15, fq = lane >> 4;
    int K = g.K; asm volatile("" : "+s"(K)); const int nt = K / BK;
    unsigned voffA[2], voffB[2];
#pragma unroll
    for (int i = 0; i < 2; ++i) { int R, C; stage_rc(tid * 16 + i * 8192, R, C); const int Rb = Epi::PERM ? ((R & ~31) + perm32(R & 31)) : R;
        voffA[i] = (unsigned)(R * g.lda + C) * 2u; voffB[i] = (unsigned)(Rb * g.ldb + C) * 2u; }
    unsigned gc[2][2], gn[2][2];
#define PG8_GLOAD(dst, unit) do { _Pragma("unroll") for (int _h = 0; _h < 2; ++_h) _Pragma("unroll") for (int _i = 0; _i < 2; ++_i) { int R_, C_; stage_rc(tid * 16 + _i * 8192, R_, C_); \
        unsigned tk_ = (unsigned)S.rowtok[(unit).pm * 256 + _h * 128 + R_]; tk_ = tk_ < (unsigned)S.nrows ? tk_ : 0u; dst[_h][_i] = (tk_ * (unsigned)g.lda + (unsigned)C_) * 2u; } } while (0)
    const size_t kstep = (size_t)(BK * 2);
    const size_t hstepA = GATHER ? 0 : (size_t)HALF * g.lda * 2, hstepB = (size_t)HALF * g.ldb * 2;
    const size_t tstepA = 2 * hstepA, tstepB = 2 * hstepB;
    const unsigned ldsw = (unsigned)wid * 1024u;
    const int aoff = lds_byte(wr * 64 + fr, fq * 8), boff = lds_byte(wc * 32 + fr, fq * 8);
#define PG8_SA(b, h) (((b) * 2 + (h)) * HTB)
#define PG8_SB(b, h) ((4 + (b) * 2 + (h)) * HTB)
#define PG8_STAGE(bufoff, gbase, voff) do { _Pragma("unroll") for (int _i = 0; _i < 2; ++_i) \
        __builtin_amdgcn_global_load_lds((const unsigned*)((const char*)(gbase) + (voff)[_i]), (LAS unsigned*)(lds + (bufoff) + ldsw + _i * 8192), 16, 0, 0); } while (0)
#define PG8_STAGEA(b, h, gbase, nx) do { if constexpr (GATHER) { _Pragma("unroll") for (int _i = 0; _i < 2; ++_i) { const unsigned o_ = (nx) ? gn[h][_i] : gc[h][_i]; \
        __builtin_amdgcn_global_load_lds((const unsigned*)((const char*)(gbase) + o_), (LAS unsigned*)(lds + PG8_SA(b, h) + ldsw + _i * 8192), 16, 0, 0); } } \
    else { PG8_STAGE(PG8_SA(b, h), (gbase) + (h) * hstepA, voffA); } } while (0)
#define PG8_LDA(dst, b, h) do { _Pragma("unroll") for (int m = 0; m < 4; ++m) _Pragma("unroll") for (int k = 0; k < 2; ++k) dst[m][k] = *(const LAS bf16x8*)(lds + PG8_SA(b, h) + aoff + m * 2048 + k * 1024); } while (0)
#define PG8_LDB(dst, b, h) do { _Pragma("unroll") for (int n = 0; n < 2; ++n) _Pragma("unroll") for (int k = 0; k < 2; ++k) dst[n][k] = *(const LAS bf16x8*)(lds + PG8_SB(b, h) + boff + n * 2048 + k * 1024); } while (0)
#define PG8_MMA(ai, bj, At, Bt) do { __builtin_amdgcn_s_setprio(1); _Pragma("unroll") for (int m = 0; m < 4; ++m) _Pragma("unroll") for (int n = 0; n < 2; ++n) _Pragma("unroll") for (int k = 0; k < 2; ++k) \
        acc[ai][bj][m][n] = __builtin_amdgcn_mfma_f32_16x16x32_bf16(Bt[n][k], At[m][k], acc[ai][bj][m][n], 0, 0, 0); __builtin_amdgcn_s_setprio(0); } while (0)
#define PG8_WAIT_V(n) asm volatile("s_waitcnt vmcnt(" #n ")" ::: "memory")
#define PG8_WAIT_L(n) asm volatile("s_waitcnt lgkmcnt(" #n ")" ::: "memory")
#define PG8_BAR __builtin_amdgcn_s_barrier()
#define PG8_SCHED __builtin_amdgcn_sched_barrier(0)
    Unit cur, nxt; int ui = 0;
    if (!S.next(0, cur)) return;
    f32x4 acc[2][2][4][2];
#pragma unroll
    for (int a = 0; a < 2; ++a)
#pragma unroll
        for (int b = 0; b < 2; ++b)
#pragma unroll
            for (int m = 0; m < 4; ++m)
#pragma unroll
                for (int n = 0; n < 2; ++n) acc[a][b][m][n] = (f32x4){0.f, 0.f, 0.f, 0.f};
    bf16x8 At[4][2], B0[2][2], B1[2][2];
    const char* cA = (const char*)g.A + (GATHER ? (size_t)0 : (size_t)cur.am * tstepA) + cur.akoff; const char* cB = (const char*)g.Bt + (size_t)cur.bn * tstepB + cur.bkoff;
    if constexpr (GATHER) PG8_GLOAD(gc, cur);
    {
        PG8_STAGE(PG8_SB(0, 0), cB, voffB); PG8_STAGE(PG8_SB(0, 1), cB + hstepB, voffB); PG8_STAGEA(0, 0, cA, false); PG8_STAGEA(0, 1, cA, false);
        if (wr == 1) PG8_BAR;
        PG8_WAIT_V(2); PG8_BAR;
        PG8_STAGE(PG8_SB(1, 0), cB + kstep, voffB); PG8_STAGEA(1, 0, cA + kstep, false); PG8_STAGE(PG8_SB(1, 1), cB + hstepB + kstep, voffB);
        PG8_WAIT_V(6); PG8_BAR;
    }
    for (;;) {
        const bool has_next = S.next(ui + 1, nxt);
        const char* nA = has_next ? (const char*)g.A + (GATHER ? (size_t)0 : (size_t)nxt.am * tstepA) + nxt.akoff : cA;
        if constexpr (GATHER) { if (has_next) PG8_GLOAD(gn, nxt); else { gn[0][0] = gc[0][0]; gn[0][1] = gc[0][1]; gn[1][0] = gc[1][0]; gn[1][1] = gc[1][1]; } } const char* nB = has_next ? (const char*)g.Bt + (size_t)nxt.bn * tstepB + nxt.bkoff : cB;
#pragma unroll 1
        for (int t = 0; t < nt; t += 2) {
            const bool last = (t == nt - 2);
            const char* a1 = cA + (size_t)(t + 1) * kstep;
            const char* a2 = last ? nA : cA + (size_t)(t + 2) * kstep; const char* b2 = last ? nB : cB + (size_t)(t + 2) * kstep;
            const char* a3 = a2 + kstep; const char* b3 = b2 + kstep;
            PG8_LDB(B0, 0, 0); PG8_LDB(B1, 0, 1); PG8_SCHED; PG8_LDA(At, 0, 0); PG8_STAGEA(1, 1, a1, false);
            PG8_WAIT_V(8); PG8_WAIT_L(0); PG8_BAR; PG8_MMA(0, 0, At, B0); PG8_MMA(0, 1, At, B1); PG8_BAR; PG8_SCHED;
            PG8_LDA(At, 0, 1); PG8_STAGE(PG8_SB(0, 0), b2, voffB); PG8_STAGE(PG8_SB(0, 1), b2 + hstepB, voffB); PG8_STAGEA(0, 0, a2, last);
            PG8_WAIT_V(8); PG8_WAIT_L(0); PG8_BAR; PG8_MMA(1, 0, At, B0); PG8_MMA(1, 1, At, B1); PG8_BAR; PG8_SCHED;
            PG8_LDB(B0, 1, 0); PG8_LDB(B1, 1, 1); PG8_SCHED; PG8_LDA(At, 1, 0); PG8_STAGEA(0, 1, a2, last);
            PG8_WAIT_V(8); PG8_WAIT_L(0); PG8_BAR; PG8_MMA(0, 0, At, B0); PG8_MMA(0, 1, At, B1); PG8_BAR; PG8_SCHED;
            PG8_LDA(At, 1, 1); PG8_STAGE(PG8_SB(1, 0), b3, voffB); PG8_STAGE(PG8_SB(1, 1), b3 + hstepB, voffB); PG8_STAGEA(1, 0, a3, last);
            PG8_WAIT_V(8); PG8_WAIT_L(0); PG8_BAR; PG8_MMA(1, 0, At, B0); PG8_MMA(1, 1, At, B1); PG8_BAR; PG8_SCHED;
        }
        if constexpr (ALIGN_EPI) { if (wr == 0) PG8_BAR; }
        if constexpr (!Epi::AFTER_DRAIN) { E(acc, cur, wr, wc, fr, fq); }
        if (!has_next) break;
        if (!(epi_chain<Epi>(0) && nxt.z != 0))
#pragma unroll
        for (int a = 0; a < 2; ++a)
#pragma unroll
            for (int b = 0; b < 2; ++b)
#pragma unroll
                for (int m = 0; m < 4; ++m)
#pragma unroll
                    for (int n = 0; n < 2; ++n) acc[a][b][m][n] = (f32x4){0.f, 0.f, 0.f, 0.f};
        cur = nxt; cA = nA; cB = nB; ++ui;
        if constexpr (GATHER) { gc[0][0] = gn[0][0]; gc[0][1] = gn[0][1]; gc[1][0] = gn[1][0]; gc[1][1] = gn[1][1]; }
        if constexpr (ALIGN_EPI) { if (wr == 1) PG8_BAR; }
    }
    PG8_WAIT_V(0);
    if constexpr (!ALIGN_EPI) { if (wr == 0) PG8_BAR; }
    PG8_BAR;
    if constexpr (Epi::AFTER_DRAIN) { E.fused(acc, cur, wr, wc, fr, fq, lds, wid, lane); }
#undef PG8_SA
#undef PG8_SB
#undef PG8_STAGE
#undef PG8_STAGEA
#undef PG8_GLOAD
#undef PG8_LDA
#undef PG8_LDB
#undef PG8_MMA
#undef PG8_WAIT_V
#undef PG8_WAIT_L
#undef PG8_BAR
#undef PG8_SCHED
}
}
using pg8::Unit;
typedef f32x4 AccT[2][2][4][2];

#define EPI_ROW(u, ai, m) ((u).pm * 256 + (ai) * 128 + wr * 64 + (m) * 16 + fr)
struct EpiProj { static constexpr bool PERM = true, AFTER_DRAIN = false; bf16_t* O;
    __device__ __forceinline__ void operator()(const AccT& acc, const Unit& u, int wr, int wc, int fr, int fq) const {
        const bool sig = u.pn >= GATE_TILE0; const int col0 = u.pn * 256 + wc * 32 + 8 * fq;
#pragma unroll
        for (int ai = 0; ai < 2; ++ai)
#pragma unroll
            for (int m = 0; m < 4; ++m) { bf16_t* rowp = O + (size_t)EPI_ROW(u, ai, m) * NPROJ + col0;
#pragma unroll
                for (int bj = 0; bj < 2; ++bj) { f32x4 v0 = acc[ai][bj][m][0], v1 = acc[ai][bj][m][1];
                    if (sig) {
#pragma unroll
                        for (int e = 0; e < 4; ++e) { v0[e] = fast_sigmoid(v0[e]); v1[e] = fast_sigmoid(v1[e]); } }
                    store8_bf16(rowp + bj * 128, v0, v1); } }
    }
};
struct EpiMlaQ { static constexpr bool PERM = false, AFTER_DRAIN = false; bf16_t* Q; const float* rstd; const float* cosb; const float* sinb;
    __device__ __forceinline__ void operator()(const AccT& acc, const Unit& u, int wr, int wc, int fr, int fq) const {
        float rs[2][4];
#pragma unroll
        for (int ai = 0; ai < 2; ++ai)
#pragma unroll
            for (int m = 0; m < 4; ++m) rs[ai][m] = rstd[EPI_ROW(u, ai, m)];
        if (u.pn < 4) {
#pragma unroll
            for (int ai = 0; ai < 2; ++ai)
#pragma unroll
                for (int m = 0; m < 4; ++m) { bf16_t* qrow = Q + (size_t)EPI_ROW(u, ai, m) * 1536;
#pragma unroll
                    for (int bj = 0; bj < 2; ++bj)
#pragma unroll
                        for (int n = 0; n < 2; ++n) { const int c = u.pn * 256 + bj * 128 + wc * 32 + n * 16 + fq * 4; const int head = c >> 6, d = c & 63;
                            store4_bf16(qrow + head * 96 + d, acc[ai][bj][m][n] * rs[ai][m]); } }
        } else {
#pragma unroll
            for (int ai = 0; ai < 2; ++ai) { f32x4 cs[4], sn[4];
#pragma unroll
                for (int m = 0; m < 4; ++m) { const int row = EPI_ROW(u, ai, m); cs[m] = *(const f32x4*)(cosb + (size_t)row * 16 + fq * 4); sn[m] = *(const f32x4*)(sinb + (size_t)row * 16 + fq * 4); }
#pragma unroll
                for (int m = 0; m < 4; ++m) { bf16_t* qrow = Q + (size_t)EPI_ROW(u, ai, m) * 1536; const float r = rs[ai][m];
#pragma unroll
                    for (int bj = 0; bj < 2; ++bj) { const int head = (u.pn - 4) * 8 + bj * 4 + wc; const f32x4 x1 = acc[ai][bj][m][0] * r, x2 = acc[ai][bj][m][1] * r;
                        store4_bf16(qrow + head * 96 + 64 + fq * 4, x1 * cs[m] - x2 * sn[m]); store4_bf16(qrow + head * 96 + 80 + fq * 4, x2 * cs[m] + x1 * sn[m]); } } }
        }
    }
};
struct EpiMlaKV { static constexpr bool PERM = true, AFTER_DRAIN = false; bf16_t* Kd; bf16_t* Vd; const float* rstd;
    __device__ __forceinline__ void operator()(const AccT& acc, const Unit& u, int wr, int wc, int fr, int fq) const {
        float rs[2][4];
#pragma unroll
        for (int ai = 0; ai < 2; ++ai)
#pragma unroll
            for (int m = 0; m < 4; ++m) rs[ai][m] = rstd[EPI_ROW(u, ai, m)];
        bf16_t* base = (u.pn < 4) ? Kd + u.pn * 256 : Vd + (u.pn * 256 - 1024);
#pragma unroll
        for (int ai = 0; ai < 2; ++ai)
#pragma unroll
            for (int m = 0; m < 4; ++m) { const int row = EPI_ROW(u, ai, m); const float r = rs[ai][m];
#pragma unroll
                for (int bj = 0; bj < 2; ++bj) store8_bf16(base + (size_t)row * 1024 + bj * 128 + wc * 32 + 8 * fq, acc[ai][bj][m][0] * r, acc[ai][bj][m][1] * r); }
    }
};
struct EpiLora { static constexpr bool PERM = false, AFTER_DRAIN = false; float* logdec; float* aic; bf16_t* gout; const float* w0; const float* a0;
    __device__ __forceinline__ void operator()(const AccT& acc, const Unit& u, int wr, int wc, int fr, int fq) const {
        const int colb = (u.pn & 3) * 256 + wc * 32 + fq * 4;
        f32x4 bias[2][2];
        { const float* bp = (u.z == 0) ? w0 : a0;
#pragma unroll
          for (int bj = 0; bj < 2; ++bj)
#pragma unroll
              for (int n = 0; n < 2; ++n) bias[bj][n] = (u.z < 2) ? *(const f32x4*)(bp + colb + bj * 128 + n * 16) : (f32x4){0.f, 0.f, 0.f, 0.f}; }
        if (u.z == 0) {
#pragma unroll
            for (int ai = 0; ai < 2; ++ai)
#pragma unroll
                for (int m = 0; m < 4; ++m) { float* rowp = logdec + (size_t)EPI_ROW(u, ai, m) * 1024 + colb;
#pragma unroll
                    for (int bj = 0; bj < 2; ++bj)
#pragma unroll
                        for (int n = 0; n < 2; ++n) { f32x4 v = acc[ai][bj][m][n] + bias[bj][n];
#pragma unroll
                            for (int e = 0; e < 4; ++e) { const float x = -v[e]; const float sp = fmaxf(x, 0.f) + __logf(1.0f + __expf(-fabsf(x))); v[e] = -__expf(-sp - 0.5f); }
                            *(f32x4*)(rowp + bj * 128 + n * 16) = v; } }
        } else if (u.z == 1) {
#pragma unroll
            for (int ai = 0; ai < 2; ++ai)
#pragma unroll
                for (int m = 0; m < 4; ++m) { float* rowp = aic + (size_t)EPI_ROW(u, ai, m) * 1024 + colb;
#pragma unroll
                    for (int bj = 0; bj < 2; ++bj)
#pragma unroll
                        for (int n = 0; n < 2; ++n) { f32x4 v = acc[ai][bj][m][n] + bias[bj][n];
#pragma unroll
                            for (int e = 0; e < 4; ++e) v[e] = fast_sigmoid(v[e]);
                            *(f32x4*)(rowp + bj * 128 + n * 16) = v; } }
        } else {
#pragma unroll
            for (int ai = 0; ai < 2; ++ai)
#pragma unroll
                for (int m = 0; m < 4; ++m) { bf16_t* rowp = gout + (size_t)EPI_ROW(u, ai, m) * 1024 + colb;
#pragma unroll
                    for (int bj = 0; bj < 2; ++bj)
#pragma unroll
                        for (int n = 0; n < 2; ++n) store4_bf16(rowp + bj * 128 + n * 16, acc[ai][bj][m][n]); }
        }
    }
};
struct EpiT1 { static constexpr bool PERM = true, AFTER_DRAIN = false; bf16_t* O;
    __device__ __forceinline__ void operator()(const AccT& acc, const Unit& u, int wr, int wc, int fr, int fq) const {
#pragma unroll
        for (int ai = 0; ai < 2; ++ai)
#pragma unroll
            for (int m = 0; m < 4; ++m) store8_bf16(O + (size_t)EPI_ROW(u, ai, m) * 128 + wc * 32 + 8 * fq, acc[ai][0][m][0], acc[ai][0][m][1]);
    }
};
struct EpiVGate { static constexpr bool PERM = true, AFTER_DRAIN = false; bf16_t* O; const float* v0;
    __device__ __forceinline__ void operator()(const AccT& acc, const Unit& u, int wr, int wc, int fr, int fq) const {
#pragma unroll
        for (int bj = 0; bj < 2; ++bj) { const int col = u.pn * 256 + bj * 128 + wc * 32 + 8 * fq; const f32x4 b0 = *(const f32x4*)(v0 + col), b1 = *(const f32x4*)(v0 + col + 4);
#pragma unroll
            for (int ai = 0; ai < 2; ++ai)
#pragma unroll
                for (int m = 0; m < 4; ++m) { f32x4 x0 = acc[ai][bj][m][0] + b0, x1 = acc[ai][bj][m][1] + b1;
#pragma unroll
                    for (int e = 0; e < 4; ++e) { x0[e] = fast_sigmoid(x0[e]); x1[e] = fast_sigmoid(x1[e]); }
                    store8_bf16(O + (size_t)EPI_ROW(u, ai, m) * 1024 + col, x0, x1); } }
    }
};
struct EpiBranch { static constexpr bool PERM = true, AFTER_DRAIN = false, CHAIN = true; const bf16_t* proj; bf16_t* merged;
    __device__ __forceinline__ void operator()(AccT& acc, const Unit& u, int wr, int wc, int fr, int fq) const {
        const int colb = u.pn * 256 + wc * 32 + 8 * fq; const bool more = u.z < 2;
#pragma unroll
        for (int ai = 0; ai < 2; ++ai) {
            u32x4 gt[4][2], gn[4][2];
#pragma unroll
            for (int m = 0; m < 4; ++m)
#pragma unroll
                for (int bj = 0; bj < 2; ++bj) gt[m][bj] = *(const u32x4*)(proj + (size_t)EPI_ROW(u, ai, m) * NPROJ + PC_GATE + u.z * 2048 + colb + bj * 128);
            if (more) {
#pragma unroll
                for (int m = 0; m < 4; ++m)
#pragma unroll
                    for (int bj = 0; bj < 2; ++bj) gn[m][bj] = *(const u32x4*)(proj + (size_t)EPI_ROW(u, ai, m) * NPROJ + PC_GATE + u.z * 2048 + 2048 + colb + bj * 128);
            } else {
#pragma unroll
                for (int m = 0; m < 4; ++m)
#pragma unroll
                    for (int bj = 0; bj < 2; ++bj) gn[m][bj] = (u32x4){0x3f803f80u, 0x3f803f80u, 0x3f803f80u, 0x3f803f80u};
            }
#pragma unroll
            for (int m = 0; m < 4; ++m)
#pragma unroll
                for (int bj = 0; bj < 2; ++bj) { float a[8], b[8]; unpack8(gt[m][bj], a); unpack8(gn[m][bj], b);
#pragma unroll
                    for (int e = 0; e < 8; ++e) a[e] = fmaxf(a[e], 1e-30f) * __builtin_amdgcn_rcpf(fmaxf(b[e], 1e-30f));
#pragma unroll
                    for (int e = 0; e < 4; ++e) { acc[ai][bj][m][0][e] *= a[e]; acc[ai][bj][m][1][e] *= a[4 + e]; }
                    if (!more) store8_bf16(merged + (size_t)EPI_ROW(u, ai, m) * 2048 + colb + bj * 128, acc[ai][bj][m][0], acc[ai][bj][m][1]); }
        }
    }
};
struct EpiWout { static constexpr bool PERM = false, AFTER_DRAIN = false; const float* xres; float* X;
    __device__ __forceinline__ void operator()(const AccT& acc, const Unit& u, int wr, int wc, int fr, int fq) const {
        const int colb = u.pn * 256 + wc * 32 + fq * 4;
#pragma unroll
        for (int ai = 0; ai < 2; ++ai) {
            f32x4 r[4][2][2];
#pragma unroll
            for (int m = 0; m < 4; ++m)
#pragma unroll
                for (int bj = 0; bj < 2; ++bj)
#pragma unroll
                    for (int n = 0; n < 2; ++n) r[m][bj][n] = *(const f32x4*)(xres + (size_t)EPI_ROW(u, ai, m) * 2048 + colb + bj * 128 + n * 16);
#pragma unroll
            for (int m = 0; m < 4; ++m)
#pragma unroll
                for (int bj = 0; bj < 2; ++bj)
#pragma unroll
                    for (int n = 0; n < 2; ++n) *(f32x4*)(X + (size_t)EPI_ROW(u, ai, m) * 2048 + colb + bj * 128 + n * 16) = r[m][bj][n] + acc[ai][bj][m][n];
        }
    }
};
struct EpiE1 { static constexpr bool PERM = true, AFTER_DRAIN = false; bf16_t* H;
    __device__ __forceinline__ void operator()(const AccT& acc, const Unit& u, int wr, int wc, int fr, int fq) const {
#pragma unroll
        for (int ai = 0; ai < 2; ++ai)
#pragma unroll
            for (int m = 0; m < 4; ++m) { f32x4 h0, h1;
#pragma unroll
                for (int e = 0; e < 4; ++e) { const float g0 = acc[ai][0][m][0][e], g1 = acc[ai][0][m][1][e];
                    h0[e] = g0 * fast_sigmoid(g0) * acc[ai][1][m][0][e]; h1[e] = g1 * fast_sigmoid(g1) * acc[ai][1][m][1][e]; }
                store8_bf16(H + (size_t)EPI_ROW(u, ai, m) * 512 + u.z * 128 + wc * 32 + 8 * fq, h0, h1); }
    }
};
struct EpiE2 { static constexpr bool PERM = true, AFTER_DRAIN = false; bf16_t* Y;
    __device__ __forceinline__ void operator()(const AccT& acc, const Unit& u, int wr, int wc, int fr, int fq) const {
#pragma unroll
        for (int ai = 0; ai < 2; ++ai)
#pragma unroll
            for (int m = 0; m < 4; ++m) { bf16_t* rowp = Y + (size_t)EPI_ROW(u, ai, m) * 2048 + u.z * 256 + wc * 32 + 8 * fq;
#pragma unroll
                for (int bj = 0; bj < 2; ++bj) store8_bf16(rowp + bj * 128, acc[ai][bj][m][0], acc[ai][bj][m][1]); }
    }
};
struct EpiRouterPart { static constexpr bool PERM = false, AFTER_DRAIN = false; float* lgp;
    __device__ __forceinline__ void operator()(const AccT& acc, const Unit& u, int wr, int wc, int fr, int fq) const {
        if (wc < 3) {
#pragma unroll
            for (int ai = 0; ai < 2; ++ai)
#pragma unroll
                for (int m = 0; m < 4; ++m) { float* rowp = lgp + ((size_t)u.z * T + EPI_ROW(u, ai, m)) * 96 + wc * 32 + fq * 4;
#pragma unroll
                    for (int n = 0; n < 2; ++n) *(f32x4*)(rowp + n * 16) = acc[ai][0][m][n] + acc[ai][1][m][n]; } }
    }
};
struct SchedRouter { int G, vcu;
    __device__ __forceinline__ bool next(int i, Unit& u) const { const int L = i * G + vcu; if (L >= 256) return false;
        u.pm = L >> 2; u.am = u.pm; u.pn = 0; u.bn = 0; u.z = L & 3; u.akoff = u.z * 2048; u.bkoff = u.z * 2048; return true; } };
constexpr size_t MiB = 1u << 20;
constexpr size_t WS_CTL = 0, CTL_ZERO_BYTES = 1 * MiB;
constexpr size_t WS_MISC = 1 * MiB;
constexpr size_t WS_COS = WS_MISC, WS_SIN = WS_COS + (size_t)T * 16 * 4, WS_RSTDQ = WS_SIN + (size_t)T * 16 * 4, WS_RSTDKV = WS_RSTDQ + (size_t)T * 4,
                 WS_TOKE = WS_RSTDKV + (size_t)T * 4, WS_TOKW = WS_TOKE + (size_t)T * 8, WS_POS = WS_TOKW + (size_t)T * 8, WS_BLKE = WS_POS + (size_t)T * 8;
static_assert(WS_BLKE + 4096 <= 4 * MiB, "misc region");
constexpr size_t WS_ROWTOK = WS_BLKE + 4096;
static_assert(WS_ROWTOK + (size_t)MOE_ROWS * 4 <= 4 * MiB, "misc region");
constexpr size_t WS_WIN = 4 * MiB;
constexpr size_t SZ_WIN = (size_t)NPROJ * 2048 * 2;
constexpr size_t WS_WUQ = WS_WIN + 2 * SZ_WIN;
constexpr size_t SZ_WUQ = (size_t)1536 * 768 * 2;
constexpr size_t WS_WUKV = WS_WUQ + 2 * SZ_WUQ;
constexpr size_t SZ_WUKV = (size_t)2048 * 256 * 2;
constexpr size_t WS_WLORA = WS_WUKV + 2 * SZ_WUKV;
constexpr size_t SZ_WLORA = (size_t)3072 * 256 * 2;
constexpr size_t WS_WV1 = WS_WLORA + 2 * SZ_WLORA;
constexpr size_t WS_WV2 = WS_WV1 + (size_t)256 * 1024 * 2;
constexpr size_t WS_WBR = WS_WV2 + (size_t)1024 * 128 * 2;
constexpr size_t SZ_WBR = (size_t)3 * 2048 * 1024 * 2;
constexpr size_t WS_WOUT = WS_WBR + 2 * SZ_WBR;
constexpr size_t SZ_WOUT = (size_t)2048 * 2048 * 2;
constexpr size_t WS_WRT = WS_WOUT + 2 * SZ_WOUT;
constexpr size_t SZ_WRT = (size_t)256 * 4096 * 2;
constexpr size_t WS_WE1 = WS_WRT + 2 * SZ_WRT;
constexpr size_t WS_WE2 = WS_WE1 + (size_t)64 * 1024 * 2048 * 2;
constexpr size_t WS_REGA = WS_WE2 + (size_t)64 * 2048 * 512 * 2;
constexpr size_t WS_PROJ = WS_REGA;
constexpr size_t WS_QMLA = WS_PROJ + (size_t)T * NPROJ * 2;
constexpr size_t WS_KMLA = WS_QMLA + (size_t)T * 1536 * 2;
constexpr size_t WS_KPE = WS_KMLA + (size_t)T * 1024 * 2;
constexpr size_t WS_VMLA = WS_KMLA + (size_t)T * 1536 * 2;
constexpr size_t WS_REGA_END = WS_VMLA + (size_t)T * 1024 * 2;
constexpr size_t WS_APRIME = WS_REGA;
constexpr size_t WS_XG = WS_APRIME + (size_t)T * 4096 * 2;
constexpr size_t WS_HMOE = WS_XG + (size_t)MOE_ROWS * 2048 * 2;
constexpr size_t WS_Y = WS_HMOE + (size_t)MOE_ROWS * 512 * 2;
static_assert(WS_Y + (size_t)MOE_ROWS * 2048 * 2 <= WS_REGA_END, "MoE overlay fits region A");
constexpr size_t WS_X = WS_REGA_END;
constexpr size_t WS_H = WS_X + (size_t)T * 2048 * 4;
constexpr size_t WS_LGP = WS_H;
constexpr size_t WS_MERGED = WS_H + (size_t)T * 2048 * 2;
constexpr size_t WS_RK = WS_MERGED + (size_t)T * 2048 * 2;
constexpr size_t WS_VS = WS_RK + (size_t)T * 2048 * 2;
constexpr size_t WS_LORAIN = WS_VS + (size_t)2 * T * 1024 * 2;
constexpr size_t WS_LOGDEC = WS_LORAIN + (size_t)T * 768 * 2;
constexpr size_t WS_AIC = WS_LOGDEC + (size_t)T * 1024 * 4;
constexpr size_t WS_MACC = WS_LOGDEC;
constexpr size_t WS_GOUT = WS_AIC + (size_t)T * 1024 * 4;
constexpr size_t WS_T1 = WS_GOUT + (size_t)T * 1024 * 2;
constexpr size_t WS_VGATE = WS_T1 + (size_t)T * 128 * 2;
constexpr size_t WS_OALL = WS_VGATE + (size_t)T * 1024 * 2;
constexpr size_t WS_VMIX = WS_OALL + (size_t)3 * T * 1024 * 2;
constexpr size_t WS_BC = WS_VMIX + (size_t)T * 1024 * 2;
constexpr size_t WS_RWS = WS_BC + (size_t)T * 16 * 4;
constexpr size_t WS_END = WS_RWS + (size_t)4096 * 49152;
static_assert(WS_END <= (size_t)2048 * MiB, "workspace map fits 2 GiB");
static_assert(DEPTH == 2, "the phase program is written out for two layers");
constexpr int CW_BAR = 4096;
constexpr int CW_QHEAD = 8192;
constexpr int CW_CNT = 8448;
constexpr int CW_CUR = 8704;
constexpr int RING_BYTES = 131072, MISC_OFF = RING_BYTES + 320, LDS_BYTES = 147456;
constexpr int NWAVES = 8;

#define XB_TMO      128
#define XB_XCNT(j)  (256  + 64 * (j))
#define XB_XSUB(j)  (1280 + 64 * (j))
#define XB_XGEN(j)  (2304 + 64 * (j))
#define XB_TOP      3328
#define XB_TOPGEN   3392
#define XCD_BAR_WORDS 3456
#define XB_SPIN_CAP (1u << 18)
__device__ __forceinline__ unsigned xb_ld(unsigned* p)              { return __hip_atomic_load(p, __ATOMIC_RELAXED, __HIP_MEMORY_SCOPE_AGENT); }
__device__ __forceinline__ unsigned xb_add(unsigned* p, unsigned v) { return __hip_atomic_fetch_add(p, v, __ATOMIC_RELAXED, __HIP_MEMORY_SCOPE_AGENT); }
__device__ __forceinline__ unsigned xb_xcc_id() { return (unsigned)__builtin_amdgcn_s_getreg((3 << 11) | 20) & 0xFu; }
#define XB_SPIN(cond, bar) do { unsigned _sp = 0; while (cond) { __builtin_amdgcn_s_sleep(1); \
    if ((++_sp & 255u) == 0u) { if (xb_ld(&(bar)[XB_TMO])) break; if (_sp > XB_SPIN_CAP) { atomicAdd(&(bar)[XB_TMO], 1u); break; } } } } while (0)
struct XcdBarrier { unsigned* bar; unsigned x; volatile LAS unsigned* st; };
__device__ __forceinline__ XcdBarrier xcd_barrier_post(unsigned* bar, volatile LAS unsigned* st, bool leader) {
    XcdBarrier b; b.bar = bar; b.x = xb_xcc_id(); b.st = st;
    if (leader) (void)xb_add(&bar[XB_XCNT(b.x)], 1u);
    return b;
}
__device__ __forceinline__ void xcd_barrier_complete(unsigned* bar, unsigned x, unsigned& nloc, unsigned& nx) {
    const unsigned G = gridDim.x * gridDim.y * gridDim.z;
    unsigned sum, cnt, mine, sp = 0u;
    for (;;) {
        sum = 0u; cnt = 0u; mine = 0u;
#pragma unroll
        for (unsigned j = 0; j < 16; ++j) { const unsigned c = xb_ld(&bar[XB_XCNT(j)]); sum += c; cnt += (c > 0u) ? 1u : 0u; mine = (j == x) ? c : mine; }
        if (sum == G) break;
        __builtin_amdgcn_s_sleep(1);
        if ((++sp & 255u) == 0u) { if (xb_ld(&bar[XB_TMO])) break; if (sp > XB_SPIN_CAP) { atomicAdd(&bar[XB_TMO], 1u); break; } }
    }
    nloc = mine > 0u ? mine : 1u; nx = cnt > 0u ? cnt : 1u;
}
__device__ __forceinline__ void xcd_barrier(const XcdBarrier& b, bool leader) {
    asm volatile("s_waitcnt vmcnt(0)" ::: "memory");
    __syncthreads();
    if (leader) {
        unsigned* bar = b.bar;
        __builtin_amdgcn_s_waitcnt(0);
        unsigned nloc = b.st[0], nx = b.st[1];
        if (nloc == 0u) { xcd_barrier_complete(bar, b.x, nloc, nx); b.st[0] = nloc; b.st[1] = nx; }
        const unsigned old = xb_add(&bar[XB_XSUB(b.x)], 1u);
        const unsigned gen = old / nloc;
        if (old + 1u == (gen + 1u) * nloc) {
            __builtin_amdgcn_fence(__ATOMIC_RELEASE, "agent");
            asm volatile("s_waitcnt vmcnt(0)" ::: "memory");
            const unsigned og = xb_add(&bar[XB_TOP], 1u);
            const unsigned tg = og / nx;
            if (og + 1u == (tg + 1u) * nx) xb_add(&bar[XB_TOPGEN], 1u);
            else XB_SPIN(xb_ld(&bar[XB_TOPGEN]) == tg, bar);
            __builtin_amdgcn_fence(__ATOMIC_ACQUIRE, "agent");
            xb_add(&bar[XB_XGEN(b.x)], 1u);
            asm volatile("s_waitcnt vmcnt(0)" ::: "memory");
        } else {
            XB_SPIN(xb_ld(&bar[XB_XGEN(b.x)]) == gen, bar);
            __builtin_amdgcn_fence(__ATOMIC_ACQUIRE, "agent");
            asm volatile("s_waitcnt vmcnt(0)" ::: "memory");
        }
    }
    __syncthreads();
}

struct Args { const void* in[35]; float* out; unsigned char* ws; int ph_lo, ph_hi; };
struct Frame {
    LAS unsigned char* lds; volatile LAS unsigned* MISC; unsigned* ctl; unsigned char* ws;
    int tid, lane, wave, vcu, G, gw, NGW;
};
#define LDS_WAIT() asm volatile("s_waitcnt lgkmcnt(0)" ::: "memory")
template <int IDX> __device__ __forceinline__ const void* kernarg_in() {
    const auto ka = __builtin_amdgcn_kernarg_segment_ptr(); unsigned long long r;
    asm volatile("s_load_dwordx2 %0, %1, %2\n\ts_waitcnt lgkmcnt(0)" : "=s"(r) : "s"(ka), "n"(IDX * 8));
    return (const void*)(const GAS void*)r;
}
#define ARGP(i) (kernarg_in<(i)>())
__device__ __forceinline__ unsigned char* launder(unsigned char* p) { unsigned long long v = (unsigned long long)p; asm volatile("" : "+s"(v)); return (unsigned char*)(GAS unsigned char*)v; }

__device__ __forceinline__ void conv_item(const float* W, int ldw, int Ksrc, int k0, int n0src, bf16_t* WT, int ldt, int row0dst, int kdst0, float scale, const float* kscale, bool lo_mode, LAS float* scr, int lane) {
#pragma unroll 16
    for (int i = 0; i < 32; ++i) { const int kk = 2 * i + (lane >> 5), k = k0 + kk; float v = 0.f;
        if (k < Ksrc) { v = W[(size_t)k * ldw + n0src + (lane & 31)] * scale; if (kscale) v *= kscale[k]; }
        if (lo_mode) v = v - bf2f(f2bf(v));
        scr[kk * 33 + (lane & 31)] = v; }
    LDS_WAIT(); asm volatile("" ::: "memory");
    const int c = lane & 7;
#pragma unroll
    for (int j = 0; j < 4; ++j) { const int n = (lane >> 3) + 8 * j; const LAS float* s = scr + (8 * c) * 33 + n;
        u32x4 o; o.x = pk2(s[0 * 33], s[1 * 33]); o.y = pk2(s[2 * 33], s[3 * 33]); o.z = pk2(s[4 * 33], s[5 * 33]); o.w = pk2(s[6 * 33], s[7 * 33]);
        *(u32x4*)(WT + (size_t)(row0dst + n) * ldt + kdst0 + k0 + 8 * c) = o; }
    LDS_WAIT(); asm volatile("" ::: "memory");
}
__device__ __forceinline__ void conv_job(Frame& F, int& base, const float* W, int ldw, int Ksrc, int Kdst, int col0, int ncols, bf16_t* WT, int ldt, int row0, int kdst0, float scale, const float* kscale, bool lo_mode) {
    LAS float* scr = (LAS float*)(F.lds + F.wave * 16384);
    const int nkb = Kdst / 64, nnb = ncols / 32, nitems = nkb * nnb;
    int it = (F.gw + F.NGW - (base % F.NGW)) % F.NGW; base += nitems;
    for (; it < nitems; it += F.NGW) { const int kb = it / nnb, nb = it % nnb;
        conv_item(W, ldw, Ksrc, kb * 64, col0 + nb * 32, WT, ldt, row0 + nb * 32, kdst0, scale, kscale, lo_mode, scr, F.lane); }
}
__device__ __forceinline__ void zero_rows(Frame& F, bf16_t* WT, int ldt, int row0, int nrows) {
    const size_t n16 = (size_t)nrows * ldt / 8; u32x4* p = (u32x4*)(WT + (size_t)row0 * ldt);
    for (size_t i = (size_t)F.gw * 64 + F.lane; i < n16; i += (size_t)F.NGW * 64) p[i] = (u32x4){0u, 0u, 0u, 0u};
}


constexpr int PANEL_PITCH = 1028;
struct PanelDesc { const float* W; bf16_t* WT; int ldw, k0, c0, ncols, ldt, kind, p0, p1; };
__device__ __forceinline__ void panel_map(const PanelDesc& d, int c, int& drow, float& sc) {
    sc = 1.f;
    if (d.kind == 0) drow = d.p0 * 1024 + 256 * (c >> 7) + 128 * d.p1 + (c & 127);
    else if (d.kind == 1) drow = d.p0 * 2048 + c;
    else if (d.kind == 2) { drow = c < 6336 ? c : c < 7616 ? c + 64 : c < 7648 ? c - 1280 : c + 32; sc = c < 1024 ? 0.125f * LOG2E : 1.f; }
    else drow = d.p0 + c;
}
__device__ __forceinline__ void panel_load(Frame& F, const PanelDesc& d, f32x4 (&v)[16]) {
#pragma unroll
    for (int i = 0; i < 16; ++i) { const int f = F.tid + 512 * i, kk = f >> 7, n4 = f & 127;
        v[i] = (4 * n4 < d.ncols) ? __builtin_nontemporal_load((const f32x4*)(d.W + (size_t)(d.k0 + kk) * d.ldw + d.c0 + 4 * n4)) : (f32x4){0.f, 0.f, 0.f, 0.f}; }
}
__device__ __forceinline__ void panel_finish(Frame& F, const PanelDesc& d, const f32x4 (&v)[16]) {
    const int tid = F.tid; LAS unsigned char* L = F.lds;
#pragma unroll
    for (int i = 0; i < 16; ++i) { const int f = tid + 512 * i, kk = f >> 7, n4 = f & 127; LAS unsigned* o = (LAS unsigned*)(L + kk * PANEL_PITCH + n4 * 8);
        o[0] = cvt_pk_bf16(v[i][0], v[i][1]); o[1] = cvt_pk_bf16(v[i][2], v[i][3]); }
    __syncthreads();
    const int c = tid & 7, nl = tid >> 3;
#pragma unroll
    for (int j = 0; j < 4; ++j) { const int n = 2 * nl + 128 * j;
        if (n < d.ncols) { int drow; float sc; panel_map(d, d.c0 + n, drow, sc);
            unsigned w[8];
#pragma unroll
            for (int q = 0; q < 8; ++q) w[q] = *(const LAS unsigned*)(L + (8 * c + q) * PANEL_PITCH + n * 2);
            u32x4 o0, o1;
            if (d.kind != 2) {
                o0.x = __builtin_amdgcn_perm(w[1], w[0], 0x05040100u); o0.y = __builtin_amdgcn_perm(w[3], w[2], 0x05040100u); o0.z = __builtin_amdgcn_perm(w[5], w[4], 0x05040100u); o0.w = __builtin_amdgcn_perm(w[7], w[6], 0x05040100u);
                o1.x = __builtin_amdgcn_perm(w[1], w[0], 0x07060302u); o1.y = __builtin_amdgcn_perm(w[3], w[2], 0x07060302u); o1.z = __builtin_amdgcn_perm(w[5], w[4], 0x07060302u); o1.w = __builtin_amdgcn_perm(w[7], w[6], 0x07060302u);
            } else { float x0[8], x1[8];
#pragma unroll
                for (int q = 0; q < 8; ++q) { x0[q] = bflo(w[q]) * sc; x1[q] = bfhi(w[q]) * sc; }
                o0.x = pk2(x0[0], x0[1]); o0.y = pk2(x0[2], x0[3]); o0.z = pk2(x0[4], x0[5]); o0.w = pk2(x0[6], x0[7]);
                o1.x = pk2(x1[0], x1[1]); o1.y = pk2(x1[2], x1[3]); o1.z = pk2(x1[4], x1[5]); o1.w = pk2(x1[6], x1[7]); }
            *(u32x4*)(d.WT + (size_t)drow * d.ldt + d.k0 + 8 * c) = o0; *(u32x4*)(d.WT + (size_t)(drow + 1) * d.ldt + d.k0 + 8 * c) = o1; } }
    __syncthreads();
}
template <class DescFn>
__device__ __forceinline__ void run_panels(Frame& F, int first, int n, int stride, const DescFn& fn) {
    if (n <= 0) return;
    f32x4 va[16], vb[16]; PanelDesc da = fn(first), db = da; panel_load(F, da, va);
    for (int q = 0; q < n; q += 2) {
        const bool hb = q + 1 < n; if (hb) { db = fn(first + (q + 1) * stride); panel_load(F, db, vb); }
        panel_finish(F, da, va);
        if (q + 2 < n) { da = fn(first + (q + 2) * stride); panel_load(F, da, va); }
        if (hb) panel_finish(F, db, vb);
    }
}
__device__ __forceinline__ void router_conv(Frame& F, int& base, const float* rgw, const float* rew, bf16_t* WT) {
    LAS float* scr = (LAS float*)(F.lds + F.wave * 16384);
    const int nitems = 32 * 4 * 3;
    int it = (F.gw + F.NGW - (base % F.NGW)) % F.NGW; base += nitems;
    for (; it < nitems; it += F.NGW) { const int var = it / 128, r = it % 128, kb = r / 4, nb = r % 4, k0 = kb * 64, lane = F.lane;
#pragma unroll 8
        for (int i = 0; i < 32; ++i) { const int kk = 2 * i + (lane >> 5), k = k0 + kk, n = nb * 32 + (lane & 31); float v = 0.f;
            if (n < 8) v = rgw[(size_t)k * 8 + n]; else if (n < 72) v = rew[(size_t)k * 64 + (n - 8)];
            if (var == 2) v = v - bf2f(f2bf(v));
            scr[kk * 33 + (lane & 31)] = v; }
        LDS_WAIT(); asm volatile("" ::: "memory");
        const int c = lane & 7; const int row0 = (var == 2 ? 128 : 0) + nb * 32, kd0 = (var == 1 ? 2048 : 0);
#pragma unroll
        for (int j = 0; j < 4; ++j) { const int n = (lane >> 3) + 8 * j; const LAS float* s = scr + (8 * c) * 33 + n;
            u32x4 o; o.x = pk2(s[0 * 33], s[1 * 33]); o.y = pk2(s[2 * 33], s[3 * 33]); o.z = pk2(s[4 * 33], s[5 * 33]); o.w = pk2(s[6 * 33], s[7 * 33]);
            *(u32x4*)(WT + (size_t)(row0 + n) * 4096 + kd0 + k0 + 8 * c) = o; }
        LDS_WAIT(); asm volatile("" ::: "memory");
    }
    for (int i = F.gw * 64 + F.lane; i < 128 * 256; i += F.NGW * 64) { const int row = 128 + i / 256, c8 = i % 256; *(u32x4*)(WT + (size_t)row * 4096 + 2048 + c8 * 8) = (u32x4){0u, 0u, 0u, 0u}; }
}

struct P0Desc { unsigned char* ws; static constexpr int NP_WIN = 27 * 32, NP_BR = 4 * 16, NP_OUT = 4 * 32, NP_L = NP_WIN + 3 * NP_BR + NP_OUT;
    __device__ __forceinline__ PanelDesc operator()(int pi) const { const int l = pi / NP_L; int r = pi % NP_L; PanelDesc d; d.p1 = 0;
        if (r < NP_WIN) { const int cp = r % 27, kb = r / 27; d.c0 = cp * 512; d.ncols = (N_IN_SRC - d.c0) < 512 ? (N_IN_SRC - d.c0) : 512;
            d.W = (const float*)ARGP(3) + (size_t)l * 2048 * N_IN_SRC; d.ldw = N_IN_SRC; d.k0 = kb * 64; d.WT = (bf16_t*)(ws + WS_WIN + l * SZ_WIN); d.ldt = 2048; d.kind = 2; d.p0 = 0; return d; }
        r -= NP_WIN;
        if (r < 3 * NP_BR) { const int br = r / NP_BR, q = r % NP_BR, cp = q & 3, kb = q >> 2; d.W = (const float*)(br == 0 ? ARGP(22) : br == 1 ? ARGP(23) : ARGP(24)) + (size_t)l * 1024 * 2048;
            d.ldw = 2048; d.k0 = kb * 64; d.c0 = cp * 512; d.ncols = 512; d.WT = (bf16_t*)(ws + WS_WBR + l * SZ_WBR); d.ldt = 1024; d.kind = 3; d.p0 = br * 2048; return d; }
        r -= 3 * NP_BR;
        { const int cp = r & 3, kb = r >> 2; d.W = (const float*)ARGP(25) + (size_t)l * 2048 * 2048; d.ldw = 2048; d.k0 = kb * 64; d.c0 = cp * 512; d.ncols = 512;
          d.WT = (bf16_t*)(ws + WS_WOUT + l * SZ_WOUT); d.ldt = 2048; d.kind = 3; d.p0 = 0; return d; } } };
__device__ __forceinline__ void phase_convert(Frame& F, const Args& a) {
    int base = 0;
    for (int l = 0; l < DEPTH; ++l) {
        zero_rows(F, (bf16_t*)(F.ws + WS_WIN + l * SZ_WIN), 2048, PC_KPE + 32, 32);
        const float* wuq = (const float*)ARGP(19) + (size_t)l * 768 * 1536; bf16_t* WUQ = (bf16_t*)(F.ws + WS_WUQ + l * SZ_WUQ); const float* qg = (const float*)ARGP(18) + l * 768;
        const float qs = 0.10206207261596575f * LOG2E;
        for (int hd = 0; hd < 16; ++hd) { conv_job(F, base, wuq, 1536, 768, 768, hd * 96, 64, WUQ, 768, hd * 64, 0, qs, qg, false);
                                           conv_job(F, base, wuq, 1536, 768, 768, hd * 96 + 64, 32, WUQ, 768, 1024 + hd * 32, 0, qs, qg, false); }
        const float* wukv = (const float*)ARGP(21) + (size_t)l * 256 * 2048; bf16_t* WUKV = (bf16_t*)(F.ws + WS_WUKV + l * SZ_WUKV); const float* kvg = (const float*)ARGP(20) + l * 256;
        for (int hd = 0; hd < 16; ++hd) { conv_job(F, base, wukv, 2048, 256, 256, hd * 128, 64, WUKV, 256, hd * 64, 0, 1.f, kvg, false);
                                           conv_job(F, base, wukv, 2048, 256, 256, hd * 128 + 64, 64, WUKV, 256, 1024 + hd * 64, 0, 1.f, kvg, false); }
        bf16_t* WLORA = (bf16_t*)(F.ws + WS_WLORA + l * SZ_WLORA);
        conv_job(F, base, (const float*)ARGP(6) + (size_t)l * 96 * 1024, 1024, 96, 256, 0, 1024, WLORA, 256, 0, 0, 1.f, nullptr, false);
        conv_job(F, base, (const float*)ARGP(8) + (size_t)l * 96 * 1024, 1024, 96, 256, 0, 1024, WLORA, 256, 1024, 0, 1.f, nullptr, false);
        conv_job(F, base, (const float*)ARGP(9) + (size_t)l * 256 * 1024, 1024, 256, 256, 0, 1024, WLORA, 256, 2048, 0, 1.f, nullptr, false);
        router_conv(F, base, (const float*)ARGP(27) + (size_t)l * 2048 * 8, (const float*)ARGP(29) + (size_t)l * 2048 * 64, (bf16_t*)(F.ws + WS_WRT + l * SZ_WRT));
    }
    conv_job(F, base, (const float*)ARGP(16), 64, 1024, 1024, 0, 64, (bf16_t*)(F.ws + WS_WV1), 1024, 0, 0, 1.f, nullptr, false);
    zero_rows(F, (bf16_t*)(F.ws + WS_WV1), 1024, 64, 192);
    conv_job(F, base, (const float*)ARGP(17), 1024, 64, 128, 0, 1024, (bf16_t*)(F.ws + WS_WV2), 128, 0, 0, 1.f, nullptr, false);
    { const int* pos = (const int*)ARGP(1); float* cosb = (float*)(F.ws + WS_COS); float* sinb = (float*)(F.ws + WS_SIN);
      for (int i = F.gw * 64 + F.lane; i < T * 16; i += F.NGW * 64) { const int t = i >> 4, j = i & 15;
          const double fr4 = (j & 3) == 0 ? 1.0 : (j & 3) == 1 ? 0.5623413251903491 : (j & 3) == 2 ? 0.31622776601683794 : 0.1778279410038923;
          const double dec = (j >> 2) == 0 ? 1.0 : (j >> 2) == 1 ? 0.1 : (j >> 2) == 2 ? 0.01 : 0.001;
          const double rev = (double)pos[t] * fr4 * dec * 0.15915494309189535;
          const double fr = rev - __builtin_floor(rev);
          const float ang = (float)(fr * 6.283185307179586);
          cosb[i] = __cosf(ang); sinb[i] = __sinf(ang); } }
    __syncthreads();
    { P0Desc fn{F.ws}; const int np = (P0Desc::NP_L - F.vcu + F.G - 1) / F.G; run_panels(F, F.vcu, np, F.G, fn); }
}
constexpr int EC_PANELS = 64 * (2 * 32 + 8 * 4);
struct EcDesc { unsigned char* ws; int l;
    __device__ __forceinline__ PanelDesc operator()(int pidx) const { const int e = pidx / 96, r = pidx % 96; PanelDesc d;
        if (r < 64) { const int which = r >> 5, kb = r & 31; d.W = (const float*)(which ? ARGP(32) : ARGP(31)) + ((size_t)l * 64 + e) * 2048 * 512; d.WT = (bf16_t*)(ws + WS_WE1);
            d.ldw = 512; d.k0 = kb * 64; d.c0 = 0; d.ncols = 512; d.ldt = 2048; d.kind = 0; d.p0 = e; d.p1 = which; }
        else { const int rr = r - 64, kb = rr >> 2, nq = rr & 3; d.W = (const float*)ARGP(33) + ((size_t)l * 64 + e) * 512 * 2048; d.WT = (bf16_t*)(ws + WS_WE2);
            d.ldw = 2048; d.k0 = kb * 64; d.c0 = nq * 512; d.ncols = 512; d.ldt = 512; d.kind = 1; d.p0 = e; d.p1 = 0; }
        return d; } };

#ifndef DBG_NOMOE
#define DBG_NOMOE 0
#endif
template <int MODE>
__device__ __forceinline__ void phase_norm(Frame& F, const float* xin, float* X, const float* g, bf16_t* H, float* out, const bf16_t* Y, const int* pos, const float* tokw) {
    f32x4 gv[8];
    { const f32x4* gr = (const f32x4*)g + F.lane;
#pragma unroll
      for (int j = 0; j < 8; ++j) gv[j] = gr[64 * j]; }
    for (int t = F.gw; t < T; t += F.NGW) {
        f32x4 v[8]; float ss = 0.f;
        const f32x4* xr = (const f32x4*)(xin + (size_t)t * 2048) + F.lane;
#pragma unroll
        for (int j = 0; j < 8; ++j) v[j] = xr[64 * j];
        if ((MODE == 1 || MODE == 2) && !DBG_NOMOE) {
            const int p0 = pos[2 * t], p1 = pos[2 * t + 1]; const float w0 = tokw[2 * t], w1 = tokw[2 * t + 1];
            const bf16_t* y0 = Y + (size_t)p0 * 2048 + 4 * F.lane; const bf16_t* y1 = Y + (size_t)p1 * 2048 + 4 * F.lane;
#pragma unroll
            for (int j = 0; j < 8; ++j) { v[j] += w0 * load4_bf16(y0 + 256 * j) + w1 * load4_bf16(y1 + 256 * j); }
            if (MODE == 1) { f32x4* xw = (f32x4*)(X + (size_t)t * 2048) + F.lane;
#pragma unroll
                for (int j = 0; j < 8; ++j) xw[64 * j] = v[j]; }
        }
#pragma unroll
        for (int j = 0; j < 8; ++j) ss += (v[j][0] * v[j][0] + v[j][1] * v[j][1]) + (v[j][2] * v[j][2] + v[j][3] * v[j][3]);
        const float rstd = rsqrtf(wave_sum(ss) * (1.f / 2048.f) + NORM_EPS);
#pragma unroll
        for (int j = 0; j < 8; ++j) { const f32x4 o = v[j] * rstd * gv[j];
            if (MODE == 2) ((f32x4*)(out + (size_t)t * 2048) + F.lane)[64 * j] = o;
            else if (MODE == 3) { u32x2 hi; hi.x = pk2(o[0], o[1]); hi.y = pk2(o[2], o[3]);
                const f32x4 lo = (f32x4){o[0] - bflo(hi.x), o[1] - bfhi(hi.x), o[2] - bflo(hi.y), o[3] - bfhi(hi.y)};
                *(u32x2*)(H + (size_t)t * 4096 + 4 * F.lane + 256 * j) = hi; store4_bf16(H + (size_t)t * 4096 + 2048 + 4 * F.lane + 256 * j, lo); }
            else store4_bf16(H + (size_t)t * 2048 + 4 * F.lane + 256 * j, o); }
    }
}

__device__ __forceinline__ void shift8(const bf16_t* cur, const bf16_t* prv, bool has_prev, const float* mu, float (&o)[8]) {
    float c[8], p[8]; load8f(cur, c);
    if (has_prev) load8f(prv, p); else {
#pragma unroll
        for (int i = 0; i < 8; ++i) p[i] = 0.f; }
#pragma unroll
    for (int i = 0; i < 8; ++i) o[i] = c[i] + (p[i] - c[i]) * mu[i];
}
__device__ __forceinline__ void phase_prep(Frame& F, const Args& a, int l) {
    const bf16_t* PROJ = (const bf16_t*)(F.ws + WS_PROJ); bf16_t* RK = (bf16_t*)(F.ws + WS_RK); bf16_t* VS = (bf16_t*)(F.ws + WS_VS) + (size_t)l * T * 1024;
    bf16_t* LORAIN = (bf16_t*)(F.ws + WS_LORAIN); bf16_t* KPE = (bf16_t*)(F.ws + WS_KPE);
    float* rstdq = (float*)(F.ws + WS_RSTDQ); float* rstdkv = (float*)(F.ws + WS_RSTDKV);
    const float* cosb = (const float*)(F.ws + WS_COS); const float* sinb = (const float*)(F.ws + WS_SIN);
    const float* mu = (const float*)ARGP(4) + (size_t)l * RWKV_COLS; const int lane = F.lane, l31 = lane & 31, l15 = lane & 15;
    const bool isW = lane < 12, isA = lane >= 32 && lane < 44;
    const int offX = isW ? PC_WD + 8 * lane : isA ? PC_AD + 8 * (lane - 32) : PC_WD, muX = isW ? 3072 + 8 * lane : isA ? 3168 + 8 * (lane - 32) : 3072;
    const float lowf = lane < 32 ? 1.f : 0.f;
    f32x4 mm[6][2];
#pragma unroll
    for (int j = 0; j < 6; ++j) { mm[j][0] = *(const f32x4*)(mu + j * 512 + lane * 8); mm[j][1] = *(const f32x4*)(mu + j * 512 + lane * 8 + 4); }
    for (int t = F.gw; t < T; t += F.NGW) {
        const bool hp = (t % SEQ) != 0; const float hpf = hp ? 1.f : 0.f;
        const bf16_t* prow = PROJ + (size_t)t * NPROJ; const bf16_t* pprev = hp ? prow - NPROJ : prow;
        u32x4 cur[6], prv[6];
#pragma unroll
        for (int j = 0; j < 6; ++j) { cur[j] = *(const u32x4*)(prow + PC_RR + j * 512 + lane * 8); prv[j] = *(const u32x4*)(pprev + PC_RR + j * 512 + lane * 8); }
        const u32x4 xc = *(const u32x4*)(prow + offX), xp = *(const u32x4*)(pprev + offX), gc = *(const u32x4*)(prow + PC_GD + 8 * l31), gp = *(const u32x4*)(pprev + PC_GD + 8 * l31);
        const u32x4 q0 = *(const u32x4*)(prow + PC_CQ + 8 * lane), q1 = *(const u32x4*)(prow + PC_CQ + 512 + 8 * l31), kv = *(const u32x4*)(prow + PC_CKV + 8 * l31);
        const f32x4 mx0 = *(const f32x4*)(mu + muX), mx1 = *(const f32x4*)(mu + muX + 4), mg0 = *(const f32x4*)(mu + 3264 + 8 * l31), mg1 = *(const f32x4*)(mu + 3264 + 8 * l31 + 4);
        const float kx1 = bf2f(prow[PC_KPE + l15]), kx2 = bf2f(prow[PC_KPE + 16 + l15]), kcs = cosb[(size_t)t * 16 + l15], ksn = sinb[(size_t)t * 16 + l15];
#pragma unroll
        for (int j = 0; j < 6; ++j) { float c[8], pv[8], o[8]; unpack8(cur[j], c); unpack8(prv[j], pv);
#pragma unroll
            for (int i = 0; i < 8; ++i) o[i] = c[i] + (pv[i] * hpf - c[i]) * mm[j][i >> 2][i & 3];
            if (j < 4) store8f(RK + (size_t)t * 2048 + j * 512 + lane * 8, o); else store8f(VS + (size_t)t * 1024 + (j - 4) * 512 + lane * 8, o); }
        { float c[8], pv[8], o[8]; unpack8(xc, c); unpack8(xp, pv);
#pragma unroll
          for (int i = 0; i < 8; ++i) { const float m = i < 4 ? mx0[i & 3] : mx1[i & 3]; const float x = c[i] + (pv[i] * hpf - c[i]) * m;
              const float th = 1.0f - 2.0f * __builtin_amdgcn_rcpf(__expf(2.0f * x) + 1.0f); o[i] = isW ? th : isA ? x : 0.f; }
          store8f(LORAIN + (size_t)t * 768 + 8 * lane, o);
          unpack8(gc, c); unpack8(gp, pv);
#pragma unroll
          for (int i = 0; i < 8; ++i) { const float m = i < 4 ? mg0[i & 3] : mg1[i & 3]; o[i] = fast_sigmoid(c[i] + (pv[i] * hpf - c[i]) * m); }
          if (lane < 32) store8f(LORAIN + (size_t)t * 768 + 512 + 8 * lane, o); }
        { float a0[8], a1[8], a2[8], s1 = 0.f, s1b = 0.f, s2 = 0.f; unpack8(q0, a0); unpack8(q1, a1); unpack8(kv, a2);
#pragma unroll
          for (int i = 0; i < 8; ++i) { s1 += a0[i] * a0[i]; s1b += a1[i] * a1[i]; s2 += a2[i] * a2[i]; }
          s1 = wave_sum(s1 + s1b * lowf); s2 = wave_sum(s2 * lowf);
          if (lane == 0) { rstdq[t] = rsqrtf(s1 * (1.f / 768.f) + NORM_EPS); rstdkv[t] = rsqrtf(s2 * (1.f / 256.f) + NORM_EPS); } }
        if (lane < 16) { KPE[(size_t)t * 32 + lane] = (bf16_t)f2bf(kx1 * kcs - kx2 * ksn); KPE[(size_t)t * 32 + 16 + lane] = (bf16_t)f2bf(kx2 * kcs + kx1 * ksn); }
    }
}

__device__ __forceinline__ int crow(int r, int hi) { return (r & 3) + 8 * (r >> 2) + 4 * hi; }
__device__ __forceinline__ s16x4 vtr(const LAS unsigned char* p) { return __builtin_bit_cast(s16x4, __builtin_amdgcn_ds_read_tr16_b64_v4i16((LAS v4i16_t*)p)); }
#define MFMA32(a, b, c) __builtin_amdgcn_mfma_f32_32x32x16_bf16((a), (b), (c), 0, 0, 0)

__device__ __forceinline__ void pv_tile(f32x16 (&o)[2], const LAS unsigned char* Vbuf, const u32x4 (&pw)[4], int lane) {
    const int hi = lane >> 5; const LAS unsigned char* vb = Vbuf + ((lane >> 4) & 1) * 32 + (lane & 3) * 8 + (4 * hi + ((lane & 15) >> 2)) * 64;
#pragma unroll
    for (int d0 = 0; d0 < 2; ++d0)
#pragma unroll
        for (int s = 0; s < 4; ++s) { const s16x4 lo = vtr(vb + d0 * 4096 + s * 1024), hh = vtr(vb + d0 * 4096 + s * 1024 + 512);
            const bf16x8 vf = (bf16x8){lo[0], lo[1], lo[2], lo[3], hh[0], hh[1], hh[2], hh[3]};
            o[d0] = MFMA32(vf, __builtin_bit_cast(bf16x8, pw[s]), o[d0]); }
}
__device__ __forceinline__ void pack_p(u32x4 (&pw)[4], const f32x16& p0, const f32x16& p1) {
    pw[0] = (u32x4){cvt_pk_bf16(p0[0], p0[1]), cvt_pk_bf16(p0[2], p0[3]), cvt_pk_bf16(p0[4], p0[5]), cvt_pk_bf16(p0[6], p0[7])};
    pw[1] = (u32x4){cvt_pk_bf16(p0[8], p0[9]), cvt_pk_bf16(p0[10], p0[11]), cvt_pk_bf16(p0[12], p0[13]), cvt_pk_bf16(p0[14], p0[15])};
    pw[2] = (u32x4){cvt_pk_bf16(p1[0], p1[1]), cvt_pk_bf16(p1[2], p1[3]), cvt_pk_bf16(p1[4], p1[5]), cvt_pk_bf16(p1[6], p1[7])};
    pw[3] = (u32x4){cvt_pk_bf16(p1[8], p1[9]), cvt_pk_bf16(p1[10], p1[11]), cvt_pk_bf16(p1[12], p1[13]), cvt_pk_bf16(p1[14], p1[15])};
}
__device__ __forceinline__ void store_o(bf16_t* Orow, const f32x16 (&o)[2], float sc, int hi) {
#pragma unroll
    for (int d0 = 0; d0 < 2; ++d0)
#pragma unroll
        for (int rg = 0; rg < 4; ++rg) { const f32x4 v = (f32x4){o[d0][4 * rg] * sc, o[d0][4 * rg + 1] * sc, o[d0][4 * rg + 2] * sc, o[d0][4 * rg + 3] * sc};
            store4_bf16(Orow + 32 * d0 + 8 * rg + 4 * hi, v); }
}
__device__ __forceinline__ float other_half(float x, int hi) {
    auto rr = __builtin_amdgcn_permlane32_swap(__float_as_uint(x), __float_as_uint(x), false, false);
    return __uint_as_float(hi ? rr[0] : rr[1]);
}

constexpr float SB_DEAD_THR = 1e-30f;
__device__ __forceinline__ void glds16(const void* gsrc, unsigned lds_dst) { unsigned keep;
    asm volatile("s_mov_b32 %0, m0\n\ts_mov_b32 m0, %2\n\ts_nop 0\n\tglobal_load_lds_dwordx4 %1, off\n\ts_mov_b32 m0, %0" : "=&s"(keep) : "v"(gsrc), "s"(lds_dst) : "memory"); }
#define ATT_WAIT_BAR(N) asm volatile("s_waitcnt vmcnt(" #N ") lgkmcnt(0)\n\ts_barrier" ::: "memory")
__device__ __forceinline__ void attn_sb_unit(Frame& F, int b, int h, int qb, const bf16_t* PROJ, bf16_t* O) {
    const int lane = F.lane, wid = F.wave, r32 = lane & 31, hi = lane >> 5;
    const int q0 = qb * 256, qw0 = q0 + wid * 32; const size_t rowbase = (size_t)b * SEQ;
    const bf16_t* Qp = PROJ + (rowbase + qw0 + r32) * NPROJ + PC_SBQ + h * 64;
    bf16x8 qf[4];
#pragma unroll
    for (int d0 = 0; d0 < 4; ++d0) qf[d0] = *(const bf16x8*)(Qp + d0 * 16 + hi * 8);
    const bf16_t* Kg = PROJ + rowbase * NPROJ + PC_SBK + h * 64 + (size_t)lane * NPROJ + wid * 8;
    const bf16_t* Vg = PROJ + rowbase * NPROJ + PC_SBV + h * 64 + (size_t)(16 * (wid & 3) + (lane >> 2)) * NPROJ + (wid >> 2) * 32 + (lane & 3) * 8;
    constexpr int SLOT = 16384; const unsigned lds0 = (unsigned)(uintptr_t)F.lds;
    const int NT = 4 * qb + 4;
#define SB_ISSUE(itx) do { const int kt_ = NT - 1 - (itx); const unsigned so_ = (unsigned)__builtin_amdgcn_readfirstlane((int)(lds0 + ((itx) % 3) * SLOT + wid * 1024)); \
        glds16(Kg + (size_t)kt_ * 64 * NPROJ, so_); glds16(Vg + (size_t)kt_ * 64 * NPROJ, so_ + 8192); } while (0)
    SB_ISSUE(0); SB_ISSUE(1);
    f32x16 o[2]; o[0] = (f32x16){}; o[1] = (f32x16){}; float carry = 1.0f;
    const int tq = qw0 + r32;
    for (int it = 0; it < NT; ++it) {
        if (it + 1 < NT) ATT_WAIT_BAR(2); else ATT_WAIT_BAR(0);
        if (it > 0) { unsigned alld = 1u;
#pragma unroll
            for (int q = 0; q < 8; ++q) alld &= F.MISC[16 + ((it - 1) & 1) * 8 + q];
            if (alld) break; }
        if (it + 2 < NT) SB_ISSUE(it + 2);
        const int kt = NT - 1 - it, cur = (it % 3) * SLOT, k0 = kt * 64;
        if (k0 < qw0 + 31) {
            f32x16 p0, p1; const LAS unsigned char* kb = F.lds + cur + hi * 1024 + r32 * 16;
#pragma unroll
            for (int d0 = 0; d0 < 4; ++d0) { const bf16x8 b0 = *(const LAS bf16x8*)(kb + d0 * 2048), b1 = *(const LAS bf16x8*)(kb + d0 * 2048 + 512);
                if (d0 == 0) { p0 = MFMA32(b0, qf[0], (f32x16){}); p1 = MFMA32(b1, qf[0], (f32x16){}); } else { p0 = MFMA32(b0, qf[d0], p0); p1 = MFMA32(b1, qf[d0], p1); } }
#pragma unroll
            for (int r = 0; r < 16; ++r) { p0[r] = __builtin_amdgcn_rcpf(1.0f + __builtin_amdgcn_exp2f(p0[r])); p1[r] = __builtin_amdgcn_rcpf(1.0f + __builtin_amdgcn_exp2f(p1[r])); }
            if (k0 + 63 >= qw0) {
#pragma unroll
                for (int r = 0; r < 16; ++r) { const int key = k0 + crow(r, hi); if (key >= tq) p0[r] = 1.0f; if (key + 32 >= tq) p1[r] = 1.0f; } }
            float tot[8], toto[8];
#pragma unroll
            for (int g = 0; g < 4; ++g) { tot[g] = (p0[4 * g] * p0[4 * g + 1]) * (p0[4 * g + 2] * p0[4 * g + 3]); tot[4 + g] = (p1[4 * g] * p1[4 * g + 1]) * (p1[4 * g + 2] * p1[4 * g + 3]); }
#pragma unroll
            for (int g = 0; g < 8; ++g) toto[g] = other_half(tot[g], hi);
            float A = carry;
#pragma unroll
            for (int g = 7; g >= 0; --g) {
                const float ag = hi ? A : A * toto[g]; A *= tot[g] * toto[g];
                float e = ag;
                if (g >= 4) { const int r = 4 * (g - 4);
                    const float k3 = p1[r + 3], k2 = p1[r + 2], k1 = p1[r + 1], k0_ = p1[r];
                    p1[r + 3] = (1.0f - k3) * e; e *= k3; p1[r + 2] = (1.0f - k2) * e; e *= k2; p1[r + 1] = (1.0f - k1) * e; e *= k1; p1[r] = (1.0f - k0_) * e;
                } else { const int r = 4 * g;
                    const float k3 = p0[r + 3], k2 = p0[r + 2], k1 = p0[r + 1], k0_ = p0[r];
                    p0[r + 3] = (1.0f - k3) * e; e *= k3; p0[r + 2] = (1.0f - k2) * e; e *= k2; p0[r + 1] = (1.0f - k1) * e; e *= k1; p0[r] = (1.0f - k0_) * e; }
            }
            carry = A;
            u32x4 pw[4]; pack_p(pw, p0, p1);
            pv_tile(o, F.lds + cur + 8192, pw, lane);
        }
        { const unsigned dflag = __all(carry < SB_DEAD_THR) ? 1u : 0u; if (lane == 0) F.MISC[16 + (it & 1) * 8 + wid] = dflag; }
    }
#undef SB_ISSUE
    ATT_WAIT_BAR(0);
    store_o(O + (rowbase + qw0 + r32) * 1024 + h * 64, o, 1.0f, hi);
}

__device__ __forceinline__ float max3f(float a, float b, float c) { float r; asm("v_max3_f32 %0, %1, %2, %3" : "=v"(r) : "v"(a), "v"(b), "v"(c)); return r; }
__device__ __forceinline__ float max2f(float a, float b) { float r; asm("v_max_f32_e32 %0, %1, %2" : "=v"(r) : "v"(a), "v"(b)); return r; }
__device__ __forceinline__ void attn_mla_unit(Frame& F, int b, int h, int qb, const bf16_t* Q, const bf16_t* Kt, const bf16_t* Kpe, const bf16_t* Vt, bf16_t* O) {
    const int lane = F.lane, wid = F.wave, r32 = lane & 31, hi = lane >> 5;
    const int q0 = qb * 256, qw0 = q0 + wid * 32; const size_t rowbase = (size_t)b * SEQ;
    const bf16_t* Qp = Q + (rowbase + qw0 + r32) * 1536 + h * 96;
    bf16x8 qf[6];
#pragma unroll
    for (int d0 = 0; d0 < 6; ++d0) qf[d0] = *(const bf16x8*)(Qp + d0 * 16 + hi * 8);
    const bf16_t* Kg = Kt + rowbase * 1024 + h * 64 + (size_t)lane * 1024 + wid * 8;
    const bf16_t* Kp = Kpe + rowbase * 32 + (size_t)lane * 32 + (wid & 3) * 8;
    const bf16_t* Vg = Vt + rowbase * 1024 + h * 64 + (size_t)(16 * (wid & 3) + (lane >> 2)) * 1024 + (wid >> 2) * 32 + (lane & 3) * 8;
    const bool two = wid < 4; constexpr int SLOT = 20480; const unsigned lds0 = (unsigned)(uintptr_t)F.lds;
    const int NT = 4 * qb + 4;
#define MLA_ISSUE(itx) do { const int kt_ = (itx); const unsigned so_ = (unsigned)__builtin_amdgcn_readfirstlane((int)(lds0 + ((itx) & 3) * SLOT + wid * 1024)); \
        glds16(Kg + (size_t)kt_ * 64 * 1024, so_); if (two) glds16(Kp + (size_t)kt_ * 64 * 32, so_ + 8192); glds16(Vg + (size_t)kt_ * 64 * 1024, so_ + 12288); } while (0)
#define MLA_QK(P0, P1, kt_) do { const int k0_ = (kt_) * 64; const LAS unsigned char* kb = F.lds + ((kt_) & 3) * SLOT + hi * 1024 + r32 * 16; \
        _Pragma("unroll") for (int d0 = 0; d0 < 6; ++d0) { const bf16x8 b0 = *(const LAS bf16x8*)(kb + d0 * 2048), b1 = *(const LAS bf16x8*)(kb + d0 * 2048 + 512); \
            if (d0 == 0) { P0 = MFMA32(b0, qf[0], negm); P1 = MFMA32(b1, qf[0], negm); } else { P0 = MFMA32(b0, qf[d0], P0); P1 = MFMA32(b1, qf[d0], P1); } } \
        if (k0_ + 63 > qw0) { _Pragma("unroll") for (int r = 0; r < 16; ++r) { const int key = k0_ + crow(r, hi); if (key > tq) P0[r] = -INFINITY; if (key + 32 > tq) P1[r] = -INFINITY; } } } while (0)
#define MLA_SM_PV(P0, P1, N0, N1, kt_) do { asm volatile("s_nop 15\n\ts_nop 7" : "+v"(P0), "+v"(P1)); \
        float ma = max3f(P0[0], P0[1], P1[0]), mb = max3f(P0[2], P0[3], P1[1]); ma = max3f(ma, P1[2], P1[3]); \
        _Pragma("unroll") for (int r = 4; r < 16; r += 4) { ma = max3f(ma, P0[r], P0[r + 1]); mb = max3f(mb, P0[r + 2], P0[r + 3]); ma = max3f(ma, P1[r], P1[r + 1]); mb = max3f(mb, P1[r + 2], P1[r + 3]); } \
        float mx = max2f(ma, mb); mx = max2f(mx, other_half(mx, hi)); \
        if (first || __any(mx > 8.0f)) { const float dl = first ? mx : fmaxf(mx, 0.f); const float f = first ? 1.0f : __builtin_amdgcn_exp2f(-dl); first = false; mref += dl; lrun *= f; \
            _Pragma("unroll") for (int r = 0; r < 16; ++r) { P0[r] -= dl; P1[r] -= dl; N0[r] -= dl; N1[r] -= dl; o[0][r] *= f; o[1][r] *= f; negm[r] = -mref; } } \
        float ls0 = 0.f, ls1 = 0.f; \
        _Pragma("unroll") for (int r = 0; r < 16; ++r) { P0[r] = __builtin_amdgcn_exp2f(P0[r]); P1[r] = __builtin_amdgcn_exp2f(P1[r]); ls0 += P0[r]; ls1 += P1[r]; } \
        lrun += ls0 + ls1; u32x4 pw[4]; pack_p(pw, P0, P1); pv_tile(o, F.lds + ((kt_) & 3) * SLOT + 12288, pw, lane); } while (0)
#define MLA_STEP(t_, PA0, PA1, PB0, PB1) do { if ((t_) + 2 < NT) { if (two) ATT_WAIT_BAR(3); else ATT_WAIT_BAR(2); } else ATT_WAIT_BAR(0); \
        if ((t_) + 3 < NT) MLA_ISSUE((t_) + 3); \
        if ((t_) + 1 < nact) { MLA_QK(PB0, PB1, (t_) + 1); } \
        if ((t_) < nact) { MLA_SM_PV(PA0, PA1, PB0, PB1, (t_)); } } while (0)
    MLA_ISSUE(0); MLA_ISSUE(1); MLA_ISSUE(2);
    f32x16 o[2]; o[0] = (f32x16){}; o[1] = (f32x16){}; float mref = 0.f, lrun = 0.f; f32x16 negm = (f32x16){};
    const int tq = qw0 + r32; bool first = true; f32x16 pa0, pa1, pb0 = (f32x16){}, pb1 = (f32x16){};
    const int nact = (qw0 + 31) / 64 + 1;
    if (two) ATT_WAIT_BAR(6); else ATT_WAIT_BAR(4);
    MLA_QK(pa0, pa1, 0);
    for (int kt = 0; kt < NT; kt += 2) { MLA_STEP(kt, pa0, pa1, pb0, pb1); MLA_STEP(kt + 1, pb0, pb1, pa0, pa1); }
#undef MLA_ISSUE
#undef MLA_QK
#undef MLA_SM_PV
#undef MLA_STEP
    ATT_WAIT_BAR(0);
    const float ltot = lrun + other_half(lrun, hi);
    store_o(O + (rowbase + qw0 + r32) * 1024 + h * 64, o, __builtin_amdgcn_rcpf(ltot), hi);
}

namespace rw {
constexpr int RM = 136;
constexpr int L_AT = 0, L_RT = 8704, L_BT = 17408, L_KT = 26112, L_Q = 34816, L_PK0 = 43520, L_PK1 = 52224, L_T = 60928;
constexpr int L_N = L_AT, L_M = L_BT, L_P = L_KT;
constexpr int L_ATV = 69632, L_VV = 77824, L_BHV = 86016, L_KHV = 94208;
constexpr int L_LW = 102400, L_GT = 118784, L_WC = 120832;
static_assert(L_WC + 256 <= RING_BYTES, "rwkv chunk LDS map");
constexpr size_t CH_G = 0, CH_H = 8192, CH_RF = 24576, CH_YF = 32768, CH_ZF = 40960, CH_BYTES = 49152;
#define RW_BAR() asm volatile("s_waitcnt vmcnt(0) lgkmcnt(0)\n\ts_barrier" ::: "memory")

__device__ __forceinline__ bf16x8 frag_rm(const LAS unsigned char* img, int row, int s4, int hi) {
    const LAS unsigned char* p = img + row * RM + s4 * 32 + hi * 8;
    const u32x2 a = *(const LAS u32x2*)p, b = *(const LAS u32x2*)(p + 16);
    return __builtin_bit_cast(bf16x8, (u32x4){a.x, a.y, b.x, b.y});
}
__device__ __forceinline__ bf16x8 frag_vi(const LAS unsigned char* img, int cb, int s4, int lane) {
    const int hi = lane >> 5; const LAS unsigned char* vb = img + ((lane >> 4) & 1) * 32 + (lane & 3) * 8 + (4 * hi + ((lane & 15) >> 2)) * 64 + cb * 4096 + s4 * 1024;
    const s16x4 lo = vtr(vb), hh = vtr(vb + 512); return (bf16x8){lo[0], lo[1], lo[2], lo[3], hh[0], hh[1], hh[2], hh[3]};
}
template <int HALF> __device__ __forceinline__ bf16x8 frag_acc(const f32x16& t) {
    const u32x4 w = (u32x4){cvt_pk_bf16(t[8 * HALF + 0], t[8 * HALF + 1]), cvt_pk_bf16(t[8 * HALF + 2], t[8 * HALF + 3]), cvt_pk_bf16(t[8 * HALF + 4], t[8 * HALF + 5]), cvt_pk_bf16(t[8 * HALF + 6], t[8 * HALF + 7])};
    return __builtin_bit_cast(bf16x8, w);
}
__device__ __forceinline__ void frags_of(bf16x8 (&f)[4], const f32x16 (&X)[2]) { f[0] = frag_acc<0>(X[0]); f[1] = frag_acc<1>(X[0]); f[2] = frag_acc<0>(X[1]); f[3] = frag_acc<1>(X[1]); }
__device__ __forceinline__ void tile_to_rm(LAS unsigned char* img, const f32x16& t, int mb, int nb, int r32, int hi) {
#pragma unroll
    for (int r = 0; r < 16; ++r) *(LAS bf16_t*)(img + (32 * mb + crow(r, hi)) * RM + (32 * nb + r32) * 2) = (bf16_t)f2bf(t[r]);
}

struct ChunkIn { u32x4 r, k, v, vf, gt; f32x4 a0, a1, l0, l1; };
struct ChunkPar { f32x4 p0[2], p1[2], p2[2]; };
__device__ __forceinline__ void chunk_par(Frame& F, int l, int cidx, ChunkPar& cp) {
    const int h = (cidx >> 6) & 15, gch = h * 64 + (F.tid & 7) * 8;
    { const f32x4* p = (const f32x4*)((const float*)ARGP(10) + l * 1024 + gch); cp.p0[0] = p[0]; cp.p0[1] = p[1]; }
    { const f32x4* p = (const f32x4*)((const float*)ARGP(11) + l * 1024 + gch); cp.p1[0] = p[0]; cp.p1[1] = p[1]; }
    { const f32x4* p = (const f32x4*)((const float*)ARGP(12) + l * 1024 + gch); cp.p2[0] = p[0]; cp.p2[1] = p[1]; }
}
__device__ __forceinline__ void chunk_fetch(Frame& F, int l, int cidx, ChunkIn& in) {
    const int tid = F.tid, bh = cidx >> 6, c = cidx & 63, b = bh >> 4, h = bh & 15, t = tid >> 3, cg = tid & 7, gch = h * 64 + cg * 8; const size_t row = (size_t)b * SEQ + c * 64 + t;
    const bf16_t* RK = (const bf16_t*)(F.ws + WS_RK); const bf16_t* VS = (const bf16_t*)(F.ws + WS_VS) + (size_t)l * T * 1024;
    in.r = *(const u32x4*)(RK + row * 2048 + gch); in.k = *(const u32x4*)(RK + row * 2048 + 1024 + gch); in.v = *(const u32x4*)(VS + row * 1024 + gch);
    if (l > 0) { in.vf = *(const u32x4*)((const bf16_t*)(F.ws + WS_VS) + row * 1024 + gch); in.gt = *(const u32x4*)((const bf16_t*)(F.ws + WS_VGATE) + row * 1024 + gch); }
    else { in.vf = in.v; in.gt = in.v; }
    const f32x4* pa = (const f32x4*)((const float*)(F.ws + WS_AIC) + row * 1024 + gch); in.a0 = pa[0]; in.a1 = pa[1];
    const f32x4* pl = (const f32x4*)((const float*)(F.ws + WS_LOGDEC) + row * 1024 + gch); in.l0 = pl[0]; in.l1 = pl[1];
}
__device__ __forceinline__ void chunk_unit(Frame& F, int l, int cidx, const ChunkIn& in, const ChunkPar& cp) {
    const int tid = F.tid, lane = F.lane, w = F.wave, r32 = lane & 31, hi = lane >> 5;
    const int bh = cidx >> 6, c = cidx & 63, b = bh >> 4, h = bh & 15;
    LAS unsigned char* L = F.lds;
    unsigned char* gs = F.ws + WS_RWS + (size_t)cidx * CH_BYTES;
    {
        const int t = tid >> 3, cg = tid & 7, ch0 = cg * 8, gch = h * 64 + ch0; const size_t row = (size_t)b * SEQ + c * 64 + t;
        float r[8], k[8], v[8], aa[8], ld[8], kc[8];
        unpack8(in.r, r); unpack8(in.k, k); unpack8(in.v, v);
        if (l > 0) { float vf[8], gt[8]; unpack8(in.vf, vf); unpack8(in.gt, gt);
#pragma unroll
            for (int i = 0; i < 8; ++i) v[i] = v[i] + (vf[i] - v[i]) * gt[i]; }
#pragma unroll
        for (int i = 0; i < 4; ++i) { aa[i] = in.a0[i]; aa[4 + i] = in.a1[i]; ld[i] = in.l0[i]; ld[4 + i] = in.l1[i]; }
        float kk[8], kmod[8]; float n2 = 0.f, bc = 0.f;
        { const f32x4 c0 = cp.p0[0], c1 = cp.p0[1];
#pragma unroll
          for (int i = 0; i < 4; ++i) { kc[i] = c0[i]; kc[4 + i] = c1[i]; } }
#pragma unroll
        for (int i = 0; i < 8; ++i) { kk[i] = k[i] * kc[i]; n2 += kk[i] * kk[i]; }
        { const f32x4 c0 = cp.p1[0], c1 = cp.p1[1];
#pragma unroll
          for (int i = 0; i < 4; ++i) { kc[i] = c0[i]; kc[4 + i] = c1[i]; } }
#pragma unroll
        for (int i = 0; i < 8; ++i) kmod[i] = k[i] * (1.0f + (aa[i] - 1.0f) * kc[i]);
        { const f32x4 c0 = cp.p2[0], c1 = cp.p2[1];
#pragma unroll
          for (int i = 0; i < 4; ++i) { kc[i] = c0[i]; kc[4 + i] = c1[i]; } }
#pragma unroll
        for (int i = 0; i < 8; ++i) bc += r[i] * kmod[i] * kc[i];
        n2 = sum8(n2); bc = sum8(bc);
        const float inv = 1.0f / fmaxf(sqrtf(n2), 1e-12f);
        if (cg == 0) ((float*)(F.ws + WS_BC))[row * 16 + h] = bc;
        store8f((bf16_t*)(F.ws + WS_VMIX) + row * 1024 + gch, v);
        LAS float* LW = (LAS float*)(L + L_LW); LAS float* GT = (LAS float*)(L + L_GT);
#pragma unroll
        for (int i = 0; i < 8; ++i) LW[t * 64 + ch0 + i] = ld[i];
        RW_BAR();
        { const int ch = tid & 63, tq = tid >> 6; float run = 0.f;
#pragma unroll
          for (int i = 0; i < 8; ++i) { run += LW[(8 * tq + i) * 64 + ch]; LW[(8 * tq + i) * 64 + ch] = run; }
          GT[tq * 64 + ch] = run; }
        RW_BAR();
        float lc[8], tot[8];
#pragma unroll
        for (int i = 0; i < 8; ++i) { lc[i] = LW[t * 64 + ch0 + i]; tot[i] = 0.f; }
#pragma unroll
        for (int q = 0; q < 8; ++q) {
#pragma unroll
            for (int i = 0; i < 8; ++i) { const float g = GT[q * 64 + ch0 + i]; tot[i] += g; if (q < (t >> 3)) lc[i] += g; } }
        float At[8], Rt[8], Bt[8], Kt[8], Bh[8], Kh[8];
#pragma unroll
        for (int i = 0; i < 8; ++i) { const float wi = __expf(lc[i]), we = __expf(lc[i] - ld[i]), wn = __expf(-lc[i]), wr = __expf(tot[i] - lc[i]);
            const float ap = -kk[i] * inv, bp = kk[i] * inv * aa[i];
            At[i] = ap * we; Rt[i] = r[i] * wi; Bt[i] = bp * wn; Kt[i] = kmod[i] * wn; Bh[i] = bp * wr; Kh[i] = kmod[i] * wr; }
        const int rmo = t * RM + cg * 16, vio = ((cg >> 2) * 4 + (t >> 4)) * 1024 + (t & 15) * 64 + (cg & 3) * 16;
        { u32x4 x;
          x = (u32x4){pk2(At[0], At[1]), pk2(At[2], At[3]), pk2(At[4], At[5]), pk2(At[6], At[7])}; *(LAS u32x2*)(L + L_AT + rmo) = (u32x2){x.x, x.y}; *(LAS u32x2*)(L + L_AT + rmo + 8) = (u32x2){x.z, x.w}; *(LAS u32x4*)(L + L_ATV + vio) = x;
          x = (u32x4){pk2(Rt[0], Rt[1]), pk2(Rt[2], Rt[3]), pk2(Rt[4], Rt[5]), pk2(Rt[6], Rt[7])}; *(LAS u32x2*)(L + L_RT + rmo) = (u32x2){x.x, x.y}; *(LAS u32x2*)(L + L_RT + rmo + 8) = (u32x2){x.z, x.w};
          x = (u32x4){pk2(Bt[0], Bt[1]), pk2(Bt[2], Bt[3]), pk2(Bt[4], Bt[5]), pk2(Bt[6], Bt[7])}; *(LAS u32x2*)(L + L_BT + rmo) = (u32x2){x.x, x.y}; *(LAS u32x2*)(L + L_BT + rmo + 8) = (u32x2){x.z, x.w};
          x = (u32x4){pk2(Kt[0], Kt[1]), pk2(Kt[2], Kt[3]), pk2(Kt[4], Kt[5]), pk2(Kt[6], Kt[7])}; *(LAS u32x2*)(L + L_KT + rmo) = (u32x2){x.x, x.y}; *(LAS u32x2*)(L + L_KT + rmo + 8) = (u32x2){x.z, x.w};
          x = (u32x4){pk2(v[0], v[1]), pk2(v[2], v[3]), pk2(v[4], v[5]), pk2(v[6], v[7])}; *(LAS u32x4*)(L + L_VV + vio) = x;
          x = (u32x4){pk2(Bh[0], Bh[1]), pk2(Bh[2], Bh[3]), pk2(Bh[4], Bh[5]), pk2(Bh[6], Bh[7])}; *(LAS u32x4*)(L + L_BHV + vio) = x;
          x = (u32x4){pk2(Kh[0], Kh[1]), pk2(Kh[2], Kh[3]), pk2(Kh[4], Kh[5]), pk2(Kh[6], Kh[7])}; *(LAS u32x4*)(L + L_KHV + vio) = x; }
        if (t == 0) { LAS float* WC = (LAS float*)(L + L_WC);
#pragma unroll
            for (int i = 0; i < 8; ++i) WC[ch0 + i] = __expf(tot[i]); }
        RW_BAR();
    }
#ifndef RWDBG
#define RWDBG 9
#endif
    if (RWDBG < 1) return;
    __builtin_amdgcn_sched_barrier(0);
    f32x16 X0[2];
    { const int mat = w >> 1, nb = w & 1; const LAS unsigned char* Ai = L + ((mat < 2) ? L_AT : L_RT); const LAS unsigned char* Bi = L + ((mat & 1) ? L_KT : L_BT);
      X0[0] = (f32x16){}; X0[1] = (f32x16){};
#pragma unroll
      for (int s4 = 0; s4 < 4; ++s4) { const bf16x8 bf = frag_rm(Bi, 32 * nb + r32, s4, hi);
#pragma unroll
          for (int mb = 0; mb < 2; ++mb) X0[mb] = MFMA32(frag_rm(Ai, 32 * mb + r32, s4, hi), bf, X0[mb]); __builtin_amdgcn_sched_barrier(0); }
      const int scol = 32 * nb + r32;
#pragma unroll
      for (int mb = 0; mb < 2; ++mb)
#pragma unroll
          for (int r = 0; r < 16; ++r) { const int trow = 32 * mb + crow(r, hi); const bool keep = (mat < 2) ? (scol < trow) : (scol <= trow); X0[mb][r] = keep ? X0[mb][r] : 0.f; }
      RW_BAR();
      LAS unsigned char* Oi = L + (mat == 0 ? L_N : mat == 1 ? L_M : mat == 2 ? L_P : L_Q);
      tile_to_rm(Oi, X0[0], 0, nb, r32, hi); tile_to_rm(Oi, X0[1], 1, nb, r32, hi);
      RW_BAR(); }
    if (RWDBG < 2) return;
    if (w < 2 && RWDBG != 3 && RWDBG != 4) {
        f32x16 P = (w == 0) ? X0[0] : X0[1]; f32x16 Tt = P;
#pragma unroll
        for (int r = 0; r < 16; ++r) if (crow(r, hi) == r32) Tt[r] += 1.0f;
        LAS unsigned char* own = L + (w == 0 ? L_PK0 : L_PK1);
#pragma unroll
        for (int k = 0; k < 5; ++k) {
            const LAS unsigned char* Ai = (k == 0) ? (const LAS unsigned char*)(L + L_N) : (const LAS unsigned char*)own;
            const bf16x8 bP0 = frag_acc<0>(P), bP1 = frag_acc<1>(P), bT0 = frag_acc<0>(Tt), bT1 = frag_acc<1>(Tt);
            const bf16x8 af0 = frag_rm(Ai, 32 * w + r32, 2 * w, hi), af1 = frag_rm(Ai, 32 * w + r32, 2 * w + 1, hi);
            if (k > 0) { Tt = MFMA32(af0, bT0, Tt); Tt = MFMA32(af1, bT1, Tt); }
            if (k < 4) { f32x16 nP = MFMA32(af0, bP0, (f32x16){}); nP = MFMA32(af1, bP1, nP); P = nP; tile_to_rm(own, P, w, w, r32, hi); }
            __builtin_amdgcn_sched_barrier(0);
        }
        f32x16 Y = (f32x16){};
        if (w == 0) { Y = MFMA32(frag_rm(L + L_N, 32 + r32, 0, hi), frag_acc<0>(Tt), Y); Y = MFMA32(frag_rm(L + L_N, 32 + r32, 1, hi), frag_acc<1>(Tt), Y); tile_to_rm(L + L_T, Tt, 0, 0, r32, hi); }
        else { tile_to_rm(L + L_T, Tt, 1, 1, r32, hi); const f32x16 zt = (f32x16){}; tile_to_rm(L + L_T, zt, 0, 1, r32, hi); }
        RW_BAR();
        if (w == 0) { f32x16 T21 = MFMA32(frag_rm(L + L_T, 32 + r32, 2, hi), frag_acc<0>(Y), (f32x16){}); T21 = MFMA32(frag_rm(L + L_T, 32 + r32, 3, hi), frag_acc<1>(Y), T21); tile_to_rm(L + L_T, T21, 1, 0, r32, hi); }
        RW_BAR();
        RW_BAR();
    } else if (w < 4 && RWDBG != 2 && RWDBG != 4) {
        const int ib = w - 2; f32x16 MV[2], Y[2], Hh[2];
        MV[0] = (f32x16){}; MV[1] = (f32x16){}; Y[0] = (f32x16){}; Y[1] = (f32x16){}; Hh[0] = (f32x16){}; Hh[1] = (f32x16){};
#pragma unroll
        for (int s4 = 0; s4 < 4; ++s4) { const bf16x8 vf = frag_vi(L + L_VV, ib, s4, lane);
#pragma unroll
            for (int q = 0; q < 2; ++q) { MV[q] = MFMA32(frag_rm(L + L_M, 32 * q + r32, s4, hi), vf, MV[q]);
                Y[q] = MFMA32(vf, frag_rm(L + L_Q, 32 * q + r32, s4, hi), Y[q]);
                Hh[q] = MFMA32(frag_vi(L + L_KHV, q, s4, lane), vf, Hh[q]); __builtin_amdgcn_sched_barrier(0); } }
        RW_BAR(); RW_BAR();
        f32x16 U0[2]; U0[0] = (f32x16){}; U0[1] = (f32x16){};
        { bf16x8 bm[4]; frags_of(bm, MV);
#pragma unroll
          for (int s4 = 0; s4 < 4; ++s4)
#pragma unroll
              for (int mb = 0; mb < 2; ++mb) { U0[mb] = MFMA32(frag_rm(L + L_T, 32 * mb + r32, s4, hi), bm[s4], U0[mb]); __builtin_amdgcn_sched_barrier(0); } }
        { bf16x8 bu[4]; frags_of(bu, U0);
#pragma unroll
          for (int s4 = 0; s4 < 4; ++s4)
#pragma unroll
              for (int q = 0; q < 2; ++q) { Y[q] = MFMA32(bu[s4], frag_rm(L + L_P, 32 * q + r32, s4, hi), Y[q]); Hh[q] = MFMA32(frag_vi(L + L_BHV, q, s4, lane), bu[s4], Hh[q]); __builtin_amdgcn_sched_barrier(0); } }
        unsigned* yf = (unsigned*)(gs + CH_YF); float* hf = (float*)(gs + CH_H);
#pragma unroll
        for (int tb = 0; tb < 2; ++tb)
#pragma unroll
            for (int q = 0; q < 8; ++q) { yf[((ib * 2 + tb) * 8 + q) * 64 + lane] = cvt_pk_bf16(Y[tb][2 * q], Y[tb][2 * q + 1]); if ((q & 3) == 3) __builtin_amdgcn_sched_barrier(0); }
#pragma unroll
        for (int jb = 0; jb < 2; ++jb)
#pragma unroll
            for (int r = 0; r < 16; ++r) { hf[((jb * 2 + ib) * 16 + r) * 64 + lane] = Hh[jb][r]; if ((r & 3) == 3) __builtin_amdgcn_sched_barrier(0); }
        RW_BAR();
    } else if (w < 6 && RWDBG != 2 && RWDBG != 3) {
        const int jc = w - 4;
        RW_BAR(); RW_BAR();
        f32x16 A2[2]; A2[0] = (f32x16){}; A2[1] = (f32x16){};
#pragma unroll
        for (int s4 = 0; s4 < 4; ++s4) { const bf16x8 af = frag_vi(L + L_ATV, jc, s4, lane);
#pragma unroll
            for (int mb = 0; mb < 2; ++mb) { A2[mb] = MFMA32(frag_rm(L + L_T, 32 * mb + r32, s4, hi), af, A2[mb]); __builtin_amdgcn_sched_barrier(0); } }
        bf16x8 ba[4]; frags_of(ba, A2);
        f32x16 R2[2], Gt[2]; R2[0] = (f32x16){}; R2[1] = (f32x16){}; Gt[0] = (f32x16){}; Gt[1] = (f32x16){};
#pragma unroll
        for (int s4 = 0; s4 < 4; ++s4)
#pragma unroll
            for (int q = 0; q < 2; ++q) { R2[q] = MFMA32(ba[s4], frag_rm(L + L_P, 32 * q + r32, s4, hi), R2[q]); Gt[q] = MFMA32(frag_vi(L + L_BHV, q, s4, lane), ba[s4], Gt[q]); __builtin_amdgcn_sched_barrier(0); }
#pragma unroll
        for (int tb = 0; tb < 2; ++tb)
#pragma unroll
            for (int rg = 0; rg < 4; ++rg) { const u32x2 x = *(const LAS u32x2*)(L + L_RT + (32 * tb + r32) * RM + (32 * jc + 8 * rg + 4 * hi) * 2);
                R2[tb][4 * rg] += bflo(x.x); R2[tb][4 * rg + 1] += bfhi(x.x); R2[tb][4 * rg + 2] += bflo(x.y); R2[tb][4 * rg + 3] += bfhi(x.y); }
        { const LAS float* WC = (const LAS float*)(L + L_WC);
#pragma unroll
          for (int r = 0; r < 16; ++r) if (crow(r, hi) == r32) Gt[jc][r] += WC[32 * jc + r32]; }
        u32x4* rf = (u32x4*)(gs + CH_RF);
#pragma unroll
        for (int tb = 0; tb < 2; ++tb) { rf[(tb * 4 + 2 * jc) * 64 + lane] = __builtin_bit_cast(u32x4, frag_acc<0>(R2[tb])); rf[(tb * 4 + 2 * jc + 1) * 64 + lane] = __builtin_bit_cast(u32x4, frag_acc<1>(R2[tb])); }
        bf16_t* gg = (bf16_t*)(gs + CH_G);
#pragma unroll
        for (int jb = 0; jb < 2; ++jb)
#pragma unroll
            for (int r = 0; r < 16; ++r) { gg[(32 * jb + crow(r, hi)) * 64 + 32 * jc + r32] = (bf16_t)f2bf(Gt[jb][r]); if ((r & 3) == 3) __builtin_amdgcn_sched_barrier(0); }
        RW_BAR();
    } else {
        RW_BAR(); RW_BAR(); RW_BAR();
    }
}

__device__ __forceinline__ void chain_wave(Frame& F, int bh) {
    const int lane = F.lane, r32 = lane & 31, hi = lane >> 5;
    f32x16 Z[2][2];
#pragma unroll
    for (int a = 0; a < 2; ++a)
#pragma unroll
        for (int bq = 0; bq < 2; ++bq) Z[a][bq] = (f32x16){};
    for (int c = 0; c < 64; ++c) {
        unsigned char* gs = F.ws + WS_RWS + (size_t)(bh * 64 + c) * CH_BYTES;
        bf16x8 zf[2][4];
#pragma unroll
        for (int ib = 0; ib < 2; ++ib) { zf[ib][0] = frag_acc<0>(Z[0][ib]); zf[ib][1] = frag_acc<1>(Z[0][ib]); zf[ib][2] = frag_acc<0>(Z[1][ib]); zf[ib][3] = frag_acc<1>(Z[1][ib]); }
        u32x4* zo = (u32x4*)(gs + CH_ZF);
#pragma unroll
        for (int ib = 0; ib < 2; ++ib)
#pragma unroll
            for (int s4 = 0; s4 < 4; ++s4) zo[(ib * 4 + s4) * 64 + lane] = __builtin_bit_cast(u32x4, zf[ib][s4]);
        if (c == 63) break;
        const float* hf = (const float*)(gs + CH_H); const bf16_t* gg = (const bf16_t*)(gs + CH_G);
        f32x16 Zn[2][2];
#pragma unroll
        for (int jb = 0; jb < 2; ++jb)
#pragma unroll
            for (int ib = 0; ib < 2; ++ib)
#pragma unroll
                for (int r = 0; r < 16; ++r) Zn[jb][ib][r] = hf[((jb * 2 + ib) * 16 + r) * 64 + lane];
#pragma unroll
        for (int jb = 0; jb < 2; ++jb)
#pragma unroll
            for (int s4 = 0; s4 < 4; ++s4) { const bf16_t* p = gg + (32 * jb + r32) * 64 + 16 * s4 + 4 * hi; const u32x2 a = *(const u32x2*)p, bb = *(const u32x2*)(p + 8);
                const bf16x8 gf = __builtin_bit_cast(bf16x8, (u32x4){a.x, a.y, bb.x, bb.y});
#pragma unroll
                for (int ib = 0; ib < 2; ++ib) Zn[jb][ib] = MFMA32(gf, zf[ib][s4], Zn[jb][ib]); }
#pragma unroll
        for (int jb = 0; jb < 2; ++jb)
#pragma unroll
            for (int ib = 0; ib < 2; ++ib) Z[jb][ib] = Zn[jb][ib];
    }
}

__device__ __forceinline__ void out_wave(Frame& F, int l, int cidx) {
    const int lane = F.lane, r32 = lane & 31, hi = lane >> 5; const int bh = cidx >> 6, c = cidx & 63, b = bh >> 4, h = bh & 15;
    const unsigned char* gs = F.ws + WS_RWS + (size_t)cidx * CH_BYTES;
    const unsigned* yf = (const unsigned*)(gs + CH_YF); const u32x4* zf = (const u32x4*)(gs + CH_ZF); const u32x4* rf = (const u32x4*)(gs + CH_RF);
    f32x16 Y[2][2];
#pragma unroll
    for (int ib = 0; ib < 2; ++ib)
#pragma unroll
        for (int tb = 0; tb < 2; ++tb)
#pragma unroll
            for (int q = 0; q < 8; ++q) { const unsigned x = yf[((ib * 2 + tb) * 8 + q) * 64 + lane]; Y[ib][tb][2 * q] = bflo(x); Y[ib][tb][2 * q + 1] = bfhi(x); }
#pragma unroll
    for (int s4 = 0; s4 < 4; ++s4) { bf16x8 za[2], rb[2];
#pragma unroll
        for (int q = 0; q < 2; ++q) { za[q] = __builtin_bit_cast(bf16x8, zf[(q * 4 + s4) * 64 + lane]); rb[q] = __builtin_bit_cast(bf16x8, rf[(q * 4 + s4) * 64 + lane]); }
#pragma unroll
        for (int ib = 0; ib < 2; ++ib)
#pragma unroll
            for (int tb = 0; tb < 2; ++tb) Y[ib][tb] = MFMA32(za[ib], rb[tb], Y[ib][tb]); }
    const float* lng = (const float*)ARGP(13) + l * 1024 + h * 64; const float* lnb = (const float*)ARGP(14) + l * 1024 + h * 64;
    const bf16_t* VM = (const bf16_t*)(F.ws + WS_VMIX); const bf16_t* GO = (const bf16_t*)(F.ws + WS_GOUT); const float* BC = (const float*)(F.ws + WS_BC);
    bf16_t* O = (bf16_t*)(F.ws + WS_OALL) + (size_t)1 * T * 1024;
#pragma unroll
    for (int tb = 0; tb < 2; ++tb) { const size_t row = (size_t)b * SEQ + c * 64 + 32 * tb + r32;
        float sm = 0.f;
#pragma unroll
        for (int ib = 0; ib < 2; ++ib)
#pragma unroll
            for (int r = 0; r < 16; ++r) sm += Y[ib][tb][r];
        sm += other_half(sm, hi); const float mean = sm * (1.f / 64.f);
        float sq = 0.f;
#pragma unroll
        for (int ib = 0; ib < 2; ++ib)
#pragma unroll
            for (int r = 0; r < 16; ++r) { const float d = Y[ib][tb][r] - mean; sq += d * d; }
        sq += other_half(sq, hi); const float rstd = rsqrtf(sq * (1.f / 64.f) + GN_EPS);
        const float bcv = BC[row * 16 + h];
#pragma unroll
        for (int ib = 0; ib < 2; ++ib) {
            u32x2 vvr[4], gor[4]; f32x4 gln[4], bln[4];
#pragma unroll
            for (int rg = 0; rg < 4; ++rg) { const int i0 = 32 * ib + 8 * rg + 4 * hi; vvr[rg] = *(const u32x2*)(VM + row * 1024 + h * 64 + i0); gor[rg] = *(const u32x2*)(GO + row * 1024 + h * 64 + i0);
                gln[rg] = *(const f32x4*)(lng + i0); bln[rg] = *(const f32x4*)(lnb + i0); }
#pragma unroll
            for (int rg = 0; rg < 4; ++rg) { const int i0 = 32 * ib + 8 * rg + 4 * hi;
                const f32x4 vv = (f32x4){bflo(vvr[rg].x), bfhi(vvr[rg].x), bflo(vvr[rg].y), bfhi(vvr[rg].y)}, go = (f32x4){bflo(gor[rg].x), bfhi(gor[rg].x), bflo(gor[rg].y), bfhi(gor[rg].y)};
                f32x4 o;
#pragma unroll
                for (int e = 0; e < 4; ++e) o[e] = ((Y[ib][tb][4 * rg + e] - mean) * rstd * gln[rg][e] + bln[rg][e] + bcv * vv[e]) * go[e];
                store4_bf16(O + row * 1024 + h * 64 + i0, o); }
            asm volatile("" ::: "memory"); } }
}
}


#ifndef DUP_MIX
#define DUP_MIX 0
#endif
__device__ __forceinline__ void unit_pop(Frame& F, unsigned* qhead, int& idx) {
    if (F.tid == 0) F.MISC[0] = __hip_atomic_fetch_add(qhead, 1u, RLX_AGENT);
    __syncthreads(); idx = (int)F.MISC[0]; __syncthreads();
    { int t_ = F.tid; asm volatile("" : "+v"(t_)); F.tid = t_; F.lane = t_ & 63; F.wave = __builtin_amdgcn_readfirstlane(t_ >> 6); }
}
__device__ __forceinline__ void phase_mix_a(Frame& F, int l, int rep) {
    const int nch = (4096 - F.vcu + F.G - 1) / F.G, nec = 0;
    rw::ChunkIn nx; if (nch > 0) rw::chunk_fetch(F, l, F.vcu, nx);
    int je = 0;
#pragma unroll 1
    for (int j = 0; j < nch; ++j) {
        { int t_ = F.tid; asm volatile("" : "+v"(t_)); F.tid = t_; F.lane = t_ & 63; F.wave = __builtin_amdgcn_readfirstlane(t_ >> 6); }
        const rw::ChunkIn cu = nx;
        rw::ChunkPar cp; rw::chunk_par(F, l, F.vcu + j * F.G, cp);
        if (j + 1 < nch) rw::chunk_fetch(F, l, F.vcu + (j + 1) * F.G, nx);
        if (rep == 0 || (DUP_MIX & 1)) rw::chunk_unit(F, l, F.vcu + j * F.G, cu, cp);
        __syncthreads();
        if (((j + F.vcu) & 3) == 3 && je < nec) { if (rep == 0 || (DUP_MIX & 8)) { EcDesc fn{F.ws, l}; run_panels(F, 6 * (F.vcu + je * F.G), 6, 1, fn); } ++je; __syncthreads(); }
    }
#pragma unroll 1
    for (; je < nec; ++je) { if (rep == 0 || (DUP_MIX & 8)) { EcDesc fn{F.ws, l}; run_panels(F, 6 * (F.vcu + je * F.G), 6, 1, fn); } __syncthreads(); }
}
__device__ __forceinline__ void phase_mix_b(Frame& F, int l, int rep) {
    unsigned* qhead = F.ctl + CW_QHEAD + 64 * l + 16 * rep + 8;
    const bf16_t* PROJ = (const bf16_t*)(F.ws + WS_PROJ); bf16_t* OALL = (bf16_t*)(F.ws + WS_OALL);
    for (;;) { int idx; unit_pop(F, qhead, idx);
        if (idx >= 64 + 3072) break;
        if (idx < 64) { if ((rep == 0 || (DUP_MIX & 16)) && F.wave == 0) rw::chain_wave(F, idx); }
        else { const int kq = idx - 64;
            if (kq % 3 == 2) { if (rep == 0 || (DUP_MIX & 8)) { EcDesc fn{F.ws, l}; run_panels(F, 6 * (kq / 3), 6, 1, fn); } }
            else { const int k = (kq / 3) * 2 + kq % 3, qb = 15 - (k >> 7), kk = k & 127, bh = kk >> 1;
                if (kk & 1) { if (rep == 0 || (DUP_MIX & 2)) attn_sb_unit(F, bh >> 4, bh & 15, qb, PROJ, OALL); }
                else { if (rep == 0 || (DUP_MIX & 4)) attn_mla_unit(F, bh >> 4, bh & 15, qb, (const bf16_t*)(F.ws + WS_QMLA), (const bf16_t*)(F.ws + WS_KMLA), (const bf16_t*)(F.ws + WS_KPE), (const bf16_t*)(F.ws + WS_VMLA), OALL + (size_t)2 * T * 1024); } } }
        __syncthreads();
    }
}

__device__ __forceinline__ void phase_select(Frame& F, int l) {
    const float* lgp = (const float*)(F.ws + WS_LGP); const float* rgb = (const float*)ARGP(28) + l * 8; const float* reb = (const float*)ARGP(30) + l * 64;
    int* toke = (int*)(F.ws + WS_TOKE); float* tokw = (float*)(F.ws + WS_TOKW); unsigned* cnt = F.ctl + CW_CNT + 64 * l;
    for (int t = F.gw * 64 + F.lane; t < T; t += F.NGW * 64) {
        float gl[8]; int grp = 0; float gmax;
        { f32x4 a0 = (f32x4){0.f, 0.f, 0.f, 0.f}, a1 = a0;
#pragma unroll
          for (int z = 0; z < 4; ++z) { const f32x4* p = (const f32x4*)(lgp + ((size_t)z * T + t) * 96); a0 += p[0]; a1 += p[1]; }
#pragma unroll
          for (int i = 0; i < 4; ++i) { gl[i] = a0[i] + rgb[i]; gl[4 + i] = a1[i] + rgb[4 + i]; } }
        gmax = gl[0];
#pragma unroll
        for (int i = 1; i < 8; ++i) if (gl[i] > gmax) { gmax = gl[i]; grp = i; }
        float gs = 0.f;
#pragma unroll
        for (int i = 0; i < 8; ++i) gs += __expf(gl[i] - gmax);
        const float pgrp = 1.0f / gs;
        float el[8];
        { f32x4 a0 = (f32x4){0.f, 0.f, 0.f, 0.f}, a1 = a0;
#pragma unroll
          for (int z = 0; z < 4; ++z) { const f32x4* p = (const f32x4*)(lgp + ((size_t)z * T + t) * 96 + 8 + grp * 8); a0 += p[0]; a1 += p[1]; }
#pragma unroll
          for (int i = 0; i < 4; ++i) { el[i] = a0[i] + reb[grp * 8 + i]; el[4 + i] = a1[i] + reb[grp * 8 + 4 + i]; } }
        int i0 = 0; float m0 = el[0];
#pragma unroll
        for (int i = 1; i < 8; ++i) if (el[i] > m0) { m0 = el[i]; i0 = i; }
        int i1 = -1; float m1 = -INFINITY;
#pragma unroll
        for (int i = 0; i < 8; ++i) if (i != i0 && el[i] > m1) { m1 = el[i]; i1 = i; }
        const float e1 = __expf(m1 - m0); const float w0 = pgrp / (1.0f + e1), w1 = pgrp * e1 / (1.0f + e1);
        const int ex0 = grp * 8 + i0, ex1 = grp * 8 + i1;
        toke[2 * t] = ex0; toke[2 * t + 1] = ex1; tokw[2 * t] = w0; tokw[2 * t + 1] = w1;
        __hip_atomic_fetch_add(cnt + ex0, 1u, RLX_AGENT); __hip_atomic_fetch_add(cnt + ex1, 1u, RLX_AGENT);
    }
}

__device__ __forceinline__ void phase_scatter(Frame& F, int l) {
    unsigned* cnt = F.ctl + CW_CNT + 64 * l; unsigned* curs = F.ctl + CW_CUR + 64 * l;
    LAS int* pst = (LAS int*)F.lds; int* blke = (int*)(F.ws + WS_BLKE);
    if (F.tid < 64) pst[64 + F.tid] = (int)((__hip_atomic_load(cnt + F.tid, RLX_AGENT) + 255u) & ~255u);
    __syncthreads();
    if (F.tid == 0) { int acc = 0;
        for (int e = 0; e < 64; ++e) { const int pd = pst[64 + e]; pst[e] = acc;
            if (blockIdx.x == 0) for (int q = 0; q < pd / 256; ++q) blke[1 + acc / 256 + q] = e;
            acc += pd; }
        if (blockIdx.x == 0) blke[0] = acc / 256; }
    __syncthreads();
    const int* toke = (const int*)(F.ws + WS_TOKE); int* pos = (int*)(F.ws + WS_POS); int* rowtok = (int*)(F.ws + WS_ROWTOK);
    for (int i = F.gw * 64 + F.lane; i < 2 * T; i += F.NGW * 64) { const int e = toke[i];
        const int p = pst[e] + (int)__hip_atomic_fetch_add(curs + e, 1u, RLX_AGENT); pos[i] = p; rowtok[p] = i >> 1; }
}

struct SchedLora { pg8::StaticOrder S;
    __device__ __forceinline__ bool next(int i, Unit& u) const { if (!S.next(i, u)) return false; u.z = u.pn >> 2; u.akoff = u.z * 512; return true; } };
struct SchedBranch { pg8::StaticOrder S;
    __device__ __forceinline__ bool next(int i, Unit& u) const { if (!S.tile(i / 3, u.pm, u.pn)) return false; u.z = i % 3; u.am = u.z * 64 + u.pm; u.bn = u.z * 8 + u.pn; u.akoff = 0; u.bkoff = 0; return true; } };
struct SchedMoe { int nblk, ntile, G, vcu; const LAS int* blke; const int* rowtok; int nrows;
    __device__ __forceinline__ bool next(int i, Unit& u) const { const int L = i * G + vcu; if (L >= nblk * ntile) return false;
        const int rb = L / ntile, j = L % ntile, e = blke[1 + rb]; u.pm = rb; u.am = rb; u.pn = j; u.bn = e * ntile + j; u.z = j; u.akoff = 0; u.bkoff = 0; return true; } };

constexpr int NPH_LAYER = 17, PH_FINAL = 1 + DEPTH * NPH_LAYER, NPHASES = PH_FINAL + 1;
__global__ void __launch_bounds__(NWAVES * 64, 2) hybrid_fwd(Args args) {
    extern __shared__ __attribute__((aligned(16))) unsigned char lds_raw[];
    Frame F;
    F.lds = (LAS unsigned char*)lds_raw; F.MISC = (volatile LAS unsigned*)(F.lds + MISC_OFF);
    F.tid = threadIdx.x; F.lane = F.tid & 63; F.wave = __builtin_amdgcn_readfirstlane(F.tid >> 6);
    F.G = gridDim.x; { const int bx = blockIdx.x; F.vcu = (F.G % 8 == 0) ? (bx % 8) * (F.G / 8) + bx / 8 : bx; }
    F.gw = F.vcu * NWAVES + F.wave; F.NGW = F.G * NWAVES;
    F.ws = args.ws; F.ctl = (unsigned*)(args.ws + WS_CTL);
    for (int u = F.tid; u < (LDS_BYTES - RING_BYTES) / 4; u += NWAVES * 64) ((LAS unsigned*)(F.lds + RING_BYTES))[u] = 0u;
    __syncthreads();
    const int lo = args.ph_lo, hi = args.ph_hi;
    XcdBarrier bar; bar.bar = F.ctl + CW_BAR; bar.x = 0; bar.st = F.MISC + 8;
    if (hi - lo > 1) bar = xcd_barrier_post(F.ctl + CW_BAR, F.MISC + 8, threadIdx.x == 0);
    bool ran = false;
#define FRAME_INIT() do { int t_ = wave0_ * 64 + (int)__builtin_amdgcn_mbcnt_hi(~0u, __builtin_amdgcn_mbcnt_lo(~0u, 0u)), bx_ = blockIdx.x, G_ = gridDim.x; asm volatile("" : "+v"(t_)); asm volatile("" : "+s"(bx_), "+s"(G_)); \
        F.tid = t_; F.lane = t_ & 63; F.wave = __builtin_amdgcn_readfirstlane(t_ >> 6); F.G = G_; F.vcu = (G_ % 8 == 0) ? (bx_ % 8) * (G_ / 8) + bx_ / 8 : bx_; \
        F.gw = F.vcu * NWAVES + F.wave; F.NGW = G_ * NWAVES; F.ws = launder(args.ws); F.ctl = (unsigned*)F.ws; cblk = bx_; } while (0)
    int cblk = 0;
    const int wave0_ = __builtin_amdgcn_readfirstlane((int)threadIdx.x >> 6);
#ifndef PHMASK
#define PHMASK 0xFFFFF
#endif
#ifndef DUPMASK
#define DUPMASK 0
#endif
#define GRID_BARRIER() do { XcdBarrier bb_ = bar; bb_.bar = (unsigned*)launder((unsigned char*)bar.bar); xcd_barrier(bb_, wave0_ == 0 && __builtin_amdgcn_mbcnt_hi(~0u, __builtin_amdgcn_mbcnt_lo(~0u, 0u)) == 0u); } while (0)
#if DUPMASK
#define PHASE_BEGIN(p, k) if (((PHMASK >> (k)) & 1) && lo <= (p) && (p) < hi) { if (ran) GRID_BARRIER(); ran = true; \
    int nrep_ = (((DUPMASK >> (k)) & 1) && !(((k) == 8 || (k) == 1) && lcur > 0)) ? 2 : 1; asm volatile("" : "+s"(nrep_)); for (int rep_ = 0; rep_ < nrep_; ++rep_) { if (rep_) GRID_BARRIER(); FRAME_INIT();
#define PHASE_END } }
#else
#define PHASE_BEGIN(p, k) if (((PHMASK >> (k)) & 1) && lo <= (p) && (p) < hi) { if (ran) GRID_BARRIER(); ran = true; FRAME_INIT(); const int rep_ = 0; (void)rep_;
#define PHASE_END }
#endif
    int lcur = 0; (void)lcur;

    PHASE_BEGIN(0, 14) phase_convert(F, args); phase_norm<0>(F, (const float*)ARGP(0), nullptr, (const float*)ARGP(2), (bf16_t*)(F.ws + WS_H), nullptr, nullptr, nullptr, nullptr); PHASE_END

    { constexpr int l = 0;
        const int pb = 1 + l * NPH_LAYER; lcur = l;
        bf16_t* PROJ = (bf16_t*)(F.ws + WS_PROJ); float* X = (float*)(F.ws + WS_X); bf16_t* H = (bf16_t*)(F.ws + WS_H);
        const float* xres = (l == 0) ? (const float*)ARGP(0) : (const float*)X;


        if (l > 0) {
        PHASE_BEGIN(pb + 1, 1)
            phase_norm<1>(F, X, X, (const float*)ARGP(2) + (size_t)l * 2048, H, nullptr, (const bf16_t*)(F.ws + WS_Y), (const int*)(F.ws + WS_POS), (const float*)(F.ws + WS_TOKW));
        PHASE_END
        }

        PHASE_BEGIN(pb + 2, 2) {
            pg8::Gemm g{H, (const bf16_t*)(F.ws + WS_WIN + l * SZ_WIN), 2048, 2048, 2048}; pg8::StaticOrder S; S.init(T / 256, NPROJ / 256, F.G, cblk);
            EpiProj E{PROJ}; pg8::gemm_phase<EpiProj, pg8::StaticOrder, true>(F.lds, F.tid, g, S, E);
            if (l == 0 && rep_ == 0) { const int nu = (T / 256) * (NPROJ / 256), nfull = nu % F.G; if (nfull != 0 && cblk >= nfull) { __syncthreads(); P0Desc fn{F.ws}; const int nh = F.G - nfull, r = cblk - nfull;
                const int np = (P0Desc::NP_L - r + nh - 1) / nh; run_panels(F, P0Desc::NP_L + r, np, nh, fn); }
              else if (nfull == 0) { __syncthreads(); P0Desc fn{F.ws}; const int np = (P0Desc::NP_L - F.vcu + F.G - 1) / F.G; run_panels(F, P0Desc::NP_L + F.vcu, np, F.G, fn); } } }
        PHASE_END

        PHASE_BEGIN(pb + 3, 3) phase_prep(F, args, l); PHASE_END

        PHASE_BEGIN(pb + 4, 4) {
#ifndef P4SUB
#define P4SUB 15
#endif
#ifndef P4DUP
#define P4DUP 15
#endif
#define P4ON(b) ((P4SUB & (b)) && (rep_ == 0 || (P4DUP & (b))))
            if (P4ON(1)) { pg8::Gemm g{PROJ + PC_CQ, (const bf16_t*)(F.ws + WS_WUQ + l * SZ_WUQ), NPROJ, 768, 768}; pg8::StaticOrder S; S.init(T / 256, 6, F.G, cblk);
              EpiMlaQ E{(bf16_t*)(F.ws + WS_QMLA), (const float*)(F.ws + WS_RSTDQ), (const float*)(F.ws + WS_COS), (const float*)(F.ws + WS_SIN)};
              pg8::gemm_phase<EpiMlaQ, pg8::StaticOrder, true>(F.lds, F.tid, g, S, E); }
            { int t_ = F.tid; asm volatile("" : "+v"(t_)); F.tid = t_; }
            if (P4ON(2)) { pg8::Gemm g{PROJ + PC_CKV, (const bf16_t*)(F.ws + WS_WUKV + l * SZ_WUKV), NPROJ, 256, 256}; pg8::StaticOrder S; S.init(T / 256, 8, F.G, cblk);
              EpiMlaKV E{(bf16_t*)(F.ws + WS_KMLA), (bf16_t*)(F.ws + WS_VMLA), (const float*)(F.ws + WS_RSTDKV)};
              pg8::gemm_phase<EpiMlaKV, pg8::StaticOrder, true>(F.lds, F.tid, g, S, E); }
            { int t_ = F.tid; asm volatile("" : "+v"(t_)); F.tid = t_; }
            if (P4ON(4)) { pg8::Gemm g{(const bf16_t*)(F.ws + WS_LORAIN), (const bf16_t*)(F.ws + WS_WLORA + l * SZ_WLORA), 768, 256, 256}; SchedLora S; S.S.init(T / 256, 12, F.G, cblk);
              EpiLora E{(float*)(F.ws + WS_LOGDEC), (float*)(F.ws + WS_AIC), (bf16_t*)(F.ws + WS_GOUT), (const float*)ARGP(5) + l * 1024, (const float*)ARGP(7) + l * 1024};
              pg8::gemm_phase<EpiLora, SchedLora, true>(F.lds, F.tid, g, S, E); }
            { int t_ = F.tid; asm volatile("" : "+v"(t_)); F.tid = t_; }
            if (P4ON(8) && l > 0) { pg8::Gemm g{(const bf16_t*)(F.ws + WS_VS) + (size_t)l * T * 1024, (const bf16_t*)(F.ws + WS_WV1), 1024, 1024, 1024}; pg8::StaticOrder S; S.init(T / 256, 1, F.G, cblk);
              EpiT1 E{(bf16_t*)(F.ws + WS_T1)}; pg8::gemm_phase<EpiT1, pg8::StaticOrder, true>(F.lds, F.tid, g, S, E); } }
        PHASE_END

        if (l > 0) {
        PHASE_BEGIN(pb + 5, 5) { pg8::Gemm g{(const bf16_t*)(F.ws + WS_T1), (const bf16_t*)(F.ws + WS_WV2), 128, 128, 128}; pg8::StaticOrder S; S.init(T / 256, 4, F.G, cblk);
              EpiVGate E{(bf16_t*)(F.ws + WS_VGATE), (const float*)ARGP(15) + (size_t)(l - 1) * 1024}; pg8::gemm_phase<EpiVGate, pg8::StaticOrder, true>(F.lds, F.tid, g, S, E); }
        PHASE_END
        }

        PHASE_BEGIN(pb + 6, 6) phase_mix_a(F, l, rep_); PHASE_END
        PHASE_BEGIN(pb + 7, 16) phase_mix_b(F, l, rep_); PHASE_END
        PHASE_BEGIN(pb + 8, 17) for (int cidx = F.gw; cidx < 4096; cidx += F.NGW) rw::out_wave(F, l, cidx); PHASE_END

        PHASE_BEGIN(pb + 9, 7) { pg8::Gemm g{(const bf16_t*)(F.ws + WS_OALL), (const bf16_t*)(F.ws + WS_WBR + l * SZ_WBR), 1024, 1024, 1024}; SchedBranch S; S.S.init(T / 256, 8, F.G, cblk);
              EpiBranch E{PROJ, (bf16_t*)(F.ws + WS_MERGED)}; pg8::gemm_phase<EpiBranch, SchedBranch, true>(F.lds, F.tid, g, S, E); }
        PHASE_END

        PHASE_BEGIN(pb + 10, 8) { pg8::Gemm g{(const bf16_t*)(F.ws + WS_MERGED), (const bf16_t*)(F.ws + WS_WOUT + l * SZ_WOUT), 2048, 2048, 2048}; pg8::StaticOrder S; S.init(T / 256, 8, F.G, cblk);
              EpiWout E{xres, X}; pg8::gemm_phase<EpiWout, pg8::StaticOrder, true>(F.lds, F.tid, g, S, E); }
        PHASE_END

        PHASE_BEGIN(pb + 11, 9) phase_norm<3>(F, X, nullptr, (const float*)ARGP(26) + (size_t)l * 2048, (bf16_t*)(F.ws + WS_APRIME), nullptr, nullptr, nullptr, nullptr); PHASE_END

        PHASE_BEGIN(pb + 12, 10) { pg8::Gemm g{(const bf16_t*)(F.ws + WS_APRIME), (const bf16_t*)(F.ws + WS_WRT + l * SZ_WRT), 4096, 4096, 1024}; SchedRouter S{F.G, F.vcu};
              EpiRouterPart E{(float*)(F.ws + WS_LGP)}; pg8::gemm_phase<EpiRouterPart, SchedRouter, true>(F.lds, F.tid, g, S, E); }
        PHASE_END

        PHASE_BEGIN(pb + 13, 18) phase_select(F, l); PHASE_END

        PHASE_BEGIN(pb + 14, 11) phase_scatter(F, l); PHASE_END

        PHASE_BEGIN(pb + 15, 12) { LAS int* tab = (LAS int*)(F.lds + RING_BYTES + 1024); const int* blke = (const int*)(F.ws + WS_BLKE);
              if (F.tid < 256) tab[F.tid] = blke[F.tid]; __syncthreads();
              SchedMoe S{tab[0], 4, F.G, F.vcu, tab, (const int*)(F.ws + WS_ROWTOK), T};
              pg8::Gemm g{(const bf16_t*)(F.ws + WS_APRIME), (const bf16_t*)(F.ws + WS_WE1), 4096, 2048, 2048}; EpiE1 E{(bf16_t*)(F.ws + WS_HMOE)};
              pg8::gemm_phase<EpiE1, SchedMoe, true, true>(F.lds, F.tid, g, S, E); }
        PHASE_END

        PHASE_BEGIN(pb + 16, 13) { LAS int* tab = (LAS int*)(F.lds + RING_BYTES + 1024); const int* blke = (const int*)(F.ws + WS_BLKE);
              if (F.tid < 256) tab[F.tid] = blke[F.tid]; __syncthreads();
              SchedMoe S{tab[0], 8, F.G, F.vcu, tab, nullptr, 0};
              pg8::Gemm g{(const bf16_t*)(F.ws + WS_HMOE), (const bf16_t*)(F.ws + WS_WE2), 512, 512, 512}; EpiE2 E{(bf16_t*)(F.ws + WS_Y)};
              pg8::gemm_phase<EpiE2, SchedMoe, true>(F.lds, F.tid, g, S, E); }
        PHASE_END
    }
    { constexpr int l = 1;
        const int pb = 1 + l * NPH_LAYER; lcur = l;
        bf16_t* PROJ = (bf16_t*)(F.ws + WS_PROJ); float* X = (float*)(F.ws + WS_X); bf16_t* H = (bf16_t*)(F.ws + WS_H);
        const float* xres = (l == 0) ? (const float*)ARGP(0) : (const float*)X;


        if (l > 0) {
        PHASE_BEGIN(pb + 1, 1)
            phase_norm<1>(F, X, X, (const float*)ARGP(2) + (size_t)l * 2048, H, nullptr, (const bf16_t*)(F.ws + WS_Y), (const int*)(F.ws + WS_POS), (const float*)(F.ws + WS_TOKW));
        PHASE_END
        }

        PHASE_BEGIN(pb + 2, 2) {
            pg8::Gemm g{H, (const bf16_t*)(F.ws + WS_WIN + l * SZ_WIN), 2048, 2048, 2048}; pg8::StaticOrder S; S.init(T / 256, NPROJ / 256, F.G, cblk);
            EpiProj E{PROJ}; pg8::gemm_phase<EpiProj, pg8::StaticOrder, true>(F.lds, F.tid, g, S, E);
            if (l == 0 && rep_ == 0) { const int nu = (T / 256) * (NPROJ / 256), nfull = nu % F.G; if (nfull != 0 && cblk >= nfull) { __syncthreads(); P0Desc fn{F.ws}; const int nh = F.G - nfull, r = cblk - nfull;
                const int np = (P0Desc::NP_L - r + nh - 1) / nh; run_panels(F, P0Desc::NP_L + r, np, nh, fn); }
              else if (nfull == 0) { __syncthreads(); P0Desc fn{F.ws}; const int np = (P0Desc::NP_L - F.vcu + F.G - 1) / F.G; run_panels(F, P0Desc::NP_L + F.vcu, np, F.G, fn); } } }
        PHASE_END

        PHASE_BEGIN(pb + 3, 3) phase_prep(F, args, l); PHASE_END

        PHASE_BEGIN(pb + 4, 4) {
#ifndef P4SUB
#define P4SUB 15
#endif
#ifndef P4DUP
#define P4DUP 15
#endif
#define P4ON(b) ((P4SUB & (b)) && (rep_ == 0 || (P4DUP & (b))))
            if (P4ON(1)) { pg8::Gemm g{PROJ + PC_CQ, (const bf16_t*)(F.ws + WS_WUQ + l * SZ_WUQ), NPROJ, 768, 768}; pg8::StaticOrder S; S.init(T / 256, 6, F.G, cblk);
              EpiMlaQ E{(bf16_t*)(F.ws + WS_QMLA), (const float*)(F.ws + WS_RSTDQ), (const float*)(F.ws + WS_COS), (const float*)(F.ws + WS_SIN)};
              pg8::gemm_phase<EpiMlaQ, pg8::StaticOrder, true>(F.lds, F.tid, g, S, E); }
            { int t_ = F.tid; asm volatile("" : "+v"(t_)); F.tid = t_; }
            if (P4ON(2)) { pg8::Gemm g{PROJ + PC_CKV, (const bf16_t*)(F.ws + WS_WUKV + l * SZ_WUKV), NPROJ, 256, 256}; pg8::StaticOrder S; S.init(T / 256, 8, F.G, cblk);
              EpiMlaKV E{(bf16_t*)(F.ws + WS_KMLA), (bf16_t*)(F.ws + WS_VMLA), (const float*)(F.ws + WS_RSTDKV)};
              pg8::gemm_phase<EpiMlaKV, pg8::StaticOrder, true>(F.lds, F.tid, g, S, E); }
            { int t_ = F.tid; asm volatile("" : "+v"(t_)); F.tid = t_; }
            if (P4ON(4)) { pg8::Gemm g{(const bf16_t*)(F.ws + WS_LORAIN), (const bf16_t*)(F.ws + WS_WLORA + l * SZ_WLORA), 768, 256, 256}; SchedLora S; S.S.init(T / 256, 12, F.G, cblk);
              EpiLora E{(float*)(F.ws + WS_LOGDEC), (float*)(F.ws + WS_AIC), (bf16_t*)(F.ws + WS_GOUT), (const float*)ARGP(5) + l * 1024, (const float*)ARGP(7) + l * 1024};
              pg8::gemm_phase<EpiLora, SchedLora, true>(F.lds, F.tid, g, S, E); }
            { int t_ = F.tid; asm volatile("" : "+v"(t_)); F.tid = t_; }
            if (P4ON(8) && l > 0) { pg8::Gemm g{(const bf16_t*)(F.ws + WS_VS) + (size_t)l * T * 1024, (const bf16_t*)(F.ws + WS_WV1), 1024, 1024, 1024}; pg8::StaticOrder S; S.init(T / 256, 1, F.G, cblk);
              EpiT1 E{(bf16_t*)(F.ws + WS_T1)}; pg8::gemm_phase<EpiT1, pg8::StaticOrder, true>(F.lds, F.tid, g, S, E); } }
        PHASE_END

        if (l > 0) {
        PHASE_BEGIN(pb + 5, 5) { pg8::Gemm g{(const bf16_t*)(F.ws + WS_T1), (const bf16_t*)(F.ws + WS_WV2), 128, 128, 128}; pg8::StaticOrder S; S.init(T / 256, 4, F.G, cblk);
              EpiVGate E{(bf16_t*)(F.ws + WS_VGATE), (const float*)ARGP(15) + (size_t)(l - 1) * 1024}; pg8::gemm_phase<EpiVGate, pg8::StaticOrder, true>(F.lds, F.tid, g, S, E); }
        PHASE_END
        }

        PHASE_BEGIN(pb + 6, 6) phase_mix_a(F, l, rep_); PHASE_END
        PHASE_BEGIN(pb + 7, 16) phase_mix_b(F, l, rep_); PHASE_END
        PHASE_BEGIN(pb + 8, 17) for (int cidx = F.gw; cidx < 4096; cidx += F.NGW) rw::out_wave(F, l, cidx); PHASE_END

        PHASE_BEGIN(pb + 9, 7) { pg8::Gemm g{(const bf16_t*)(F.ws + WS_OALL), (const bf16_t*)(F.ws + WS_WBR + l * SZ_WBR), 1024, 1024, 1024}; SchedBranch S; S.S.init(T / 256, 8, F.G, cblk);
              EpiBranch E{PROJ, (bf16_t*)(F.ws + WS_MERGED)}; pg8::gemm_phase<EpiBranch, SchedBranch, true>(F.lds, F.tid, g, S, E); }
        PHASE_END

        PHASE_BEGIN(pb + 10, 8) { pg8::Gemm g{(const bf16_t*)(F.ws + WS_MERGED), (const bf16_t*)(F.ws + WS_WOUT + l * SZ_WOUT), 2048, 2048, 2048}; pg8::StaticOrder S; S.init(T / 256, 8, F.G, cblk);
              EpiWout E{xres, X}; pg8::gemm_phase<EpiWout, pg8::StaticOrder, true>(F.lds, F.tid, g, S, E); }
        PHASE_END

        PHASE_BEGIN(pb + 11, 9) phase_norm<3>(F, X, nullptr, (const float*)ARGP(26) + (size_t)l * 2048, (bf16_t*)(F.ws + WS_APRIME), nullptr, nullptr, nullptr, nullptr); PHASE_END

        PHASE_BEGIN(pb + 12, 10) { pg8::Gemm g{(const bf16_t*)(F.ws + WS_APRIME), (const bf16_t*)(F.ws + WS_WRT + l * SZ_WRT), 4096, 4096, 1024}; SchedRouter S{F.G, F.vcu};
              EpiRouterPart E{(float*)(F.ws + WS_LGP)}; pg8::gemm_phase<EpiRouterPart, SchedRouter, true>(F.lds, F.tid, g, S, E); }
        PHASE_END

        PHASE_BEGIN(pb + 13, 18) phase_select(F, l); PHASE_END

        PHASE_BEGIN(pb + 14, 11) phase_scatter(F, l); PHASE_END

        PHASE_BEGIN(pb + 15, 12) { LAS int* tab = (LAS int*)(F.lds + RING_BYTES + 1024); const int* blke = (const int*)(F.ws + WS_BLKE);
              if (F.tid < 256) tab[F.tid] = blke[F.tid]; __syncthreads();
              SchedMoe S{tab[0], 4, F.G, F.vcu, tab, (const int*)(F.ws + WS_ROWTOK), T};
              pg8::Gemm g{(const bf16_t*)(F.ws + WS_APRIME), (const bf16_t*)(F.ws + WS_WE1), 4096, 2048, 2048}; EpiE1 E{(bf16_t*)(F.ws + WS_HMOE)};
              pg8::gemm_phase<EpiE1, SchedMoe, true, true>(F.lds, F.tid, g, S, E); }
        PHASE_END

        PHASE_BEGIN(pb + 16, 13) { LAS int* tab = (LAS int*)(F.lds + RING_BYTES + 1024); const int* blke = (const int*)(F.ws + WS_BLKE);
              if (F.tid < 256) tab[F.tid] = blke[F.tid]; __syncthreads();
              SchedMoe S{tab[0], 8, F.G, F.vcu, tab, nullptr, 0};
              pg8::Gemm g{(const bf16_t*)(F.ws + WS_HMOE), (const bf16_t*)(F.ws + WS_WE2), 512, 512, 512}; EpiE2 E{(bf16_t*)(F.ws + WS_Y)};
              pg8::gemm_phase<EpiE2, SchedMoe, true>(F.lds, F.tid, g, S, E); }
        PHASE_END
    }


    PHASE_BEGIN(PH_FINAL, 15)
        phase_norm<2>(F, (const float*)(F.ws + WS_X), nullptr, (const float*)ARGP(34), nullptr, args.out, (const bf16_t*)(F.ws + WS_Y), (const int*)(F.ws + WS_POS), (const float*)(F.ws + WS_TOKW));
    PHASE_END
#undef PHASE_BEGIN
#undef PHASE_END
}

#ifndef MK_MULTI
#define MK_MULTI 0
#endif
extern "C" void kernel_launch(void* const* d_in, const int* in_sizes, int n_in, void* d_out, int out_size, void* d_ws, size_t ws_size, hipStream_t stream) {
    static int grid = 0;
    if (grid == 0) {
        if (n_in != 35 || out_size != T * DM || ws_size < WS_END) { fprintf(stderr, "kernel_launch: unexpected shapes (n_in %d, out %d, ws %zu, need %zu)\n", n_in, out_size, ws_size, (size_t)WS_END); grid = -1; return; }
        int dev = 0, cus = 0, per_cu = 0;
        if (hipGetDevice(&dev) != hipSuccess || hipDeviceGetAttribute(&cus, hipDeviceAttributeMultiprocessorCount, dev) != hipSuccess) { grid = -1; return; }
        if (hipFuncSetAttribute((const void*)hybrid_fwd, hipFuncAttributeMaxDynamicSharedMemorySize, LDS_BYTES) != hipSuccess) { fprintf(stderr, "kernel_launch: hipFuncSetAttribute failed\n"); grid = -1; return; }
        if (hipOccupancyMaxActiveBlocksPerMultiprocessor(&per_cu, (const void*)hybrid_fwd, NWAVES * 64, LDS_BYTES) != hipSuccess || per_cu < 1)
            fprintf(stderr, "kernel_launch: occupancy query reports %d workgroups per CU\n", per_cu);
        (void)hipGetLastError();
        grid = cus;
    }
    if (grid < 0) return;
    if (hipMemsetAsync((char*)d_ws + WS_CTL, 0, CTL_ZERO_BYTES, stream) != hipSuccess) return;
    Args a{};
    for (int i = 0; i < 35; ++i) a.in[i] = d_in[i];
    a.out = (float*)d_out; a.ws = (unsigned char*)d_ws;
#if MK_MULTI
    for (int p = 0; p < NPHASES; ++p) { a.ph_lo = p; a.ph_hi = p + 1; hipLaunchKernelGGL(hybrid_fwd, dim3(grid), dim3(NWAVES * 64), LDS_BYTES, stream, a); }
#else
    a.ph_lo = 0; a.ph_hi = NPHASES;
    hipLaunchKernelGGL(hybrid_fwd, dim3(grid), dim3(NWAVES * 64), LDS_BYTES, stream, a);
#endif
    const hipError_t le = hipPeekAtLastError();
    if (le != hipSuccess) fprintf(stderr, "kernel_launch: launch failed: %s\n", hipGetErrorName(le));
}
```

```cpp
#include <hip/hip_runtime.h>
#include <cstdio>
#include <cstdint>

#define LAS __attribute__((address_space(3)))
#define GAS __attribute__((address_space(1)))
typedef unsigned short bf16_t;
typedef short bf16x8 __attribute__((ext_vector_type(8)));
typedef short s16x4 __attribute__((ext_vector_type(4)));
typedef short v4i16_t __attribute__((ext_vector_type(4)));
typedef float f32x4 __attribute__((ext_vector_type(4)));
typedef float f32x2 __attribute__((ext_vector_type(2)));
typedef float f32x16 __attribute__((ext_vector_type(16)));
typedef unsigned u32x4 __attribute__((ext_vector_type(4)));
typedef unsigned u32x2 __attribute__((ext_vector_type(2)));
typedef GAS unsigned gu32;
#define RLX_AGENT __ATOMIC_RELAXED, __HIP_MEMORY_SCOPE_AGENT

constexpr int T = 16384, SEQ = 4096, NBATCH = 4, DM = 2048, DEPTH = 2;
constexpr int NHEAD = 16;
constexpr int N_IN_SRC = 13792;
constexpr int NPROJ = 13824;
constexpr int PC_SBQ = 0, PC_SBK = 1024, PC_SBV = 2048, PC_RR = 3072, PC_RK = 4096, PC_RV = 5120;
constexpr int PC_WD = 6144, PC_AD = 6240, PC_KPE = 6336, PC_GD = 6400, PC_CQ = 6656, PC_CKV = 7424, PC_GATE = 7680;
constexpr int GATE_TILE0 = PC_GATE / 256;
constexpr int RWKV_COLS = 3520;
constexpr float NORM_EPS = 1e-6f, GN_EPS = 64e-5f;
constexpr float LOG2E = 1.4426950408889634f;
constexpr int MOE_MAXBLK = 192;
constexpr int MOE_ROWS = MOE_MAXBLK * 256;

__device__ __forceinline__ unsigned f2bf(float f) { unsigned u = __builtin_bit_cast(unsigned, f); return (u + 0x7fffu + ((u >> 16) & 1u)) >> 16; }
__device__ __forceinline__ unsigned pk2(float lo, float hi) { return f2bf(lo) | (f2bf(hi) << 16); }
__device__ __forceinline__ float bf2f(unsigned b) { return __builtin_bit_cast(float, b << 16); }
__device__ __forceinline__ float bflo(unsigned w) { return __builtin_bit_cast(float, w << 16); }
__device__ __forceinline__ float bfhi(unsigned w) { return __builtin_bit_cast(float, w & 0xffff0000u); }
typedef __bf16 bf16x2_t __attribute__((ext_vector_type(2)));
__device__ __forceinline__ unsigned cvt_pk_bf16(float lo, float hi) { const f32x2 v = {lo, hi}; const bf16x2_t b = __builtin_convertvector(v, bf16x2_t); return __builtin_bit_cast(unsigned, b); }
__device__ __forceinline__ float fast_sigmoid(float v) { return __builtin_amdgcn_rcpf(1.0f + __expf(-v)); }
template <int CTRL> __device__ __forceinline__ float dpp_mov(float v) { return __builtin_bit_cast(float, __builtin_amdgcn_update_dpp(0, __builtin_bit_cast(int, v), CTRL, 0xF, 0xF, false)); }
__device__ __forceinline__ float sum8(float v) {
    v += dpp_mov<0xB1>(v);
    v += dpp_mov<0x4E>(v);
    v += dpp_mov<0x141>(v);
    return v;
}
__device__ __forceinline__ float wave_sum(float v) {
    v = sum8(v); v += dpp_mov<0x140>(v);
    const float a = __builtin_bit_cast(float, __builtin_amdgcn_readlane(__builtin_bit_cast(int, v), 0)), b = __builtin_bit_cast(float, __builtin_amdgcn_readlane(__builtin_bit_cast(int, v), 16)),
                c = __builtin_bit_cast(float, __builtin_amdgcn_readlane(__builtin_bit_cast(int, v), 32)), d = __builtin_bit_cast(float, __builtin_amdgcn_readlane(__builtin_bit_cast(int, v), 48));
    return (a + b) + (c + d);
}
__device__ __forceinline__ void store8_bf16(bf16_t* p, f32x4 v0, f32x4 v1) {
    u32x4 w; w.x = cvt_pk_bf16(v0[0], v0[1]); w.y = cvt_pk_bf16(v0[2], v0[3]); w.z = cvt_pk_bf16(v1[0], v1[1]); w.w = cvt_pk_bf16(v1[2], v1[3]);
    *(u32x4*)p = w;
}
__device__ __forceinline__ void store4_bf16(bf16_t* p, f32x4 v) { u32x2 w; w.x = cvt_pk_bf16(v[0], v[1]); w.y = cvt_pk_bf16(v[2], v[3]); *(u32x2*)p = w; }
__device__ __forceinline__ f32x4 load4_bf16(const bf16_t* p) { const u32x2 w = *(const u32x2*)p; return (f32x4){bflo(w.x), bfhi(w.x), bflo(w.y), bfhi(w.y)}; }
__device__ __forceinline__ void load8f(const bf16_t* p, float (&o)[8]) { const u32x4 w = *(const u32x4*)p; o[0] = bflo(w.x); o[1] = bfhi(w.x); o[2] = bflo(w.y); o[3] = bfhi(w.y); o[4] = bflo(w.z); o[5] = bfhi(w.z); o[6] = bflo(w.w); o[7] = bfhi(w.w); }
__device__ __forceinline__ void unpack8(const u32x4& w, float (&o)[8]) { o[0] = bflo(w.x); o[1] = bfhi(w.x); o[2] = bflo(w.y); o[3] = bfhi(w.y); o[4] = bflo(w.z); o[5] = bfhi(w.z); o[6] = bflo(w.w); o[7] = bfhi(w.w); }
__device__ __forceinline__ void store8f(bf16_t* p, const float (&v)[8]) { u32x4 w; w.x = pk2(v[0], v[1]); w.y = pk2(v[2], v[3]); w.z = pk2(v[4], v[5]); w.w = pk2(v[6], v[7]); *(u32x4*)p = w; }

namespace pg8 {
constexpr int BM = 256, BK = 64, HALF = 128, HTB = HALF * BK * 2  , STAGE_BYTES = 8 * HTB, NXCD = 8, WGM = 8;
__host__ __device__ __forceinline__ int lds_byte(int r, int c) { const int st = (r >> 4) * 2 + (c >> 5), rr = r & 15, cc = c & 31, ob = rr * 64 + cc * 2; return st * 1024 + (ob ^ (((ob >> 9) & 1) << 5)); }
__host__ __device__ __forceinline__ void stage_rc(int b, int& R, int& C) { const int st = b / 1024, sb = b % 1024, swz = sb ^ (((sb >> 9) & 1) << 5); R = (st >> 1) * 16 + swz / 64; C = (st & 1) * 32 + (swz % 64) / 2; }
__host__ __device__ __forceinline__ int perm32(int rho) { const int n = rho >> 4, i = rho & 15; return 8 * (i >> 2) + 4 * n + (i & 3); }

struct Unit { int pm, pn, am, bn, akoff, bkoff, z; };
struct Gemm { const bf16_t* A; const bf16_t* Bt; int lda, ldb, K; };

struct StaticOrder {
    int nM, nN, nwg, G, c;
    __device__ __forceinline__ void init(int nM_, int nN_, int G_, int c_) { nM = nM_; nN = nN_; nwg = nM * nN; G = G_; c = c_; }
    __device__ __forceinline__ bool tile(int i, int& pm, int& pn) const {
        const long L = (long)i * G + c; if (L >= nwg) return false;
        int wgid = (int)L; { const int q = nwg / NXCD, r = nwg % NXCD, xcd = wgid % NXCD, off = wgid / NXCD; wgid = (xcd < r ? xcd * (q + 1) : r * (q + 1) + (xcd - r) * q) + off; }
        const int nig = WGM * nN, gid = wgid / nig, fm = gid * WGM, gsz = (nM - fm) < WGM ? (nM - fm) : WGM;
        pm = fm + ((wgid % nig) % gsz); pn = (wgid % nig) / gsz; return true;
    }
    __device__ __forceinline__ bool next(int i, Unit& u) const { if (!tile(i, u.pm, u.pn)) return false; u.am = u.pm; u.bn = u.pn; u.akoff = 0; u.bkoff = 0; u.z = 0; return true; }
};

template <class E> constexpr auto epi_chain(int) -> decltype(E::CHAIN) { return E::CHAIN; }
template <class E> constexpr bool epi_chain(long) { return false; }
template <class Epi, class Sched, bool ALIGN_EPI, bool GATHER = false>
__device__ __forceinline__ void gemm_phase(LAS unsigned char* lds, const int tid, const Gemm g, const Sched& S, const Epi& E) {
    const int wid = __builtin_amdgcn_readfirstlane(tid >> 6), lane = tid & 63, wr = wid >> 2, wc = wid & 3, fr = lane & 15, fq = lane >> 4;
    int K = g.K; asm volatile("" : "+s"(K)); const int nt = K / BK;
    unsigned voffA[2], voffB[2];
#pragma unroll
    for (int i = 0; i < 2; ++i) { int R, C; stage_rc(tid * 16 + i * 8192, R, C); const int Rb = Epi::PERM ? ((R & ~31) + perm32(R & 31)) : R;
        voffA[i] = (unsigned)(R * g.lda + C) * 2u; voffB[i] = (unsigned)(Rb * g.ldb + C) * 2u; }
    unsigned gc[2][2], gn[2][2];
#define PG8_GLOAD(dst, unit) do { _Pragma("unroll") for (int _h = 0; _h < 2; ++_h) _Pragma("unroll") for (int _i = 0; _i < 2; ++_i) { int R_, C_; stage_rc(tid * 16 + _i * 8192, R_, C_); \
        unsigned tk_ = (unsigned)S.rowtok[(unit).pm * 256 + _h * 128 + R_]; tk_ = tk_ < (unsigned)S.nrows ? tk_ : 0u; dst[_h][_i] = (tk_ * (unsigned)g.lda + (unsigned)C_) * 2u; } } while (0)
    const size_t kstep = (size_t)(BK * 2);
    const size_t hstepA = GATHER ? 0 : (size_t)HALF * g.lda * 2, hstepB = (size_t)HALF * g.ldb * 2;
    const size_t tstepA = 2 * hstepA, tstepB = 2 * hstepB;
    const unsigned ldsw = (unsigned)wid * 1024u;
    const int aoff = lds_byte(wr * 64 + fr, fq * 8), boff = lds_byte(wc * 32 + fr, fq * 8);
#define PG8_SA(b, h) (((b) * 2 + (h)) * HTB)
#define PG8_SB(b, h) ((4 + (b) * 2 + (h)) * HTB)
#define PG8_STAGE(bufoff, gbase, voff) do { _Pragma("unroll") for (int _i = 0; _i < 2; ++_i) \
        __builtin_amdgcn_global_load_lds((const unsigned*)((const char*)(gbase) + (voff)[_i]), (LAS unsigned*)(lds + (bufoff) + ldsw + _i * 8192), 16, 0, 0); } while (0)
#define PG8_STAGEA(b, h, gbase, nx) do { if constexpr (GATHER) { _Pragma("unroll") for (int _i = 0; _i < 2; ++_i) { const unsigned o_ = (nx) ? gn[h][_i] : gc[h][_i]; \
        __builtin_amdgcn_global_load_lds((const unsigned*)((const char*)(gbase) + o_), (LAS unsigned*)(lds + PG8_SA(b, h) + ldsw + _i * 8192), 16, 0, 0); } } \
    else { PG8_STAGE(PG8_SA(b, h), (gbase) + (h) * hstepA, voffA); } } while (0)
#define PG8_LDA(dst, b, h) do { _Pragma("unroll") for (int m = 0; m < 4; ++m) _Pragma("unroll") for (int k = 0; k < 2; ++k) dst[m][k] = *(const LAS bf16x8*)(lds + PG8_SA(b, h) + aoff + m * 2048 + k * 1024); } while (0)
#define PG8_LDB(dst, b, h) do { _Pragma("unroll") for (int n = 0; n < 2; ++n) _Pragma("unroll") for (int k = 0; k < 2; ++k) dst[n][k] = *(const LAS bf16x8*)(lds + PG8_SB(b, h) + boff + n * 2048 + k * 1024); } while (0)
#define PG8_MMA(ai, bj, At, Bt) do { __builtin_amdgcn_s_setprio(1); _Pragma("unroll") for (int m = 0; m < 4; ++m) _Pragma("unroll") for (int n = 0; n < 2; ++n) _Pragma("unroll") for (int k = 0; k < 2; ++k) \
        acc[ai][bj][m][n] = __builtin_amdgcn_mfma_f32_16x16x32_bf16(Bt[n][k], At[m][k], acc[ai][bj][m][n], 0, 0, 0); __builtin_amdgcn_s_setprio(0); } while (0)
#define PG8_WAIT_V(n) asm volatile("s_waitcnt vmcnt(" #n ")" ::: "memory")
#define PG8_WAIT_L(n) asm volatile("s_waitcnt lgkmcnt(" #n ")" ::: "memory")
#define PG8_BAR __builtin_amdgcn_s_barrier()
#define PG8_SCHED __builtin_amdgcn_sched_barrier(0)
    Unit cur, nxt; int ui = 0;
    if (!S.next(0, cur)) return;
    f32x4 acc[2][2][4][2];
#pragma unroll
    for (int a = 0; a < 2; ++a)
#pragma unroll
        for (int b = 0; b < 2; ++b)
#pragma unroll
            for (int m = 0; m < 4; ++m)
#pragma unroll
                for (int n = 0; n < 2; ++n) acc[a][b][m][n] = (f32x4){0.f, 0.f, 0.f, 0.f};
    bf16x8 At[4][2], B0[2][2], B1[2][2];
    const char* cA = (const char*)g.A + (GATHER ? (size_t)0 : (size_t)cur.am * tstepA) + cur.akoff; const char* cB = (const char*)g.Bt + (size_t)cur.bn * tstepB + cur.bkoff;
    if constexpr (GATHER) PG8_GLOAD(gc, cur);
    {
        PG8_STAGE(PG8_SB(0, 0), cB, voffB); PG8_STAGE(PG8_SB(0, 1), cB + hstepB, voffB); PG8_STAGEA(0, 0, cA, false); PG8_STAGEA(0, 1, cA, false);
        if (wr == 1) PG8_BAR;
        PG8_WAIT_V(2); PG8_BAR;
        PG8_STAGE(PG8_SB(1, 0), cB + kstep, voffB); PG8_STAGEA(1, 0, cA + kstep, false); PG8_STAGE(PG8_SB(1, 1), cB + hstepB + kstep, voffB);
        PG8_WAIT_V(6); PG8_BAR;
    }
    for (;;) {
        const bool has_next = S.next(ui + 1, nxt);
        const char* nA = has_next ? (const char*)g.A + (GATHER ? (size_t)0 : (size_t)nxt.am * tstepA) + nxt.akoff : cA;
        if constexpr (GATHER) { if (has_next) PG8_GLOAD(gn, nxt); else { gn[0][0] = gc[0][0]; gn[0][1] = gc[0][1]; gn[1][0] = gc[1][0]; gn[1][1] = gc[1][1]; } } const char* nB = has_next ? (const char*)g.Bt + (size_t)nxt.bn * tstepB + nxt.bkoff : cB;
#pragma unroll 1
        for (int t = 0; t < nt; t += 2) {
            const bool last = (t == nt - 2);
            const char* a1 = cA + (size_t)(t + 1) * kstep;
            const char* a2 = last ? nA : cA + (size_t)(t + 2) * kstep; const char* b2 = last ? nB : cB + (size_t)(t + 2) * kstep;
            const char* a3 = a2 + kstep; const char* b3 = b2 + kstep;
            PG8_LDB(B0, 0, 0); PG8_LDB(B1, 0, 1); PG8_SCHED; PG8_LDA(At, 0, 0); PG8_STAGEA(1, 1, a1, false);
            PG8_WAIT_V(8); PG8_WAIT_L(0); PG8_BAR; PG8_MMA(0, 0, At, B0); PG8_MMA(0, 1, At, B1); PG8_BAR; PG8_SCHED;
            PG8_LDA(At, 0, 1); PG8_STAGE(PG8_SB(0, 0), b2, voffB); PG8_STAGE(PG8_SB(0, 1), b2 + hstepB, voffB); PG8_STAGEA(0, 0, a2, last);
            PG8_WAIT_V(8); PG8_WAIT_L(0); PG8_BAR; PG8_MMA(1, 0, At, B0); PG8_MMA(1, 1, At, B1); PG8_BAR; PG8_SCHED;
            PG8_LDB(B0, 1, 0); PG8_LDB(B1, 1, 1); PG8_SCHED; PG8_LDA(At, 1, 0); PG8_STAGEA(0, 1, a2, last);
            PG8_WAIT_V(8); PG8_WAIT_L(0); PG8_BAR; PG8_MMA(0, 0, At, B0); PG8_MMA(0, 1, At, B1); PG8_BAR; PG8_SCHED;
            PG8_LDA(At, 1, 1); PG8_STAGE(PG8_SB(1, 0), b3, voffB); PG8_STAGE(PG8_SB(1, 1), b3 + hstepB, voffB); PG8_STAGEA(1, 0, a3, last);
            PG8_WAIT_V(8); PG8_WAIT_L(0); PG8_BAR; PG8_MMA(1, 0, At, B0); PG8_MMA(1, 1, At, B1); PG8_BAR; PG8_SCHED;
        }
        if constexpr (ALIGN_EPI) { if (wr == 0) PG8_BAR; }
        if constexpr (!Epi::AFTER_DRAIN) { E(acc, cur, wr, wc, fr, fq); }
        if (!has_next) break;
        if (!(epi_chain<Epi>(0) && nxt.z != 0))
#pragma unroll
        for (int a = 0; a < 2; ++a)
#pragma unroll
            for (int b = 0; b < 2; ++b)
#pragma unroll
                for (int m = 0; m < 4; ++m)
#pragma unroll
                    for (int n = 0; n < 2; ++n) acc[a][b][m][n] = (f32x4){0.f, 0.f, 0.f, 0.f};
        cur = nxt; cA = nA; cB = nB; ++ui;
        if constexpr (GATHER) { gc[0][0] = gn[0][0]; gc[0][1] = gn[0][1]; gc[1][0] = gn[1][0]; gc[1][1] = gn[1][1]; }
        if constexpr (ALIGN_EPI) { if (wr == 1) PG8_BAR; }
    }
    PG8_WAIT_V(0);
    if constexpr (!ALIGN_EPI) { if (wr == 0) PG8_BAR; }
    PG8_BAR;
    if constexpr (Epi::AFTER_DRAIN) { E.fused(acc, cur, wr, wc, fr, fq, lds, wid, lane); }
#undef PG8_SA
#undef PG8_SB
#undef PG8_STAGE
#undef PG8_STAGEA
#undef PG8_GLOAD
#undef PG8_LDA
#undef PG8_LDB
#undef PG8_MMA
#undef PG8_WAIT_V
#undef PG8_WAIT_L
#undef PG8_BAR
#undef PG8_SCHED
}
}
using pg8::Unit;
typedef f32x4 AccT[2][2][4][2];

#define EPI_ROW(u, ai, m) ((u).pm * 256 + (ai) * 128 + wr * 64 + (m) * 16 + fr)
struct EpiProj { static constexpr bool PERM = true, AFTER_DRAIN = false; bf16_t* O;
    __device__ __forceinline__ void operator()(const AccT& acc, const Unit& u, int wr, int wc, int fr, int fq) const {
        const bool sig = u.pn >= GATE_TILE0; const int col0 = u.pn * 256 + wc * 32 + 8 * fq;
#pragma unroll
        for (int ai = 0; ai < 2; ++ai)
#pragma unroll
            for (int m = 0; m < 4; ++m) { bf16_t* rowp = O + (size_t)EPI_ROW(u, ai, m) * NPROJ + col0;
#pragma unroll
                for (int bj = 0; bj < 2; ++bj) { f32x4 v0 = acc[ai][bj][m][0], v1 = acc[ai][bj][m][1];
                    if (sig) {
#pragma unroll
                        for (int e = 0; e < 4; ++e) { v0[e] = fast_sigmoid(v0[e]); v1[e] = fast_sigmoid(v1[e]); } }
                    store8_bf16(rowp + bj * 128, v0, v1); } }
    }
};
struct EpiMlaQ { static constexpr bool PERM = false, AFTER_DRAIN = false; bf16_t* Q; const float* rstd; const float* cosb; const float* sinb;
    __device__ __forceinline__ void operator()(const AccT& acc, const Unit& u, int wr, int wc, int fr, int fq) const {
        float rs[2][4];
#pragma unroll
        for (int ai = 0; ai < 2; ++ai)
#pragma unroll
            for (int m = 0; m < 4; ++m) rs[ai][m] = rstd[EPI_ROW(u, ai, m)];
        if (u.pn < 4) {
#pragma unroll
            for (int ai = 0; ai < 2; ++ai)
#pragma unroll
                for (int m = 0; m < 4; ++m) { bf16_t* qrow = Q + (size_t)EPI_ROW(u, ai, m) * 1536;
#pragma unroll
                    for (int bj = 0; bj < 2; ++bj)
#pragma unroll
                        for (int n = 0; n < 2; ++n) { const int c = u.pn * 256 + bj * 128 + wc * 32 + n * 16 + fq * 4; const int head = c >> 6, d = c & 63;
                            store4_bf16(qrow + head * 96 + d, acc[ai][bj][m][n] * rs[ai][m]); } }
        } else {
#pragma unroll
            for (int ai = 0; ai < 2; ++ai) { f32x4 cs[4], sn[4];
#pragma unroll
                for (int m = 0; m < 4; ++m) { const int row = EPI_ROW(u, ai, m); cs[m] = *(const f32x4*)(cosb + (size_t)row * 16 + fq * 4); sn[m] = *(const f32x4*)(sinb + (size_t)row * 16 + fq * 4); }
#pragma unroll
                for (int m = 0; m < 4; ++m) { bf16_t* qrow = Q + (size_t)EPI_ROW(u, ai, m) * 1536; const float r = rs[ai][m];
#pragma unroll
                    for (int bj = 0; bj < 2; ++bj) { const int head = (u.pn - 4) * 8 + bj * 4 + wc; const f32x4 x1 = acc[ai][bj][m][0] * r, x2 = acc[ai][bj][m][1] * r;
                        store4_bf16(qrow + head * 96 + 64 + fq * 4, x1 * cs[m] - x2 * sn[m]); store4_bf16(qrow + head * 96 + 80 + fq * 4, x2 * cs[m] + x1 * sn[m]); } } }
        }
    }
};
struct EpiMlaKV { static constexpr bool PERM = true, AFTER_DRAIN = false; bf16_t* Kd; bf16_t* Vd; const float* rstd;
    __device__ __forceinline__ void operator()(const AccT& acc, const Unit& u, int wr, int wc, int fr, int fq) const {
        float rs[2][4];
#pragma unroll
        for (int ai = 0; ai < 2; ++ai)
#pragma unroll
            for (int m = 0; m < 4; ++m) rs[ai][m] = rstd[EPI_ROW(u, ai, m)];
        bf16_t* base = (u.pn < 4) ? Kd + u.pn * 256 : Vd + (u.pn * 256 - 1024);
#pragma unroll
        for (int ai = 0; ai < 2; ++ai)
#pragma unroll
            for (int m = 0; m < 4; ++m) { const int row = EPI_ROW(u, ai, m); const float r = rs[ai][m];
#pragma unroll
                for (int bj = 0; bj < 2; ++bj) store8_bf16(base + (size_t)row * 1024 + bj * 128 + wc * 32 + 8 * fq, acc[ai][bj][m][0] * r, acc[ai][bj][m][1] * r); }
    }
};
struct EpiLora { static constexpr bool PERM = false, AFTER_DRAIN = false; float* logdec; float* aic; bf16_t* gout; const float* w0; const float* a0;
    __device__ __forceinline__ void operator()(const AccT& acc, const Unit& u, int wr, int wc, int fr, int fq) const {
        const int colb = (u.pn & 3) * 256 + wc * 32 + fq * 4;
        f32x4 bias[2][2];
        { const float* bp = (u.z == 0) ? w0 : a0;
#pragma unroll
          for (int bj = 0; bj < 2; ++bj)
#pragma unroll
              for (int n = 0; n < 2; ++n) bias[bj][n] = (u.z < 2) ? *(const f32x4*)(bp + colb + bj * 128 + n * 16) : (f32x4){0.f, 0.f, 0.f, 0.f}; }
        if (u.z == 0) {
#pragma unroll
            for (int ai = 0; ai < 2; ++ai)
#pragma unroll
                for (int m = 0; m < 4; ++m) { float* rowp = logdec + (size_t)EPI_ROW(u, ai, m) * 1024 + colb;
#pragma unroll
                    for (int bj = 0; bj < 2; ++bj)
#pragma unroll
                        for (int n = 0; n < 2; ++n) { f32x4 v = acc[ai][bj][m][n] + bias[bj][n];
#pragma unroll
                            for (int e = 0; e < 4; ++e) { const float x = -v[e]; const float sp = fmaxf(x, 0.f) + __logf(1.0f + __expf(-fabsf(x))); v[e] = -__expf(-sp - 0.5f); }
                            *(f32x4*)(rowp + bj * 128 + n * 16) = v; } }
        } else if (u.z == 1) {
#pragma unroll
            for (int ai = 0; ai < 2; ++ai)
#pragma unroll
                for (int m = 0; m < 4; ++m) { float* rowp = aic + (size_t)EPI_ROW(u, ai, m) * 1024 + colb;
#pragma unroll
                    for (int bj = 0; bj < 2; ++bj)
#pragma unroll
                        for (int n = 0; n < 2; ++n) { f32x4 v = acc[ai][bj][m][n] + bias[bj][n];
#pragma unroll
                            for (int e = 0; e < 4; ++e) v[e] = fast_sigmoid(v[e]);
                            *(f32x4*)(rowp + bj * 128 + n * 16) = v; } }
        } else {
#pragma unroll
            for (int ai = 0; ai < 2; ++ai)
#pragma unroll
                for (int m = 0; m < 4; ++m) { bf16_t* rowp = gout + (size_t)EPI_ROW(u, ai, m) * 1024 + colb;
#pragma unroll
                    for (int bj = 0; bj < 2; ++bj)
#pragma unroll
                        for (int n = 0; n < 2; ++n) store4_bf16(rowp + bj * 128 + n * 16, acc[ai][bj][m][n]); }
        }
    }
};
struct EpiT1 { static constexpr bool PERM = true, AFTER_DRAIN = false; bf16_t* O;
    __device__ __forceinline__ void operator()(const AccT& acc, const Unit& u, int wr, int wc, int fr, int fq) const {
#pragma unroll
        for (int ai = 0; ai < 2; ++ai)
#pragma unroll
            for (int m = 0; m < 4; ++m) store8_bf16(O + (size_t)EPI_ROW(u, ai, m) * 128 + wc * 32 + 8 * fq, acc[ai][0][m][0], acc[ai][0][m][1]);
    }
};
struct EpiVGate { static constexpr bool PERM = true, AFTER_DRAIN = false; bf16_t* O; const float* v0;
    __device__ __forceinline__ void operator()(const AccT& acc, const Unit& u, int wr, int wc, int fr, int fq) const {
#pragma unroll
        for (int bj = 0; bj < 2; ++bj) { const int col = u.pn * 256 + bj * 128 + wc * 32 + 8 * fq; const f32x4 b0 = *(const f32x4*)(v0 + col), b1 = *(const f32x4*)(v0 + col + 4);
#pragma unroll
            for (int ai = 0; ai < 2; ++ai)
#pragma unroll
                for (int m = 0; m < 4; ++m) { f32x4 x0 = acc[ai][bj][m][0] + b0, x1 = acc[ai][bj][m][1] + b1;
#pragma unroll
                    for (int e = 0; e < 4; ++e) { x0[e] = fast_sigmoid(x0[e]); x1[e] = fast_sigmoid(x1[e]); }
                    store8_bf16(O + (size_t)EPI_ROW(u, ai, m) * 1024 + col, x0, x1); } }
    }
};
struct EpiBranch { static constexpr bool PERM = true, AFTER_DRAIN = false, CHAIN = true; const bf16_t* proj; bf16_t* merged;
    __device__ __forceinline__ void operator()(AccT& acc, const Unit& u, int wr, int wc, int fr, int fq) const {
        const int colb = u.pn * 256 + wc * 32 + 8 * fq; const bool more = u.z < 2;
#pragma unroll
        for (int ai = 0; ai < 2; ++ai) {
            u32x4 gt[4][2], gn[4][2];
#pragma unroll
            for (int m = 0; m < 4; ++m)
#pragma unroll
                for (int bj = 0; bj < 2; ++bj) gt[m][bj] = *(const u32x4*)(proj + (size_t)EPI_ROW(u, ai, m) * NPROJ + PC_GATE + u.z * 2048 + colb + bj * 128);
            if (more) {
#pragma unroll
                for (int m = 0; m < 4; ++m)
#pragma unroll
                    for (int bj = 0; bj < 2; ++bj) gn[m][bj] = *(const u32x4*)(proj + (size_t)EPI_ROW(u, ai, m) * NPROJ + PC_GATE + u.z * 2048 + 2048 + colb + bj * 128);
            } else {
#pragma unroll
                for (int m = 0; m < 4; ++m)
#pragma unroll
                    for (int bj = 0; bj < 2; ++bj) gn[m][bj] = (u32x4){0x3f803f80u, 0x3f803f80u, 0x3f803f80u, 0x3f803f80u};
            }
#pragma unroll
            for (int m = 0; m < 4; ++m)
#pragma unroll
                for (int bj = 0; bj < 2; ++bj) { float a[8], b[8]; unpack8(gt[m][bj], a); unpack8(gn[m][bj], b);
#pragma unroll
                    for (int e = 0; e < 8; ++e) a[e] = fmaxf(a[e], 1e-30f) * __builtin_amdgcn_rcpf(fmaxf(b[e], 1e-30f));
#pragma unroll
                    for (int e = 0; e < 4; ++e) { acc[ai][bj][m][0][e] *= a[e]; acc[ai][bj][m][1][e] *= a[4 + e]; }
                    if (!more) store8_bf16(merged + (size_t)EPI_ROW(u, ai, m) * 2048 + colb + bj * 128, acc[ai][bj][m][0], acc[ai][bj][m][1]); }
        }
    }
};
struct EpiWout { static constexpr bool PERM = false, AFTER_DRAIN = false; const float* xres; float* X;
    __device__ __forceinline__ void operator()(const AccT& acc, const Unit& u, int wr, int wc, int fr, int fq) const {
        const int colb = u.pn * 256 + wc * 32 + fq * 4;
#pragma unroll
        for (int ai = 0; ai < 2; ++ai) {
            f32x4 r[4][2][2];
#pragma unroll
            for (int m = 0; m < 4; ++m)
#pragma unroll
                for (int bj = 0; bj < 2; ++bj)
#pragma unroll
                    for (int n = 0; n < 2; ++n) r[m][bj][n] = *(const f32x4*)(xres + (size_t)EPI_ROW(u, ai, m) * 2048 + colb + bj * 128 + n * 16);
#pragma unroll
            for (int m = 0; m < 4; ++m)
#pragma unroll
                for (int bj = 0; bj < 2; ++bj)
#pragma unroll
                    for (int n = 0; n < 2; ++n) *(f32x4*)(X + (size_t)EPI_ROW(u, ai, m) * 2048 + colb + bj * 128 + n * 16) = r[m][bj][n] + acc[ai][bj][m][n];
        }
    }
};
struct EpiE1 { static constexpr bool PERM = true, AFTER_DRAIN = false; bf16_t* H;
    __device__ __forceinline__ void operator()(const AccT& acc, const Unit& u, int wr, int wc, int fr, int fq) const {
#pragma unroll
        for (int ai = 0; ai < 2; ++ai)
#pragma unroll
            for (int m = 0; m < 4; ++m) { f32x4 h0, h1;
#pragma unroll
                for (int e = 0; e < 4; ++e) { const float g0 = acc[ai][0][m][0][e], g1 = acc[ai][0][m][1][e];
                    h0[e] = g0 * fast_sigmoid(g0) * acc[ai][1][m][0][e]; h1[e] = g1 * fast_sigmoid(g1) * acc[ai][1][m][1][e]; }
                store8_bf16(H + (size_t)EPI_ROW(u, ai, m) * 512 + u.z * 128 + wc * 32 + 8 * fq, h0, h1); }
    }
};
struct EpiE2 { static constexpr bool PERM = true, AFTER_DRAIN = false; bf16_t* Y;
    __device__ __forceinline__ void operator()(const AccT& acc, const Unit& u, int wr, int wc, int fr, int fq) const {
#pragma unroll
        for (int ai = 0; ai < 2; ++ai)
#pragma unroll
            for (int m = 0; m < 4; ++m) { bf16_t* rowp = Y + (size_t)EPI_ROW(u, ai, m) * 2048 + u.z * 256 + wc * 32 + 8 * fq;
#pragma unroll
                for (int bj = 0; bj < 2; ++bj) store8_bf16(rowp + bj * 128, acc[ai][bj][m][0], acc[ai][bj][m][1]); }
    }
};
struct EpiRouterPart { static constexpr bool PERM = false, AFTER_DRAIN = false; float* lgp;
    __device__ __forceinline__ void operator()(const AccT& acc, const Unit& u, int wr, int wc, int fr, int fq) const {
        if (wc < 3) {
#pragma unroll
            for (int ai = 0; ai < 2; ++ai)
#pragma unroll
                for (int m = 0; m < 4; ++m) { float* rowp = lgp + ((size_t)u.z * T + EPI_ROW(u, ai, m)) * 96 + wc * 32 + fq * 4;
#pragma unroll
                    for (int n = 0; n < 2; ++n) *(f32x4*)(rowp + n * 16) = acc[ai][0][m][n] + acc[ai][1][m][n]; } }
    }
};
struct SchedRouter { int G, vcu;
    __device__ __forceinline__ bool next(int i, Unit& u) const { const int L = i * G + vcu; if (L >= 256) return false;
        u.pm = L >> 2; u.am = u.pm; u.pn = 0; u.bn = 0; u.z = L & 3; u.akoff = u.z * 2048; u.bkoff = u.z * 2048; return true; } };
constexpr size_t MiB = 1u << 20;
constexpr size_t WS_CTL = 0, CTL_ZERO_BYTES = 1 * MiB;
constexpr size_t WS_MISC = 1 * MiB;
constexpr size_t WS_COS = WS_MISC, WS_SIN = WS_COS + (size_t)T * 16 * 4, WS_RSTDQ = WS_SIN + (size_t)T * 16 * 4, WS_RSTDKV = WS_RSTDQ + (size_t)T * 4,
                 WS_TOKE = WS_RSTDKV + (size_t)T * 4, WS_TOKW = WS_TOKE + (size_t)T * 8, WS_POS = WS_TOKW + (size_t)T * 8, WS_BLKE = WS_POS + (size_t)T * 8;
static_assert(WS_BLKE + 4096 <= 4 * MiB, "misc region");
constexpr size_t WS_ROWTOK = WS_BLKE + 4096;
static_assert(WS_ROWTOK + (size_t)MOE_ROWS * 4 <= 4 * MiB, "misc region");
constexpr size_t WS_WIN = 4 * MiB;
constexpr size_t SZ_WIN = (size_t)NPROJ * 2048 * 2;
constexpr size_t WS_WUQ = WS_WIN + 2 * SZ_WIN;
constexpr size_t SZ_WUQ = (size_t)1536 * 768 * 2;
constexpr size_t WS_WUKV = WS_WUQ + 2 * SZ_WUQ;
constexpr size_t SZ_WUKV = (size_t)2048 * 256 * 2;
constexpr size_t WS_WLORA = WS_WUKV + 2 * SZ_WUKV;
constexpr size_t SZ_WLORA = (size_t)3072 * 256 * 2;
constexpr size_t WS_WV1 = WS_WLORA + 2 * SZ_WLORA;
constexpr size_t WS_WV2 = WS_WV1 + (size_t)256 * 1024 * 2;
constexpr size_t WS_WBR = WS_WV2 + (size_t)1024 * 128 * 2;
constexpr size_t SZ_WBR = (size_t)3 * 2048 * 1024 * 2;
constexpr size_t WS_WOUT = WS_WBR + 2 * SZ_WBR;
constexpr size_t SZ_WOUT = (size_t)2048 * 2048 * 2;
constexpr size_t WS_WRT = WS_WOUT + 2 * SZ_WOUT;
constexpr size_t SZ_WRT = (size_t)256 * 4096 * 2;
constexpr size_t WS_WE1 = WS_WRT + 2 * SZ_WRT;
constexpr size_t WS_WE2 = WS_WE1 + (size_t)64 * 1024 * 2048 * 2;
constexpr size_t WS_REGA = WS_WE2 + (size_t)64 * 2048 * 512 * 2;
constexpr size_t WS_PROJ = WS_REGA;
constexpr size_t WS_QMLA = WS_PROJ + (size_t)T * NPROJ * 2;
constexpr size_t WS_KMLA = WS_QMLA + (size_t)T * 1536 * 2;
constexpr size_t WS_KPE = WS_KMLA + (size_t)T * 1024 * 2;
constexpr size_t WS_VMLA = WS_KMLA + (size_t)T * 1536 * 2;
constexpr size_t WS_REGA_END = WS_VMLA + (size_t)T * 1024 * 2;
constexpr size_t WS_APRIME = WS_REGA;
constexpr size_t WS_XG = WS_APRIME + (size_t)T * 4096 * 2;
constexpr size_t WS_HMOE = WS_XG + (size_t)MOE_ROWS * 2048 * 2;
constexpr size_t WS_Y = WS_HMOE + (size_t)MOE_ROWS * 512 * 2;
static_assert(WS_Y + (size_t)MOE_ROWS * 2048 * 2 <= WS_REGA_END, "MoE overlay fits region A");
constexpr size_t WS_X = WS_REGA_END;
constexpr size_t WS_H = WS_X + (size_t)T * 2048 * 4;
constexpr size_t WS_LGP = WS_H;
constexpr size_t WS_MERGED = WS_H + (size_t)T * 2048 * 2;
constexpr size_t WS_RK = WS_MERGED + (size_t)T * 2048 * 2;
constexpr size_t WS_VS = WS_RK + (size_t)T * 2048 * 2;
constexpr size_t WS_LORAIN = WS_VS + (size_t)2 * T * 1024 * 2;
constexpr size_t WS_LOGDEC = WS_LORAIN + (size_t)T * 768 * 2;
constexpr size_t WS_AIC = WS_LOGDEC + (size_t)T * 1024 * 4;
constexpr size_t WS_MACC = WS_LOGDEC;
constexpr size_t WS_GOUT = WS_AIC + (size_t)T * 1024 * 4;
constexpr size_t WS_T1 = WS_GOUT + (size_t)T * 1024 * 2;
constexpr size_t WS_VGATE = WS_T1 + (size_t)T * 128 * 2;
constexpr size_t WS_OALL = WS_VGATE + (size_t)T * 1024 * 2;
constexpr size_t WS_VMIX = WS_OALL + (size_t)3 * T * 1024 * 2;
constexpr size_t WS_BC = WS_VMIX + (size_t)T * 1024 * 2;
constexpr size_t WS_RWS = WS_BC + (size_t)T * 16 * 4;
constexpr size_t WS_END = WS_RWS + (size_t)4096 * 49152;
static_assert(WS_END <= (size_t)2048 * MiB, "workspace map fits 2 GiB");
static_assert(DEPTH == 2, "the phase program is written out for two layers");
constexpr int CW_BAR = 4096;
constexpr int CW_QHEAD = 8192;
constexpr int CW_CNT = 8448;
constexpr int CW_CUR = 8704;
constexpr int RING_BYTES = 131072, MISC_OFF = RING_BYTES + 4096 + 320, LDS_BYTES = 147456;
constexpr int NWAVES = 8;

#define XB_TMO      128
#define XB_XCNT(j)  (256  + 64 * (j))
#define XB_XSUB(j)  (1280 + 64 * (j))
#define XB_XGEN(j)  (2304 + 64 * (j))
#define XB_TOP      3328
#define XB_TOPGEN   3392
#define XCD_BAR_WORDS 3456
#define XB_SPIN_CAP (1u << 18)
__device__ __forceinline__ unsigned xb_ld(unsigned* p)              { return __hip_atomic_load(p, __ATOMIC_RELAXED, __HIP_MEMORY_SCOPE_AGENT); }
__device__ __forceinline__ unsigned xb_add(unsigned* p, unsigned v) { return __hip_atomic_fetch_add(p, v, __ATOMIC_RELAXED, __HIP_MEMORY_SCOPE_AGENT); }
__device__ __forceinline__ unsigned xb_xcc_id() { return (unsigned)__builtin_amdgcn_s_getreg((3 << 11) | 20) & 0xFu; }
#define XB_SPIN(cond, bar) do { unsigned _sp = 0; while (cond) { __builtin_amdgcn_s_sleep(1); \
    if ((++_sp & 255u) == 0u) { if (xb_ld(&(bar)[XB_TMO])) break; if (_sp > XB_SPIN_CAP) { atomicAdd(&(bar)[XB_TMO], 1u); break; } } } } while (0)
struct XcdBarrier { unsigned* bar; unsigned x; volatile LAS unsigned* st; };
__device__ __forceinline__ XcdBarrier xcd_barrier_post(unsigned* bar, volatile LAS unsigned* st, bool leader) {
    XcdBarrier b; b.bar = bar; b.x = xb_xcc_id(); b.st = st;
    if (leader) (void)xb_add(&bar[XB_XCNT(b.x)], 1u);
    return b;
}
__device__ __forceinline__ void xcd_barrier_complete(unsigned* bar, unsigned x, unsigned& nloc, unsigned& nx) {
    const unsigned G = gridDim.x * gridDim.y * gridDim.z;
    unsigned sum, cnt, mine, sp = 0u;
    for (;;) {
        sum = 0u; cnt = 0u; mine = 0u;
#pragma unroll
        for (unsigned j = 0; j < 16; ++j) { const unsigned c = xb_ld(&bar[XB_XCNT(j)]); sum += c; cnt += (c > 0u) ? 1u : 0u; mine = (j == x) ? c : mine; }
        if (sum == G) break;
        __builtin_amdgcn_s_sleep(1);
        if ((++sp & 255u) == 0u) { if (xb_ld(&bar[XB_TMO])) break; if (sp > XB_SPIN_CAP) { atomicAdd(&bar[XB_TMO], 1u); break; } }
    }
    nloc = mine > 0u ? mine : 1u; nx = cnt > 0u ? cnt : 1u;
}
__device__ __forceinline__ void xcd_barrier(const XcdBarrier& b, bool leader) {
    asm volatile("s_waitcnt vmcnt(0)" ::: "memory");
    __syncthreads();
    if (leader) {
        unsigned* bar = b.bar;
        __builtin_amdgcn_s_waitcnt(0);
        unsigned nloc = b.st[0], nx = b.st[1];
        if (nloc == 0u) { xcd_barrier_complete(bar, b.x, nloc, nx); b.st[0] = nloc; b.st[1] = nx; }
        const unsigned old = xb_add(&bar[XB_XSUB(b.x)], 1u);
        const unsigned gen = old / nloc;
        if (old + 1u == (gen + 1u) * nloc) {
            __builtin_amdgcn_fence(__ATOMIC_RELEASE, "agent");
            asm volatile("s_waitcnt vmcnt(0)" ::: "memory");
            const unsigned og = xb_add(&bar[XB_TOP], 1u);
            const unsigned tg = og / nx;
            if (og + 1u == (tg + 1u) * nx) xb_add(&bar[XB_TOPGEN], 1u);
            else XB_SPIN(xb_ld(&bar[XB_TOPGEN]) == tg, bar);
            __builtin_amdgcn_fence(__ATOMIC_ACQUIRE, "agent");
            xb_add(&bar[XB_XGEN(b.x)], 1u);
            asm volatile("s_waitcnt vmcnt(0)" ::: "memory");
        } else {
            XB_SPIN(xb_ld(&bar[XB_XGEN(b.x)]) == gen, bar);
            __builtin_amdgcn_fence(__ATOMIC_ACQUIRE, "agent");
            asm volatile("s_waitcnt vmcnt(0)" ::: "memory");
        }
    }
    __syncthreads();
}

struct Args { const void* in[35]; float* out; unsigned char* ws; int ph_lo, ph_hi; };
struct Frame {
    LAS unsigned char* lds; volatile LAS unsigned* MISC; unsigned* ctl; unsigned char* ws;
    int tid, lane, wave, vcu, G, gw, NGW;
};
#define LDS_WAIT() asm volatile("s_waitcnt lgkmcnt(0)" ::: "memory")
template <int IDX> __device__ __forceinline__ const void* kernarg_in() {
    const auto ka = __builtin_amdgcn_kernarg_segment_ptr(); unsigned long long r;
    asm volatile("s_load_dwordx2 %0, %1, %2\n\ts_waitcnt lgkmcnt(0)" : "=s"(r) : "s"(ka), "n"(IDX * 8));
    return (const void*)(const GAS void*)r;
}
#define ARGP(i) (kernarg_in<(i)>())
__device__ __forceinline__ unsigned char* launder(unsigned char* p) { unsigned long long v = (unsigned long long)p; asm volatile("" : "+s"(v)); return (unsigned char*)(GAS unsigned char*)v; }

__device__ __forceinline__ void conv_item(const float* W, int ldw, int Ksrc, int k0, int n0src, bf16_t* WT, int ldt, int row0dst, int kdst0, float scale, const float* kscale, bool lo_mode, LAS float* scr, int lane) {
#pragma unroll 16
    for (int i = 0; i < 32; ++i) { const int kk = 2 * i + (lane >> 5), k = k0 + kk; float v = 0.f;
        if (k < Ksrc) { v = W[(size_t)k * ldw + n0src + (lane & 31)] * scale; if (kscale) v *= kscale[k]; }
        if (lo_mode) v = v - bf2f(f2bf(v));
        scr[kk * 33 + (lane & 31)] = v; }
    LDS_WAIT(); asm volatile("" ::: "memory");
    const int c = lane & 7;
#pragma unroll
    for (int j = 0; j < 4; ++j) { const int n = (lane >> 3) + 8 * j; const LAS float* s = scr + (8 * c) * 33 + n;
        u32x4 o; o.x = pk2(s[0 * 33], s[1 * 33]); o.y = pk2(s[2 * 33], s[3 * 33]); o.z = pk2(s[4 * 33], s[5 * 33]); o.w = pk2(s[6 * 33], s[7 * 33]);
        *(u32x4*)(WT + (size_t)(row0dst + n) * ldt + kdst0 + k0 + 8 * c) = o; }
    LDS_WAIT(); asm volatile("" ::: "memory");
}
__device__ __forceinline__ void conv_job(Frame& F, int& base, const float* W, int ldw, int Ksrc, int Kdst, int col0, int ncols, bf16_t* WT, int ldt, int row0, int kdst0, float scale, const float* kscale, bool lo_mode) {
    LAS float* scr = (LAS float*)(F.lds + F.wave * 16384);
    const int nkb = Kdst / 64, nnb = ncols / 32, nitems = nkb * nnb;
    int it = (F.gw + F.NGW - (base % F.NGW)) % F.NGW; base += nitems;
    for (; it < nitems; it += F.NGW) { const int kb = it / nnb, nb = it % nnb;
        conv_item(W, ldw, Ksrc, kb * 64, col0 + nb * 32, WT, ldt, row0 + nb * 32, kdst0, scale, kscale, lo_mode, scr, F.lane); }
}
__device__ __forceinline__ void zero_rows(Frame& F, bf16_t* WT, int ldt, int row0, int nrows) {
    const size_t n16 = (size_t)nrows * ldt / 8; u32x4* p = (u32x4*)(WT + (size_t)row0 * ldt);
    for (size_t i = (size_t)F.gw * 64 + F.lane; i < n16; i += (size_t)F.NGW * 64) p[i] = (u32x4){0u, 0u, 0u, 0u};
}


constexpr int PANEL_PITCH = 1028;
struct PanelDesc { const float* W; bf16_t* WT; int ldw, k0, c0, ncols, ldt, kind, p0, p1; };
__device__ __forceinline__ void panel_map(const PanelDesc& d, int c, int& drow, float& sc) {
    sc = 1.f;
    if (d.kind == 0) drow = d.p0 * 1024 + 256 * (c >> 7) + 128 * d.p1 + (c & 127);
    else if (d.kind == 1) drow = d.p0 * 2048 + c;
    else if (d.kind == 2) { drow = c < 6336 ? c : c < 7616 ? c + 64 : c < 7648 ? c - 1280 : c + 32; sc = c < 1024 ? 0.125f * LOG2E : 1.f; }
    else drow = d.p0 + c;
}
__device__ __forceinline__ void panel_load(Frame& F, const PanelDesc& d, f32x4 (&v)[16]) {
#pragma unroll
    for (int i = 0; i < 16; ++i) { const int f = F.tid + 512 * i, kk = f >> 7, n4 = f & 127;
        v[i] = (4 * n4 < d.ncols) ? __builtin_nontemporal_load((const f32x4*)(d.W + (size_t)(d.k0 + kk) * d.ldw + d.c0 + 4 * n4)) : (f32x4){0.f, 0.f, 0.f, 0.f}; }
}
constexpr int PANEL_IMG = 64 * PANEL_PITCH;
static_assert(2 * PANEL_IMG <= RING_BYTES + 1024, "panel images");
__device__ __forceinline__ void panel_write(Frame& F, const f32x4 (&v)[16], int img) {
    const int tid = F.tid; LAS unsigned char* L = F.lds + img * PANEL_IMG;
#pragma unroll
    for (int i = 0; i < 16; ++i) { const int f = tid + 512 * i, kk = f >> 7, n4 = f & 127; LAS unsigned* o = (LAS unsigned*)(L + kk * PANEL_PITCH + n4 * 8);
        o[0] = cvt_pk_bf16(v[i][0], v[i][1]); o[1] = cvt_pk_bf16(v[i][2], v[i][3]); }
}
__device__ __forceinline__ void panel_read(Frame& F, const PanelDesc& d, int img) {
    const int tid = F.tid; const LAS unsigned char* L = F.lds + img * PANEL_IMG;
    const int c = tid & 7, nl = tid >> 3;
#pragma unroll
    for (int j = 0; j < 4; ++j) { const int n = 2 * nl + 128 * j;
        if (n < d.ncols) { int drow; float sc; panel_map(d, d.c0 + n, drow, sc);
            float x0[8], x1[8];
#pragma unroll
            for (int q = 0; q < 8; ++q) { const unsigned w = *(const LAS unsigned*)(L + (8 * c + q) * PANEL_PITCH + n * 2); x0[q] = bflo(w) * sc; x1[q] = bfhi(w) * sc; }
            u32x4 o0, o1; o0.x = pk2(x0[0], x0[1]); o0.y = pk2(x0[2], x0[3]); o0.z = pk2(x0[4], x0[5]); o0.w = pk2(x0[6], x0[7]);
            o1.x = pk2(x1[0], x1[1]); o1.y = pk2(x1[2], x1[3]); o1.z = pk2(x1[4], x1[5]); o1.w = pk2(x1[6], x1[7]);
            *(u32x4*)(d.WT + (size_t)drow * d.ldt + d.k0 + 8 * c) = o0; *(u32x4*)(d.WT + (size_t)(drow + 1) * d.ldt + d.k0 + 8 * c) = o1; } }
}
template <class DescFn>
__device__ __forceinline__ void run_panels(Frame& F, int first, int n, int stride, const DescFn& fn) {
    if (n <= 0) return;
    f32x4 va[16], vb[16]; PanelDesc da = fn(first), db = da;
    panel_load(F, da, va);
    if (n > 1) { db = fn(first + stride); panel_load(F, db, vb); }
    panel_write(F, va, 0);
    __syncthreads();
    for (int q = 0; q < n; q += 2) {
        PanelDesc dn = da; const bool h2 = q + 2 < n; if (h2) { dn = fn(first + (q + 2) * stride); panel_load(F, dn, va); }
        panel_read(F, da, 0);
        if (q + 1 < n) panel_write(F, vb, 1);
        __syncthreads();
        if (q + 1 >= n) break;
        PanelDesc dm = db; if (q + 3 < n) { dm = fn(first + (q + 3) * stride); panel_load(F, dm, vb); }
        panel_read(F, db, 1);
        if (h2) panel_write(F, va, 0);
        __syncthreads();
        da = dn; db = dm;
    }
}
__device__ __forceinline__ void router_conv(Frame& F, int& base, const float* rgw, const float* rew, bf16_t* WT) {
    LAS float* scr = (LAS float*)(F.lds + F.wave * 16384);
    const int nitems = 32 * 4 * 3;
    int it = (F.gw + F.NGW - (base % F.NGW)) % F.NGW; base += nitems;
    for (; it < nitems; it += F.NGW) { const int var = it / 128, r = it % 128, kb = r / 4, nb = r % 4, k0 = kb * 64, lane = F.lane;
#pragma unroll 8
        for (int i = 0; i < 32; ++i) { const int kk = 2 * i + (lane >> 5), k = k0 + kk, n = nb * 32 + (lane & 31); float v = 0.f;
            if (n < 8) v = rgw[(size_t)k * 8 + n]; else if (n < 72) v = rew[(size_t)k * 64 + (n - 8)];
            if (var == 2) v = v - bf2f(f2bf(v));
            scr[kk * 33 + (lane & 31)] = v; }
        LDS_WAIT(); asm volatile("" ::: "memory");
        const int c = lane & 7; const int row0 = (var == 2 ? 128 : 0) + nb * 32, kd0 = (var == 1 ? 2048 : 0);
#pragma unroll
        for (int j = 0; j < 4; ++j) { const int n = (lane >> 3) + 8 * j; const LAS float* s = scr + (8 * c) * 33 + n;
            u32x4 o; o.x = pk2(s[0 * 33], s[1 * 33]); o.y = pk2(s[2 * 33], s[3 * 33]); o.z = pk2(s[4 * 33], s[5 * 33]); o.w = pk2(s[6 * 33], s[7 * 33]);
            *(u32x4*)(WT + (size_t)(row0 + n) * 4096 + kd0 + k0 + 8 * c) = o; }
        LDS_WAIT(); asm volatile("" ::: "memory");
    }
    for (int i = F.gw * 64 + F.lane; i < 128 * 256; i += F.NGW * 64) { const int row = 128 + i / 256, c8 = i % 256; *(u32x4*)(WT + (size_t)row * 4096 + 2048 + c8 * 8) = (u32x4){0u, 0u, 0u, 0u}; }
}

struct P0Desc { unsigned char* ws; static constexpr int NP_WIN = 27 * 32, NP_BR = 4 * 16, NP_OUT = 4 * 32, NP_L = NP_WIN + 3 * NP_BR + NP_OUT;
    __device__ __forceinline__ PanelDesc operator()(int pi) const { const int l = pi / NP_L; int r = pi % NP_L; PanelDesc d; d.p1 = 0;
        if (r < NP_WIN) { const int cp = r % 27, kb = r / 27; d.c0 = cp * 512; d.ncols = (N_IN_SRC - d.c0) < 512 ? (N_IN_SRC - d.c0) : 512;
            d.W = (const float*)ARGP(3) + (size_t)l * 2048 * N_IN_SRC; d.ldw = N_IN_SRC; d.k0 = kb * 64; d.WT = (bf16_t*)(ws + WS_WIN + l * SZ_WIN); d.ldt = 2048; d.kind = 2; d.p0 = 0; return d; }
        r -= NP_WIN;
        if (r < 3 * NP_BR) { const int br = r / NP_BR, q = r % NP_BR, cp = q & 3, kb = q >> 2; d.W = (const float*)(br == 0 ? ARGP(22) : br == 1 ? ARGP(23) : ARGP(24)) + (size_t)l * 1024 * 2048;
            d.ldw = 2048; d.k0 = kb * 64; d.c0 = cp * 512; d.ncols = 512; d.WT = (bf16_t*)(ws + WS_WBR + l * SZ_WBR); d.ldt = 1024; d.kind = 3; d.p0 = br * 2048; return d; }
        r -= 3 * NP_BR;
        { const int cp = r & 3, kb = r >> 2; d.W = (const float*)ARGP(25) + (size_t)l * 2048 * 2048; d.ldw = 2048; d.k0 = kb * 64; d.c0 = cp * 512; d.ncols = 512;
          d.WT = (bf16_t*)(ws + WS_WOUT + l * SZ_WOUT); d.ldt = 2048; d.kind = 3; d.p0 = 0; return d; } } };
__device__ __forceinline__ void phase_convert(Frame& F, const Args& a) {
    int base = 0;
    for (int l = 0; l < DEPTH; ++l) {
        zero_rows(F, (bf16_t*)(F.ws + WS_WIN + l * SZ_WIN), 2048, PC_KPE + 32, 32);
        const float* wuq = (const float*)ARGP(19) + (size_t)l * 768 * 1536; bf16_t* WUQ = (bf16_t*)(F.ws + WS_WUQ + l * SZ_WUQ); const float* qg = (const float*)ARGP(18) + l * 768;
        const float qs = 0.10206207261596575f * LOG2E;
        for (int hd = 0; hd < 16; ++hd) { conv_job(F, base, wuq, 1536, 768, 768, hd * 96, 64, WUQ, 768, hd * 64, 0, qs, qg, false);
                                           conv_job(F, base, wuq, 1536, 768, 768, hd * 96 + 64, 32, WUQ, 768, 1024 + hd * 32, 0, qs, qg, false); }
        const float* wukv = (const float*)ARGP(21) + (size_t)l * 256 * 2048; bf16_t* WUKV = (bf16_t*)(F.ws + WS_WUKV + l * SZ_WUKV); const float* kvg = (const float*)ARGP(20) + l * 256;
        for (int hd = 0; hd < 16; ++hd) { conv_job(F, base, wukv, 2048, 256, 256, hd * 128, 64, WUKV, 256, hd * 64, 0, 1.f, kvg, false);
                                           conv_job(F, base, wukv, 2048, 256, 256, hd * 128 + 64, 64, WUKV, 256, 1024 + hd * 64, 0, 1.f, kvg, false); }
        bf16_t* WLORA = (bf16_t*)(F.ws + WS_WLORA + l * SZ_WLORA);
        conv_job(F, base, (const float*)ARGP(6) + (size_t)l * 96 * 1024, 1024, 96, 256, 0, 1024, WLORA, 256, 0, 0, 1.f, nullptr, false);
        conv_job(F, base, (const float*)ARGP(8) + (size_t)l * 96 * 1024, 1024, 96, 256, 0, 1024, WLORA, 256, 1024, 0, 1.f, nullptr, false);
        conv_job(F, base, (const float*)ARGP(9) + (size_t)l * 256 * 1024, 1024, 256, 256, 0, 1024, WLORA, 256, 2048, 0, 1.f, nullptr, false);
        router_conv(F, base, (const float*)ARGP(27) + (size_t)l * 2048 * 8, (const float*)ARGP(29) + (size_t)l * 2048 * 64, (bf16_t*)(F.ws + WS_WRT + l * SZ_WRT));
    }
    conv_job(F, base, (const float*)ARGP(16), 64, 1024, 1024, 0, 64, (bf16_t*)(F.ws + WS_WV1), 1024, 0, 0, 1.f, nullptr, false);
    zero_rows(F, (bf16_t*)(F.ws + WS_WV1), 1024, 64, 192);
    conv_job(F, base, (const float*)ARGP(17), 1024, 64, 128, 0, 1024, (bf16_t*)(F.ws + WS_WV2), 128, 0, 0, 1.f, nullptr, false);
    { const int* pos = (const int*)ARGP(1); float* cosb = (float*)(F.ws + WS_COS); float* sinb = (float*)(F.ws + WS_SIN);
      for (int i = F.gw * 64 + F.lane; i < T * 16; i += F.NGW * 64) { const int t = i >> 4, j = i & 15;
          const double fr4 = (j & 3) == 0 ? 1.0 : (j & 3) == 1 ? 0.5623413251903491 : (j & 3) == 2 ? 0.31622776601683794 : 0.1778279410038923;
          const double dec = (j >> 2) == 0 ? 1.0 : (j >> 2) == 1 ? 0.1 : (j >> 2) == 2 ? 0.01 : 0.001;
          const double rev = (double)pos[t] * fr4 * dec * 0.15915494309189535;
          const double fr = rev - __builtin_floor(rev);
          const float ang = (float)(fr * 6.283185307179586);
          cosb[i] = __cosf(ang); sinb[i] = __sinf(ang); } }
    __syncthreads();
    { P0Desc fn{F.ws}; const int np = (P0Desc::NP_L - F.vcu + F.G - 1) / F.G; run_panels(F, F.vcu, np, F.G, fn); }
}
constexpr int EC_PANELS = 64 * (2 * 32 + 8 * 4);
struct EcDesc { unsigned char* ws; int l;
    __device__ __forceinline__ PanelDesc operator()(int pidx) const { const int e = pidx / 96, r = pidx % 96; PanelDesc d;
        if (r < 64) { const int which = r >> 5, kb = r & 31; d.W = (const float*)(which ? ARGP(32) : ARGP(31)) + ((size_t)l * 64 + e) * 2048 * 512; d.WT = (bf16_t*)(ws + WS_WE1);
            d.ldw = 512; d.k0 = kb * 64; d.c0 = 0; d.ncols = 512; d.ldt = 2048; d.kind = 0; d.p0 = e; d.p1 = which; }
        else { const int rr = r - 64, kb = rr >> 2, nq = rr & 3; d.W = (const float*)ARGP(33) + ((size_t)l * 64 + e) * 512 * 2048; d.WT = (bf16_t*)(ws + WS_WE2);
            d.ldw = 2048; d.k0 = kb * 64; d.c0 = nq * 512; d.ncols = 512; d.ldt = 512; d.kind = 1; d.p0 = e; d.p1 = 0; }
        return d; } };

#ifndef DBG_NOMOE
#define DBG_NOMOE 0
#endif
template <int MODE>
__device__ __forceinline__ void phase_norm(Frame& F, const float* xin, float* X, const float* g, bf16_t* H, float* out, const bf16_t* Y, const int* pos, const float* tokw) {
    f32x4 gv[8];
    { const f32x4* gr = (const f32x4*)g + F.lane;
#pragma unroll
      for (int j = 0; j < 8; ++j) gv[j] = gr[64 * j]; }
    for (int t = F.gw; t < T; t += F.NGW) {
        f32x4 v[8]; float ss = 0.f;
        const f32x4* xr = (const f32x4*)(xin + (size_t)t * 2048) + F.lane;
#pragma unroll
        for (int j = 0; j < 8; ++j) v[j] = xr[64 * j];
        if ((MODE == 1 || MODE == 2) && !DBG_NOMOE) {
            const int p0 = pos[2 * t], p1 = pos[2 * t + 1]; const float w0 = tokw[2 * t], w1 = tokw[2 * t + 1];
            const bf16_t* y0 = Y + (size_t)p0 * 2048 + 4 * F.lane; const bf16_t* y1 = Y + (size_t)p1 * 2048 + 4 * F.lane;
#pragma unroll
            for (int j = 0; j < 8; ++j) { v[j] += w0 * load4_bf16(y0 + 256 * j) + w1 * load4_bf16(y1 + 256 * j); }
            if (MODE == 1) { f32x4* xw = (f32x4*)(X + (size_t)t * 2048) + F.lane;
#pragma unroll
                for (int j = 0; j < 8; ++j) xw[64 * j] = v[j]; }
        }
#pragma unroll
        for (int j = 0; j < 8; ++j) ss += (v[j][0] * v[j][0] + v[j][1] * v[j][1]) + (v[j][2] * v[j][2] + v[j][3] * v[j][3]);
        const float rstd = rsqrtf(wave_sum(ss) * (1.f / 2048.f) + NORM_EPS);
#pragma unroll
        for (int j = 0; j < 8; ++j) { const f32x4 o = v[j] * rstd * gv[j];
            if (MODE == 2) ((f32x4*)(out + (size_t)t * 2048) + F.lane)[64 * j] = o;
            else if (MODE == 3) { u32x2 hi; hi.x = pk2(o[0], o[1]); hi.y = pk2(o[2], o[3]);
                const f32x4 lo = (f32x4){o[0] - bflo(hi.x), o[1] - bfhi(hi.x), o[2] - bflo(hi.y), o[3] - bfhi(hi.y)};
                *(u32x2*)(H + (size_t)t * 4096 + 4 * F.lane + 256 * j) = hi; store4_bf16(H + (size_t)t * 4096 + 2048 + 4 * F.lane + 256 * j, lo); }
            else store4_bf16(H + (size_t)t * 2048 + 4 * F.lane + 256 * j, o); }
    }
}

__device__ __forceinline__ void shift8(const bf16_t* cur, const bf16_t* prv, bool has_prev, const float* mu, float (&o)[8]) {
    float c[8], p[8]; load8f(cur, c);
    if (has_prev) load8f(prv, p); else {
#pragma unroll
        for (int i = 0; i < 8; ++i) p[i] = 0.f; }
#pragma unroll
    for (int i = 0; i < 8; ++i) o[i] = c[i] + (p[i] - c[i]) * mu[i];
}
__device__ __forceinline__ void phase_prep(Frame& F, const Args& a, int l) {
    const bf16_t* PROJ = (const bf16_t*)(F.ws + WS_PROJ); bf16_t* RK = (bf16_t*)(F.ws + WS_RK); bf16_t* VS = (bf16_t*)(F.ws + WS_VS) + (size_t)l * T * 1024;
    bf16_t* LORAIN = (bf16_t*)(F.ws + WS_LORAIN); bf16_t* KPE = (bf16_t*)(F.ws + WS_KPE);
    float* rstdq = (float*)(F.ws + WS_RSTDQ); float* rstdkv = (float*)(F.ws + WS_RSTDKV);
    const float* cosb = (const float*)(F.ws + WS_COS); const float* sinb = (const float*)(F.ws + WS_SIN);
    const float* mu = (const float*)ARGP(4) + (size_t)l * RWKV_COLS; const int lane = F.lane, l31 = lane & 31, l15 = lane & 15;
    const bool isW = lane < 12, isA = lane >= 32 && lane < 44;
    const int offX = isW ? PC_WD + 8 * lane : isA ? PC_AD + 8 * (lane - 32) : PC_WD, muX = isW ? 3072 + 8 * lane : isA ? 3168 + 8 * (lane - 32) : 3072;
    const float lowf = lane < 32 ? 1.f : 0.f;
    f32x4 mm[6][2];
#pragma unroll
    for (int j = 0; j < 6; ++j) { mm[j][0] = *(const f32x4*)(mu + j * 512 + lane * 8); mm[j][1] = *(const f32x4*)(mu + j * 512 + lane * 8 + 4); }
    for (int t = F.gw; t < T; t += F.NGW) {
        const bool hp = (t % SEQ) != 0; const float hpf = hp ? 1.f : 0.f;
        const bf16_t* prow = PROJ + (size_t)t * NPROJ; const bf16_t* pprev = hp ? prow - NPROJ : prow;
        u32x4 cur[6], prv[6];
#pragma unroll
        for (int j = 0; j < 6; ++j) { cur[j] = *(const u32x4*)(prow + PC_RR + j * 512 + lane * 8); prv[j] = *(const u32x4*)(pprev + PC_RR + j * 512 + lane * 8); }
        const u32x4 xc = *(const u32x4*)(prow + offX), xp = *(const u32x4*)(pprev + offX), gc = *(const u32x4*)(prow + PC_GD + 8 * l31), gp = *(const u32x4*)(pprev + PC_GD + 8 * l31);
        const u32x4 q0 = *(const u32x4*)(prow + PC_CQ + 8 * lane), q1 = *(const u32x4*)(prow + PC_CQ + 512 + 8 * l31), kv = *(const u32x4*)(prow + PC_CKV + 8 * l31);
        const f32x4 mx0 = *(const f32x4*)(mu + muX), mx1 = *(const f32x4*)(mu + muX + 4), mg0 = *(const f32x4*)(mu + 3264 + 8 * l31), mg1 = *(const f32x4*)(mu + 3264 + 8 * l31 + 4);
        const float kx1 = bf2f(prow[PC_KPE + l15]), kx2 = bf2f(prow[PC_KPE + 16 + l15]), kcs = cosb[(size_t)t * 16 + l15], ksn = sinb[(size_t)t * 16 + l15];
#pragma unroll
        for (int j = 0; j < 6; ++j) { float c[8], pv[8], o[8]; unpack8(cur[j], c); unpack8(prv[j], pv);
#pragma unroll
            for (int i = 0; i < 8; ++i) o[i] = c[i] + (pv[i] * hpf - c[i]) * mm[j][i >> 2][i & 3];
            if (j < 4) store8f(RK + (size_t)t * 2048 + j * 512 + lane * 8, o); else store8f(VS + (size_t)t * 1024 + (j - 4) * 512 + lane * 8, o); }
        { float c[8], pv[8], o[8]; unpack8(xc, c); unpack8(xp, pv);
#pragma unroll
          for (int i = 0; i < 8; ++i) { const float m = i < 4 ? mx0[i & 3] : mx1[i & 3]; const float x = c[i] + (pv[i] * hpf - c[i]) * m;
              const float th = 1.0f - 2.0f * __builtin_amdgcn_rcpf(__expf(2.0f * x) + 1.0f); o[i] = isW ? th : isA ? x : 0.f; }
          store8f(LORAIN + (size_t)t * 768 + 8 * lane, o);
          unpack8(gc, c); unpack8(gp, pv);
#pragma unroll
          for (int i = 0; i < 8; ++i) { const float m = i < 4 ? mg0[i & 3] : mg1[i & 3]; o[i] = fast_sigmoid(c[i] + (pv[i] * hpf - c[i]) * m); }
          if (lane < 32) store8f(LORAIN + (size_t)t * 768 + 512 + 8 * lane, o); }
        { float a0[8], a1[8], a2[8], s1 = 0.f, s1b = 0.f, s2 = 0.f; unpack8(q0, a0); unpack8(q1, a1); unpack8(kv, a2);
#pragma unroll
          for (int i = 0; i < 8; ++i) { s1 += a0[i] * a0[i]; s1b += a1[i] * a1[i]; s2 += a2[i] * a2[i]; }
          s1 = wave_sum(s1 + s1b * lowf); s2 = wave_sum(s2 * lowf);
          if (lane == 0) { rstdq[t] = rsqrtf(s1 * (1.f / 768.f) + NORM_EPS); rstdkv[t] = rsqrtf(s2 * (1.f / 256.f) + NORM_EPS); } }
        if (lane < 16) { KPE[(size_t)t * 32 + lane] = (bf16_t)f2bf(kx1 * kcs - kx2 * ksn); KPE[(size_t)t * 32 + 16 + lane] = (bf16_t)f2bf(kx2 * kcs + kx1 * ksn); }
    }
}

__device__ __forceinline__ int crow(int r, int hi) { return (r & 3) + 8 * (r >> 2) + 4 * hi; }
__device__ __forceinline__ s16x4 vtr(const LAS unsigned char* p) { return __builtin_bit_cast(s16x4, __builtin_amdgcn_ds_read_tr16_b64_v4i16((LAS v4i16_t*)p)); }
#define MFMA32(a, b, c) __builtin_amdgcn_mfma_f32_32x32x16_bf16((a), (b), (c), 0, 0, 0)

__device__ __forceinline__ void pv_tile(f32x16 (&o)[2], const LAS unsigned char* Vbuf, const u32x4 (&pw)[4], int lane) {
    const int hi = lane >> 5; const LAS unsigned char* vb = Vbuf + ((lane >> 4) & 1) * 32 + (lane & 3) * 8 + (4 * hi + ((lane & 15) >> 2)) * 64;
#pragma unroll
    for (int d0 = 0; d0 < 2; ++d0)
#pragma unroll
        for (int s = 0; s < 4; ++s) { const s16x4 lo = vtr(vb + d0 * 4096 + s * 1024), hh = vtr(vb + d0 * 4096 + s * 1024 + 512);
            const bf16x8 vf = (bf16x8){lo[0], lo[1], lo[2], lo[3], hh[0], hh[1], hh[2], hh[3]};
            o[d0] = MFMA32(vf, __builtin_bit_cast(bf16x8, pw[s]), o[d0]); }
}
__device__ __forceinline__ void pack_p(u32x4 (&pw)[4], const f32x16& p0, const f32x16& p1) {
    pw[0] = (u32x4){cvt_pk_bf16(p0[0], p0[1]), cvt_pk_bf16(p0[2], p0[3]), cvt_pk_bf16(p0[4], p0[5]), cvt_pk_bf16(p0[6], p0[7])};
    pw[1] = (u32x4){cvt_pk_bf16(p0[8], p0[9]), cvt_pk_bf16(p0[10], p0[11]), cvt_pk_bf16(p0[12], p0[13]), cvt_pk_bf16(p0[14], p0[15])};
    pw[2] = (u32x4){cvt_pk_bf16(p1[0], p1[1]), cvt_pk_bf16(p1[2], p1[3]), cvt_pk_bf16(p1[4], p1[5]), cvt_pk_bf16(p1[6], p1[7])};
    pw[3] = (u32x4){cvt_pk_bf16(p1[8], p1[9]), cvt_pk_bf16(p1[10], p1[11]), cvt_pk_bf16(p1[12], p1[13]), cvt_pk_bf16(p1[14], p1[15])};
}
__device__ __forceinline__ void store_o(bf16_t* Orow, const f32x16 (&o)[2], float sc, int hi) {
#pragma unroll
    for (int d0 = 0; d0 < 2; ++d0)
#pragma unroll
        for (int rg = 0; rg < 4; ++rg) { const f32x4 v = (f32x4){o[d0][4 * rg] * sc, o[d0][4 * rg + 1] * sc, o[d0][4 * rg + 2] * sc, o[d0][4 * rg + 3] * sc};
            store4_bf16(Orow + 32 * d0 + 8 * rg + 4 * hi, v); }
}
__device__ __forceinline__ float other_half(float x, int hi) {
    auto rr = __builtin_amdgcn_permlane32_swap(__float_as_uint(x), __float_as_uint(x), false, false);
    return __uint_as_float(hi ? rr[0] : rr[1]);
}

constexpr float SB_DEAD_THR = 1e-30f;
__device__ __forceinline__ void glds16(const void* gsrc, unsigned lds_dst) { unsigned keep;
    asm volatile("s_mov_b32 %0, m0\n\ts_mov_b32 m0, %2\n\ts_nop 0\n\tglobal_load_lds_dwordx4 %1, off\n\ts_mov_b32 m0, %0" : "=&s"(keep) : "v"(gsrc), "s"(lds_dst) : "memory"); }
#define ATT_WAIT_BAR(N) asm volatile("s_waitcnt vmcnt(" #N ") lgkmcnt(0)\n\ts_barrier" ::: "memory")
__device__ __forceinline__ void attn_sb_unit(Frame& F, int b, int h, int qb, const bf16_t* PROJ, bf16_t* O) {
    const int lane = F.lane, wid = F.wave, r32 = lane & 31, hi = lane >> 5;
    const int q0 = qb * 256, qw0 = q0 + wid * 32; const size_t rowbase = (size_t)b * SEQ;
    const bf16_t* Qp = PROJ + (rowbase + qw0 + r32) * NPROJ + PC_SBQ + h * 64;
    bf16x8 qf[4];
#pragma unroll
    for (int d0 = 0; d0 < 4; ++d0) qf[d0] = *(const bf16x8*)(Qp + d0 * 16 + hi * 8);
    const bf16_t* Kg = PROJ + rowbase * NPROJ + PC_SBK + h * 64 + (size_t)lane * NPROJ + wid * 8;
    const bf16_t* Vg = PROJ + rowbase * NPROJ + PC_SBV + h * 64 + (size_t)(16 * (wid & 3) + (lane >> 2)) * NPROJ + (wid >> 2) * 32 + (lane & 3) * 8;
    constexpr int SLOT = 16384; const unsigned lds0 = (unsigned)(uintptr_t)F.lds;
    const int NT = 4 * qb + 4;
#define SB_ISSUE(itx) do { const int kt_ = NT - 1 - (itx); const unsigned so_ = (unsigned)__builtin_amdgcn_readfirstlane((int)(lds0 + ((itx) % 3) * SLOT + wid * 1024)); \
        glds16(Kg + (size_t)kt_ * 64 * NPROJ, so_); glds16(Vg + (size_t)kt_ * 64 * NPROJ, so_ + 8192); } while (0)
    SB_ISSUE(0); SB_ISSUE(1);
    f32x16 o[2]; o[0] = (f32x16){}; o[1] = (f32x16){}; float carry = 1.0f;
    const int tq = qw0 + r32;
    for (int it = 0; it < NT; ++it) {
        if (it + 1 < NT) ATT_WAIT_BAR(2); else ATT_WAIT_BAR(0);
        if (it > 0) { unsigned alld = 1u;
#pragma unroll
            for (int q = 0; q < 8; ++q) alld &= F.MISC[16 + ((it - 1) & 1) * 8 + q];
            if (alld) break; }
        if (it + 2 < NT) SB_ISSUE(it + 2);
        const int kt = NT - 1 - it, cur = (it % 3) * SLOT, k0 = kt * 64;
        if (k0 < qw0 + 31) {
            f32x16 p0, p1; const LAS unsigned char* kb = F.lds + cur + hi * 1024 + r32 * 16;
#pragma unroll
            for (int d0 = 0; d0 < 4; ++d0) { const bf16x8 b0 = *(const LAS bf16x8*)(kb + d0 * 2048), b1 = *(const LAS bf16x8*)(kb + d0 * 2048 + 512);
                if (d0 == 0) { p0 = MFMA32(b0, qf[0], (f32x16){}); p1 = MFMA32(b1, qf[0], (f32x16){}); } else { p0 = MFMA32(b0, qf[d0], p0); p1 = MFMA32(b1, qf[d0], p1); } }
#pragma unroll
            for (int r = 0; r < 16; ++r) { p0[r] = __builtin_amdgcn_rcpf(1.0f + __builtin_amdgcn_exp2f(p0[r])); p1[r] = __builtin_amdgcn_rcpf(1.0f + __builtin_amdgcn_exp2f(p1[r])); }
            if (k0 + 63 >= qw0) {
#pragma unroll
                for (int r = 0; r < 16; ++r) { const int key = k0 + crow(r, hi); if (key >= tq) p0[r] = 1.0f; if (key + 32 >= tq) p1[r] = 1.0f; } }
            float tot[8], toto[8];
#pragma unroll
            for (int g = 0; g < 4; ++g) { tot[g] = (p0[4 * g] * p0[4 * g + 1]) * (p0[4 * g + 2] * p0[4 * g + 3]); tot[4 + g] = (p1[4 * g] * p1[4 * g + 1]) * (p1[4 * g + 2] * p1[4 * g + 3]); }
#pragma unroll
            for (int g = 0; g < 8; ++g) toto[g] = other_half(tot[g], hi);
            float A = carry;
#pragma unroll
            for (int g = 7; g >= 0; --g) {
                const float ag = hi ? A : A * toto[g]; A *= tot[g] * toto[g];
                float e = ag;
                if (g >= 4) { const int r = 4 * (g - 4);
                    const float k3 = p1[r + 3], k2 = p1[r + 2], k1 = p1[r + 1], k0_ = p1[r];
                    p1[r + 3] = (1.0f - k3) * e; e *= k3; p1[r + 2] = (1.0f - k2) * e; e *= k2; p1[r + 1] = (1.0f - k1) * e; e *= k1; p1[r] = (1.0f - k0_) * e;
                } else { const int r = 4 * g;
                    const float k3 = p0[r + 3], k2 = p0[r + 2], k1 = p0[r + 1], k0_ = p0[r];
                    p0[r + 3] = (1.0f - k3) * e; e *= k3; p0[r + 2] = (1.0f - k2) * e; e *= k2; p0[r + 1] = (1.0f - k1) * e; e *= k1; p0[r] = (1.0f - k0_) * e; }
            }
            carry = A;
            u32x4 pw[4]; pack_p(pw, p0, p1);
            pv_tile(o, F.lds + cur + 8192, pw, lane);
        }
        { const unsigned dflag = __all(carry < SB_DEAD_THR) ? 1u : 0u; if (lane == 0) F.MISC[16 + (it & 1) * 8 + wid] = dflag; }
    }
#undef SB_ISSUE
    ATT_WAIT_BAR(0);
    store_o(O + (rowbase + qw0 + r32) * 1024 + h * 64, o, 1.0f, hi);
}

__device__ __forceinline__ float max3f(float a, float b, float c) { float r; asm("v_max3_f32 %0, %1, %2, %3" : "=v"(r) : "v"(a), "v"(b), "v"(c)); return r; }
__device__ __forceinline__ float max2f(float a, float b) { float r; asm("v_max_f32_e32 %0, %1, %2" : "=v"(r) : "v"(a), "v"(b)); return r; }
__device__ __forceinline__ void attn_mla_unit(Frame& F, int b, int h, int qb, const bf16_t* Q, const bf16_t* Kt, const bf16_t* Kpe, const bf16_t* Vt, bf16_t* O) {
    const int lane = F.lane, wid = F.wave, r32 = lane & 31, hi = lane >> 5;
    const int q0 = qb * 256, qw0 = q0 + wid * 32; const size_t rowbase = (size_t)b * SEQ;
    const bf16_t* Qp = Q + (rowbase + qw0 + r32) * 1536 + h * 96;
    bf16x8 qf[6];
#pragma unroll
    for (int d0 = 0; d0 < 6; ++d0) qf[d0] = *(const bf16x8*)(Qp + d0 * 16 + hi * 8);
    const bf16_t* Kg = Kt + rowbase * 1024 + h * 64 + (size_t)lane * 1024 + wid * 8;
    const bf16_t* Kp = Kpe + rowbase * 32 + (size_t)lane * 32 + (wid & 3) * 8;
    const bf16_t* Vg = Vt + rowbase * 1024 + h * 64 + (size_t)(16 * (wid & 3) + (lane >> 2)) * 1024 + (wid >> 2) * 32 + (lane & 3) * 8;
    const bool two = wid < 4; constexpr int SLOT = 20480; const unsigned lds0 = (unsigned)(uintptr_t)F.lds;
    const int NT = 4 * qb + 4;
#define MLA_ISSUE(itx) do { const int kt_ = (itx); const unsigned so_ = (unsigned)__builtin_amdgcn_readfirstlane((int)(lds0 + ((itx) & 3) * SLOT + wid * 1024)); \
        glds16(Kg + (size_t)kt_ * 64 * 1024, so_); if (two) glds16(Kp + (size_t)kt_ * 64 * 32, so_ + 8192); glds16(Vg + (size_t)kt_ * 64 * 1024, so_ + 12288); } while (0)
#define MLA_QK(P0, P1, kt_) do { const int k0_ = (kt_) * 64; const LAS unsigned char* kb = F.lds + ((kt_) & 3) * SLOT + hi * 1024 + r32 * 16; \
        _Pragma("unroll") for (int d0 = 0; d0 < 6; ++d0) { const bf16x8 b0 = *(const LAS bf16x8*)(kb + d0 * 2048), b1 = *(const LAS bf16x8*)(kb + d0 * 2048 + 512); \
            if (d0 == 0) { P0 = MFMA32(b0, qf[0], negm); P1 = MFMA32(b1, qf[0], negm); } else { P0 = MFMA32(b0, qf[d0], P0); P1 = MFMA32(b1, qf[d0], P1); } } \
        if (k0_ + 63 > qw0) { _Pragma("unroll") for (int r = 0; r < 16; ++r) { const int key = k0_ + crow(r, hi); if (key > tq) P0[r] = -INFINITY; if (key + 32 > tq) P1[r] = -INFINITY; } } } while (0)
#define MLA_SM_PV(P0, P1, N0, N1, kt_) do { asm volatile("s_nop 15\n\ts_nop 7" : "+v"(P0), "+v"(P1)); \
        float ma = max3f(P0[0], P0[1], P1[0]), mb = max3f(P0[2], P0[3], P1[1]); ma = max3f(ma, P1[2], P1[3]); \
        _Pragma("unroll") for (int r = 4; r < 16; r += 4) { ma = max3f(ma, P0[r], P0[r + 1]); mb = max3f(mb, P0[r + 2], P0[r + 3]); ma = max3f(ma, P1[r], P1[r + 1]); mb = max3f(mb, P1[r + 2], P1[r + 3]); } \
        float mx = max2f(ma, mb); mx = max2f(mx, other_half(mx, hi)); \
        if (first || __any(mx > 8.0f)) { const float dl = first ? mx : fmaxf(mx, 0.f); const float f = first ? 1.0f : __builtin_amdgcn_exp2f(-dl); first = false; mref += dl; lrun *= f; \
            _Pragma("unroll") for (int r = 0; r < 16; ++r) { P0[r] -= dl; P1[r] -= dl; N0[r] -= dl; N1[r] -= dl; o[0][r] *= f; o[1][r] *= f; negm[r] = -mref; } } \
        float ls0 = 0.f, ls1 = 0.f; \
        _Pragma("unroll") for (int r = 0; r < 16; ++r) { P0[r] = __builtin_amdgcn_exp2f(P0[r]); P1[r] = __builtin_amdgcn_exp2f(P1[r]); ls0 += P0[r]; ls1 += P1[r]; } \
        lrun += ls0 + ls1; u32x4 pw[4]; pack_p(pw, P0, P1); pv_tile(o, F.lds + ((kt_) & 3) * SLOT + 12288, pw, lane); } while (0)
#define MLA_STEP(t_, PA0, PA1, PB0, PB1) do { if ((t_) + 2 < NT) { if (two) ATT_WAIT_BAR(3); else ATT_WAIT_BAR(2); } else ATT_WAIT_BAR(0); \
        if ((t_) + 3 < NT) MLA_ISSUE((t_) + 3); \
        if ((t_) + 1 < nact) { MLA_QK(PB0, PB1, (t_) + 1); } \
        if ((t_) < nact) { MLA_SM_PV(PA0, PA1, PB0, PB1, (t_)); } } while (0)
    MLA_ISSUE(0); MLA_ISSUE(1); MLA_ISSUE(2);
    f32x16 o[2]; o[0] = (f32x16){}; o[1] = (f32x16){}; float mref = 0.f, lrun = 0.f; f32x16 negm = (f32x16){};
    const int tq = qw0 + r32; bool first = true; f32x16 pa0, pa1, pb0 = (f32x16){}, pb1 = (f32x16){};
    const int nact = (qw0 + 31) / 64 + 1;
    if (two) ATT_WAIT_BAR(6); else ATT_WAIT_BAR(4);
    MLA_QK(pa0, pa1, 0);
    for (int kt = 0; kt < NT; kt += 2) { MLA_STEP(kt, pa0, pa1, pb0, pb1); MLA_STEP(kt + 1, pb0, pb1, pa0, pa1); }
#undef MLA_ISSUE
#undef MLA_QK
#undef MLA_SM_PV
#undef MLA_STEP
    ATT_WAIT_BAR(0);
    const float ltot = lrun + other_half(lrun, hi);
    store_o(O + (rowbase + qw0 + r32) * 1024 + h * 64, o, __builtin_amdgcn_rcpf(ltot), hi);
}

namespace rw {
constexpr int RM = 136;
constexpr int L_AT = 0, L_RT = 8704, L_BT = 17408, L_KT = 26112, L_Q = 34816, L_PK0 = 43520, L_PK1 = 52224, L_T = 60928;
constexpr int L_N = L_AT, L_M = L_BT, L_P = L_KT;
constexpr int L_ATV = 69632, L_VV = 77824, L_BHV = 86016, L_KHV = 94208;
constexpr int L_LW = 102400, L_GT = 118784, L_WC = 120832;
static_assert(L_WC + 256 <= RING_BYTES, "rwkv chunk LDS map");
constexpr size_t CH_G = 0, CH_H = 8192, CH_RF = 24576, CH_YF = 32768, CH_ZF = 40960, CH_BYTES = 49152;
#define RW_BAR() asm volatile("s_waitcnt vmcnt(0) lgkmcnt(0)\n\ts_barrier" ::: "memory")

__device__ __forceinline__ bf16x8 frag_rm(const LAS unsigned char* img, int row, int s4, int hi) {
    const LAS unsigned char* p = img + row * RM + s4 * 32 + hi * 8;
    const u32x2 a = *(const LAS u32x2*)p, b = *(const LAS u32x2*)(p + 16);
    return __builtin_bit_cast(bf16x8, (u32x4){a.x, a.y, b.x, b.y});
}
__device__ __forceinline__ bf16x8 frag_vi(const LAS unsigned char* img, int cb, int s4, int lane) {
    const int hi = lane >> 5; const LAS unsigned char* vb = img + ((lane >> 4) & 1) * 32 + (lane & 3) * 8 + (4 * hi + ((lane & 15) >> 2)) * 64 + cb * 4096 + s4 * 1024;
    const s16x4 lo = vtr(vb), hh = vtr(vb + 512); return (bf16x8){lo[0], lo[1], lo[2], lo[3], hh[0], hh[1], hh[2], hh[3]};
}
template <int HALF> __device__ __forceinline__ bf16x8 frag_acc(const f32x16& t) {
    const u32x4 w = (u32x4){cvt_pk_bf16(t[8 * HALF + 0], t[8 * HALF + 1]), cvt_pk_bf16(t[8 * HALF + 2], t[8 * HALF + 3]), cvt_pk_bf16(t[8 * HALF + 4], t[8 * HALF + 5]), cvt_pk_bf16(t[8 * HALF + 6], t[8 * HALF + 7])};
    return __builtin_bit_cast(bf16x8, w);
}
__device__ __forceinline__ void frags_of(bf16x8 (&f)[4], const f32x16 (&X)[2]) { f[0] = frag_acc<0>(X[0]); f[1] = frag_acc<1>(X[0]); f[2] = frag_acc<0>(X[1]); f[3] = frag_acc<1>(X[1]); }
__device__ __forceinline__ void tile_to_rm(LAS unsigned char* img, const f32x16& t, int mb, int nb, int r32, int hi) {
#pragma unroll
    for (int r = 0; r < 16; ++r) *(LAS bf16_t*)(img + (32 * mb + crow(r, hi)) * RM + (32 * nb + r32) * 2) = (bf16_t)f2bf(t[r]);
}

struct ChunkIn { u32x4 r, k, v, vf, gt; f32x4 a0, a1, l0, l1; };
struct ChunkPar { f32x4 p0[2], p1[2], p2[2]; };
__device__ __forceinline__ void chunk_par(Frame& F, int l, int cidx, ChunkPar& cp) {
    const int h = (cidx >> 6) & 15, gch = h * 64 + (F.tid & 7) * 8;
    { const f32x4* p = (const f32x4*)((const float*)ARGP(10) + l * 1024 + gch); cp.p0[0] = p[0]; cp.p0[1] = p[1]; }
    { const f32x4* p = (const f32x4*)((const float*)ARGP(11) + l * 1024 + gch); cp.p1[0] = p[0]; cp.p1[1] = p[1]; }
    { const f32x4* p = (const f32x4*)((const float*)ARGP(12) + l * 1024 + gch); cp.p2[0] = p[0]; cp.p2[1] = p[1]; }
}
__device__ __forceinline__ void chunk_fetch(Frame& F, int l, int cidx, ChunkIn& in) {
    const int tid = F.tid, bh = cidx >> 6, c = cidx & 63, b = bh >> 4, h = bh & 15, t = tid >> 3, cg = tid & 7, gch = h * 64 + cg * 8; const size_t row = (size_t)b * SEQ + c * 64 + t;
    const bf16_t* RK = (const bf16_t*)(F.ws + WS_RK); const bf16_t* VS = (const bf16_t*)(F.ws + WS_VS) + (size_t)l * T * 1024;
    in.r = *(const u32x4*)(RK + row * 2048 + gch); in.k = *(const u32x4*)(RK + row * 2048 + 1024 + gch); in.v = *(const u32x4*)(VS + row * 1024 + gch);
    if (l > 0) { in.vf = *(const u32x4*)((const bf16_t*)(F.ws + WS_VS) + row * 1024 + gch); in.gt = *(const u32x4*)((const bf16_t*)(F.ws + WS_VGATE) + row * 1024 + gch); }
    else { in.vf = in.v; in.gt = in.v; }
    const f32x4* pa = (const f32x4*)((const float*)(F.ws + WS_AIC) + row * 1024 + gch); in.a0 = pa[0]; in.a1 = pa[1];
    const f32x4* pl = (const f32x4*)((const float*)(F.ws + WS_LOGDEC) + row * 1024 + gch); in.l0 = pl[0]; in.l1 = pl[1];
}
__device__ __forceinline__ void chunk_unit(Frame& F, int l, int cidx, const ChunkIn& in, const ChunkPar& cp) {
    const int tid = F.tid, lane = F.lane, w = F.wave, r32 = lane & 31, hi = lane >> 5;
    const int bh = cidx >> 6, c = cidx & 63, b = bh >> 4, h = bh & 15;
    LAS unsigned char* L = F.lds;
    unsigned char* gs = F.ws + WS_RWS + (size_t)cidx * CH_BYTES;
    {
        const int t = tid >> 3, cg = tid & 7, ch0 = cg * 8, gch = h * 64 + ch0; const size_t row = (size_t)b * SEQ + c * 64 + t;
        float r[8], k[8], v[8], aa[8], ld[8], kc[8];
        unpack8(in.r, r); unpack8(in.k, k); unpack8(in.v, v);
        if (l > 0) { float vf[8], gt[8]; unpack8(in.vf, vf); unpack8(in.gt, gt);
#pragma unroll
            for (int i = 0; i < 8; ++i) v[i] = v[i] + (vf[i] - v[i]) * gt[i]; }
#pragma unroll
        for (int i = 0; i < 4; ++i) { aa[i] = in.a0[i]; aa[4 + i] = in.a1[i]; ld[i] = in.l0[i]; ld[4 + i] = in.l1[i]; }
        float kk[8], kmod[8]; float n2 = 0.f, bc = 0.f;
        { const f32x4 c0 = cp.p0[0], c1 = cp.p0[1];
#pragma unroll
          for (int i = 0; i < 4; ++i) { kc[i] = c0[i]; kc[4 + i] = c1[i]; } }
#pragma unroll
        for (int i = 0; i < 8; ++i) { kk[i] = k[i] * kc[i]; n2 += kk[i] * kk[i]; }
        { const f32x4 c0 = cp.p1[0], c1 = cp.p1[1];
#pragma unroll
          for (int i = 0; i < 4; ++i) { kc[i] = c0[i]; kc[4 + i] = c1[i]; } }
#pragma unroll
        for (int i = 0; i < 8; ++i) kmod[i] = k[i] * (1.0f + (aa[i] - 1.0f) * kc[i]);
        { const f32x4 c0 = cp.p2[0], c1 = cp.p2[1];
#pragma unroll
          for (int i = 0; i < 4; ++i) { kc[i] = c0[i]; kc[4 + i] = c1[i]; } }
#pragma unroll
        for (int i = 0; i < 8; ++i) bc += r[i] * kmod[i] * kc[i];
        n2 = sum8(n2); bc = sum8(bc);
        const float inv = 1.0f / fmaxf(sqrtf(n2), 1e-12f);
        if (cg == 0) ((float*)(F.ws + WS_BC))[row * 16 + h] = bc;
        store8f((bf16_t*)(F.ws + WS_VMIX) + row * 1024 + gch, v);
        LAS float* LW = (LAS float*)(L + L_LW); LAS float* GT = (LAS float*)(L + L_GT);
#pragma unroll
        for (int i = 0; i < 8; ++i) LW[t * 64 + ch0 + i] = ld[i];
        RW_BAR();
        { const int ch = tid & 63, tq = tid >> 6; float run = 0.f;
#pragma unroll
          for (int i = 0; i < 8; ++i) { run += LW[(8 * tq + i) * 64 + ch]; LW[(8 * tq + i) * 64 + ch] = run; }
          GT[tq * 64 + ch] = run; }
        RW_BAR();
        float lc[8], tot[8];
#pragma unroll
        for (int i = 0; i < 8; ++i) { lc[i] = LW[t * 64 + ch0 + i]; tot[i] = 0.f; }
#pragma unroll
        for (int q = 0; q < 8; ++q) {
#pragma unroll
            for (int i = 0; i < 8; ++i) { const float g = GT[q * 64 + ch0 + i]; tot[i] += g; if (q < (t >> 3)) lc[i] += g; } }
        float At[8], Rt[8], Bt[8], Kt[8], Bh[8], Kh[8];
#pragma unroll
        for (int i = 0; i < 8; ++i) { const float wi = __expf(lc[i]), we = __expf(lc[i] - ld[i]), wn = __expf(-lc[i]), wr = __expf(tot[i] - lc[i]);
            const float ap = -kk[i] * inv, bp = kk[i] * inv * aa[i];
            At[i] = ap * we; Rt[i] = r[i] * wi; Bt[i] = bp * wn; Kt[i] = kmod[i] * wn; Bh[i] = bp * wr; Kh[i] = kmod[i] * wr; }
        const int rmo = t * RM + cg * 16, vio = ((cg >> 2) * 4 + (t >> 4)) * 1024 + (t & 15) * 64 + (cg & 3) * 16;
        { u32x4 x;
          x = (u32x4){pk2(At[0], At[1]), pk2(At[2], At[3]), pk2(At[4], At[5]), pk2(At[6], At[7])}; *(LAS u32x2*)(L + L_AT + rmo) = (u32x2){x.x, x.y}; *(LAS u32x2*)(L + L_AT + rmo + 8) = (u32x2){x.z, x.w}; *(LAS u32x4*)(L + L_ATV + vio) = x;
          x = (u32x4){pk2(Rt[0], Rt[1]), pk2(Rt[2], Rt[3]), pk2(Rt[4], Rt[5]), pk2(Rt[6], Rt[7])}; *(LAS u32x2*)(L + L_RT + rmo) = (u32x2){x.x, x.y}; *(LAS u32x2*)(L + L_RT + rmo + 8) = (u32x2){x.z, x.w};
          x = (u32x4){pk2(Bt[0], Bt[1]), pk2(Bt[2], Bt[3]), pk2(Bt[4], Bt[5]), pk2(Bt[6], Bt[7])}; *(LAS u32x2*)(L + L_BT + rmo) = (u32x2){x.x, x.y}; *(LAS u32x2*)(L + L_BT + rmo + 8) = (u32x2){x.z, x.w};
          x = (u32x4){pk2(Kt[0], Kt[1]), pk2(Kt[2], Kt[3]), pk2(Kt[4], Kt[5]), pk2(Kt[6], Kt[7])}; *(LAS u32x2*)(L + L_KT + rmo) = (u32x2){x.x, x.y}; *(LAS u32x2*)(L + L_KT + rmo + 8) = (u32x2){x.z, x.w};
          x = (u32x4){pk2(v[0], v[1]), pk2(v[2], v[3]), pk2(v[4], v[5]), pk2(v[6], v[7])}; *(LAS u32x4*)(L + L_VV + vio) = x;
          x = (u32x4){pk2(Bh[0], Bh[1]), pk2(Bh[2], Bh[3]), pk2(Bh[4], Bh[5]), pk2(Bh[6], Bh[7])}; *(LAS u32x4*)(L + L_BHV + vio) = x;
          x = (u32x4){pk2(Kh[0], Kh[1]), pk2(Kh[2], Kh[3]), pk2(Kh[4], Kh[5]), pk2(Kh[6], Kh[7])}; *(LAS u32x4*)(L + L_KHV + vio) = x; }
        if (t == 0) { LAS float* WC = (LAS float*)(L + L_WC);
#pragma unroll
            for (int i = 0; i < 8; ++i) WC[ch0 + i] = __expf(tot[i]); }
        RW_BAR();
    }
#ifndef RWDBG
#define RWDBG 9
#endif
    if (RWDBG < 1) return;
    __builtin_amdgcn_sched_barrier(0);
    f32x16 X0[2];
    { const int mat = w >> 1, nb = w & 1; const LAS unsigned char* Ai = L + ((mat < 2) ? L_AT : L_RT); const LAS unsigned char* Bi = L + ((mat & 1) ? L_KT : L_BT);
      X0[0] = (f32x16){}; X0[1] = (f32x16){};
#pragma unroll
      for (int s4 = 0; s4 < 4; ++s4) { const bf16x8 bf = frag_rm(Bi, 32 * nb + r32, s4, hi);
#pragma unroll
          for (int mb = 0; mb < 2; ++mb) X0[mb] = MFMA32(frag_rm(Ai, 32 * mb + r32, s4, hi), bf, X0[mb]); __builtin_amdgcn_sched_barrier(0); }
      const int scol = 32 * nb + r32;
#pragma unroll
      for (int mb = 0; mb < 2; ++mb)
#pragma unroll
          for (int r = 0; r < 16; ++r) { const int trow = 32 * mb + crow(r, hi); const bool keep = (mat < 2) ? (scol < trow) : (scol <= trow); X0[mb][r] = keep ? X0[mb][r] : 0.f; }
      RW_BAR();
      LAS unsigned char* Oi = L + (mat == 0 ? L_N : mat == 1 ? L_M : mat == 2 ? L_P : L_Q);
      tile_to_rm(Oi, X0[0], 0, nb, r32, hi); tile_to_rm(Oi, X0[1], 1, nb, r32, hi);
      RW_BAR(); }
    if (RWDBG < 2) return;
    if (w < 2 && RWDBG != 3 && RWDBG != 4) {
        f32x16 P = (w == 0) ? X0[0] : X0[1]; f32x16 Tt = P;
#pragma unroll
        for (int r = 0; r < 16; ++r) if (crow(r, hi) == r32) Tt[r] += 1.0f;
        LAS unsigned char* own = L + (w == 0 ? L_PK0 : L_PK1);
#pragma unroll
        for (int k = 0; k < 5; ++k) {
            const LAS unsigned char* Ai = (k == 0) ? (const LAS unsigned char*)(L + L_N) : (const LAS unsigned char*)own;
            const bf16x8 bP0 = frag_acc<0>(P), bP1 = frag_acc<1>(P), bT0 = frag_acc<0>(Tt), bT1 = frag_acc<1>(Tt);
            const bf16x8 af0 = frag_rm(Ai, 32 * w + r32, 2 * w, hi), af1 = frag_rm(Ai, 32 * w + r32, 2 * w + 1, hi);
            if (k > 0) { Tt = MFMA32(af0, bT0, Tt); Tt = MFMA32(af1, bT1, Tt); }
            if (k < 4) { f32x16 nP = MFMA32(af0, bP0, (f32x16){}); nP = MFMA32(af1, bP1, nP); P = nP; tile_to_rm(own, P, w, w, r32, hi); }
            __builtin_amdgcn_sched_barrier(0);
        }
        f32x16 Y = (f32x16){};
        if (w == 0) { Y = MFMA32(frag_rm(L + L_N, 32 + r32, 0, hi), frag_acc<0>(Tt), Y); Y = MFMA32(frag_rm(L + L_N, 32 + r32, 1, hi), frag_acc<1>(Tt), Y); tile_to_rm(L + L_T, Tt, 0, 0, r32, hi); }
        else { tile_to_rm(L + L_T, Tt, 1, 1, r32, hi); const f32x16 zt = (f32x16){}; tile_to_rm(L + L_T, zt, 0, 1, r32, hi); }
        RW_BAR();
        if (w == 0) { f32x16 T21 = MFMA32(frag_rm(L + L_T, 32 + r32, 2, hi), frag_acc<0>(Y), (f32x16){}); T21 = MFMA32(frag_rm(L + L_T, 32 + r32, 3, hi), frag_acc<1>(Y), T21); tile_to_rm(L + L_T, T21, 1, 0, r32, hi); }
        RW_BAR();
        RW_BAR();
    } else if (w < 4 && RWDBG != 2 && RWDBG != 4) {
        const int ib = w - 2; f32x16 MV[2], Y[2], Hh[2];
        MV[0] = (f32x16){}; MV[1] = (f32x16){}; Y[0] = (f32x16){}; Y[1] = (f32x16){}; Hh[0] = (f32x16){}; Hh[1] = (f32x16){};
#pragma unroll
        for (int s4 = 0; s4 < 4; ++s4) { const bf16x8 vf = frag_vi(L + L_VV, ib, s4, lane);
#pragma unroll
            for (int q = 0; q < 2; ++q) { MV[q] = MFMA32(frag_rm(L + L_M, 32 * q + r32, s4, hi), vf, MV[q]);
                Y[q] = MFMA32(vf, frag_rm(L + L_Q, 32 * q + r32, s4, hi), Y[q]);
                Hh[q] = MFMA32(frag_vi(L + L_KHV, q, s4, lane), vf, Hh[q]); __builtin_amdgcn_sched_barrier(0); } }
        RW_BAR(); RW_BAR();
        f32x16 U0[2]; U0[0] = (f32x16){}; U0[1] = (f32x16){};
        { bf16x8 bm[4]; frags_of(bm, MV);
#pragma unroll
          for (int s4 = 0; s4 < 4; ++s4)
#pragma unroll
              for (int mb = 0; mb < 2; ++mb) { U0[mb] = MFMA32(frag_rm(L + L_T, 32 * mb + r32, s4, hi), bm[s4], U0[mb]); __builtin_amdgcn_sched_barrier(0); } }
        { bf16x8 bu[4]; frags_of(bu, U0);
#pragma unroll
          for (int s4 = 0; s4 < 4; ++s4)
#pragma unroll
              for (int q = 0; q < 2; ++q) { Y[q] = MFMA32(bu[s4], frag_rm(L + L_P, 32 * q + r32, s4, hi), Y[q]); Hh[q] = MFMA32(frag_vi(L + L_BHV, q, s4, lane), bu[s4], Hh[q]); __builtin_amdgcn_sched_barrier(0); } }
        unsigned* yf = (unsigned*)(gs + CH_YF); float* hf = (float*)(gs + CH_H);
#pragma unroll
        for (int tb = 0; tb < 2; ++tb)
#pragma unroll
            for (int q = 0; q < 8; ++q) { yf[((ib * 2 + tb) * 8 + q) * 64 + lane] = cvt_pk_bf16(Y[tb][2 * q], Y[tb][2 * q + 1]); if ((q & 3) == 3) __builtin_amdgcn_sched_barrier(0); }
#pragma unroll
        for (int jb = 0; jb < 2; ++jb)
#pragma unroll
            for (int r = 0; r < 16; ++r) { hf[((jb * 2 + ib) * 16 + r) * 64 + lane] = Hh[jb][r]; if ((r & 3) == 3) __builtin_amdgcn_sched_barrier(0); }
        RW_BAR();
    } else if (w < 6 && RWDBG != 2 && RWDBG != 3) {
        const int jc = w - 4;
        RW_BAR(); RW_BAR();
        f32x16 A2[2]; A2[0] = (f32x16){}; A2[1] = (f32x16){};
#pragma unroll
        for (int s4 = 0; s4 < 4; ++s4) { const bf16x8 af = frag_vi(L + L_ATV, jc, s4, lane);
#pragma unroll
            for (int mb = 0; mb < 2; ++mb) { A2[mb] = MFMA32(frag_rm(L + L_T, 32 * mb + r32, s4, hi), af, A2[mb]); __builtin_amdgcn_sched_barrier(0); } }
        bf16x8 ba[4]; frags_of(ba, A2);
        f32x16 R2[2], Gt[2]; R2[0] = (f32x16){}; R2[1] = (f32x16){}; Gt[0] = (f32x16){}; Gt[1] = (f32x16){};
#pragma unroll
        for (int s4 = 0; s4 < 4; ++s4)
#pragma unroll
            for (int q = 0; q < 2; ++q) { R2[q] = MFMA32(ba[s4], frag_rm(L + L_P, 32 * q + r32, s4, hi), R2[q]); Gt[q] = MFMA32(frag_vi(L + L_BHV, q, s4, lane), ba[s4], Gt[q]); __builtin_amdgcn_sched_barrier(0); }
#pragma unroll
        for (int tb = 0; tb < 2; ++tb)
#pragma unroll
            for (int rg = 0; rg < 4; ++rg) { const u32x2 x = *(const LAS u32x2*)(L + L_RT + (32 * tb + r32) * RM + (32 * jc + 8 * rg + 4 * hi) * 2);
                R2[tb][4 * rg] += bflo(x.x); R2[tb][4 * rg + 1] += bfhi(x.x); R2[tb][4 * rg + 2] += bflo(x.y); R2[tb][4 * rg + 3] += bfhi(x.y); }
        { const LAS float* WC = (const LAS float*)(L + L_WC);
#pragma unroll
          for (int r = 0; r < 16; ++r) if (crow(r, hi) == r32) Gt[jc][r] += WC[32 * jc + r32]; }
        u32x4* rf = (u32x4*)(gs + CH_RF);
#pragma unroll
        for (int tb = 0; tb < 2; ++tb) { rf[(tb * 4 + 2 * jc) * 64 + lane] = __builtin_bit_cast(u32x4, frag_acc<0>(R2[tb])); rf[(tb * 4 + 2 * jc + 1) * 64 + lane] = __builtin_bit_cast(u32x4, frag_acc<1>(R2[tb])); }
        bf16_t* gg = (bf16_t*)(gs + CH_G);
#pragma unroll
        for (int jb = 0; jb < 2; ++jb)
#pragma unroll
            for (int r = 0; r < 16; ++r) { gg[(32 * jb + crow(r, hi)) * 64 + 32 * jc + r32] = (bf16_t)f2bf(Gt[jb][r]); if ((r & 3) == 3) __builtin_amdgcn_sched_barrier(0); }
        RW_BAR();
    } else {
        RW_BAR(); RW_BAR(); RW_BAR();
    }
}

__device__ __forceinline__ void chain_wave(Frame& F, int bh) {
    const int lane = F.lane, r32 = lane & 31, hi = lane >> 5;
    f32x16 Z[2][2];
#pragma unroll
    for (int a = 0; a < 2; ++a)
#pragma unroll
        for (int bq = 0; bq < 2; ++bq) Z[a][bq] = (f32x16){};
    for (int c = 0; c < 64; ++c) {
        unsigned char* gs = F.ws + WS_RWS + (size_t)(bh * 64 + c) * CH_BYTES;
        bf16x8 zf[2][4];
#pragma unroll
        for (int ib = 0; ib < 2; ++ib) { zf[ib][0] = frag_acc<0>(Z[0][ib]); zf[ib][1] = frag_acc<1>(Z[0][ib]); zf[ib][2] = frag_acc<0>(Z[1][ib]); zf[ib][3] = frag_acc<1>(Z[1][ib]); }
        u32x4* zo = (u32x4*)(gs + CH_ZF);
#pragma unroll
        for (int ib = 0; ib < 2; ++ib)
#pragma unroll
            for (int s4 = 0; s4 < 4; ++s4) zo[(ib * 4 + s4) * 64 + lane] = __builtin_bit_cast(u32x4, zf[ib][s4]);
        if (c == 63) break;
        const float* hf = (const float*)(gs + CH_H); const bf16_t* gg = (const bf16_t*)(gs + CH_G);
        f32x16 Zn[2][2];
#pragma unroll
        for (int jb = 0; jb < 2; ++jb)
#pragma unroll
            for (int ib = 0; ib < 2; ++ib)
#pragma unroll
                for (int r = 0; r < 16; ++r) Zn[jb][ib][r] = hf[((jb * 2 + ib) * 16 + r) * 64 + lane];
#pragma unroll
        for (int jb = 0; jb < 2; ++jb)
#pragma unroll
            for (int s4 = 0; s4 < 4; ++s4) { const bf16_t* p = gg + (32 * jb + r32) * 64 + 16 * s4 + 4 * hi; const u32x2 a = *(const u32x2*)p, bb = *(const u32x2*)(p + 8);
                const bf16x8 gf = __builtin_bit_cast(bf16x8, (u32x4){a.x, a.y, bb.x, bb.y});
#pragma unroll
                for (int ib = 0; ib < 2; ++ib) Zn[jb][ib] = MFMA32(gf, zf[ib][s4], Zn[jb][ib]); }
#pragma unroll
        for (int jb = 0; jb < 2; ++jb)
#pragma unroll
            for (int ib = 0; ib < 2; ++ib) Z[jb][ib] = Zn[jb][ib];
    }
}

__device__ __forceinline__ void out_wave(Frame& F, int l, int cidx) {
    const int lane = F.lane, r32 = lane & 31, hi = lane >> 5; const int bh = cidx >> 6, c = cidx & 63, b = bh >> 4, h = bh & 15;
    const unsigned char* gs = F.ws + WS_RWS + (size_t)cidx * CH_BYTES;
    const unsigned* yf = (const unsigned*)(gs + CH_YF); const u32x4* zf = (const u32x4*)(gs + CH_ZF); const u32x4* rf = (const u32x4*)(gs + CH_RF);
    f32x16 Y[2][2];
#pragma unroll
    for (int ib = 0; ib < 2; ++ib)
#pragma unroll
        for (int tb = 0; tb < 2; ++tb)
#pragma unroll
            for (int q = 0; q < 8; ++q) { const unsigned x = yf[((ib * 2 + tb) * 8 + q) * 64 + lane]; Y[ib][tb][2 * q] = bflo(x); Y[ib][tb][2 * q + 1] = bfhi(x); }
#pragma unroll
    for (int s4 = 0; s4 < 4; ++s4) { bf16x8 za[2], rb[2];
#pragma unroll
        for (int q = 0; q < 2; ++q) { za[q] = __builtin_bit_cast(bf16x8, zf[(q * 4 + s4) * 64 + lane]); rb[q] = __builtin_bit_cast(bf16x8, rf[(q * 4 + s4) * 64 + lane]); }
#pragma unroll
        for (int ib = 0; ib < 2; ++ib)
#pragma unroll
            for (int tb = 0; tb < 2; ++tb) Y[ib][tb] = MFMA32(za[ib], rb[tb], Y[ib][tb]); }
    const float* lng = (const float*)ARGP(13) + l * 1024 + h * 64; const float* lnb = (const float*)ARGP(14) + l * 1024 + h * 64;
    const bf16_t* VM = (const bf16_t*)(F.ws + WS_VMIX); const bf16_t* GO = (const bf16_t*)(F.ws + WS_GOUT); const float* BC = (const float*)(F.ws + WS_BC);
    bf16_t* O = (bf16_t*)(F.ws + WS_OALL) + (size_t)1 * T * 1024;
#pragma unroll
    for (int tb = 0; tb < 2; ++tb) { const size_t row = (size_t)b * SEQ + c * 64 + 32 * tb + r32;
        float sm = 0.f;
#pragma unroll
        for (int ib = 0; ib < 2; ++ib)
#pragma unroll
            for (int r = 0; r < 16; ++r) sm += Y[ib][tb][r];
        sm += other_half(sm, hi); const float mean = sm * (1.f / 64.f);
        float sq = 0.f;
#pragma unroll
        for (int ib = 0; ib < 2; ++ib)
#pragma unroll
            for (int r = 0; r < 16; ++r) { const float d = Y[ib][tb][r] - mean; sq += d * d; }
        sq += other_half(sq, hi); const float rstd = rsqrtf(sq * (1.f / 64.f) + GN_EPS);
        const float bcv = BC[row * 16 + h];
#pragma unroll
        for (int ib = 0; ib < 2; ++ib) {
            u32x2 vvr[4], gor[4]; f32x4 gln[4], bln[4];
#pragma unroll
            for (int rg = 0; rg < 4; ++rg) { const int i0 = 32 * ib + 8 * rg + 4 * hi; vvr[rg] = *(const u32x2*)(VM + row * 1024 + h * 64 + i0); gor[rg] = *(const u32x2*)(GO + row * 1024 + h * 64 + i0);
                gln[rg] = *(const f32x4*)(lng + i0); bln[rg] = *(const f32x4*)(lnb + i0); }
#pragma unroll
            for (int rg = 0; rg < 4; ++rg) { const int i0 = 32 * ib + 8 * rg + 4 * hi;
                const f32x4 vv = (f32x4){bflo(vvr[rg].x), bfhi(vvr[rg].x), bflo(vvr[rg].y), bfhi(vvr[rg].y)}, go = (f32x4){bflo(gor[rg].x), bfhi(gor[rg].x), bflo(gor[rg].y), bfhi(gor[rg].y)};
                f32x4 o;
#pragma unroll
                for (int e = 0; e < 4; ++e) o[e] = ((Y[ib][tb][4 * rg + e] - mean) * rstd * gln[rg][e] + bln[rg][e] + bcv * vv[e]) * go[e];
                store4_bf16(O + row * 1024 + h * 64 + i0, o); }
            asm volatile("" ::: "memory"); } }
}
}


#ifndef DUP_MIX
#define DUP_MIX 0
#endif
__device__ __forceinline__ void unit_pop(Frame& F, unsigned* qhead, int& idx) {
    if (F.tid == 0) F.MISC[0] = __hip_atomic_fetch_add(qhead, 1u, RLX_AGENT);
    __syncthreads(); idx = (int)F.MISC[0]; __syncthreads();
    { int t_ = F.tid; asm volatile("" : "+v"(t_)); F.tid = t_; F.lane = t_ & 63; F.wave = __builtin_amdgcn_readfirstlane(t_ >> 6); }
}
__device__ __forceinline__ void phase_mix_a(Frame& F, int l, int rep) {
    const int nch = (4096 - F.vcu + F.G - 1) / F.G, nec = 0;
    rw::ChunkIn nx; if (nch > 0) rw::chunk_fetch(F, l, F.vcu, nx);
    int je = 0;
#pragma unroll 1
    for (int j = 0; j < nch; ++j) {
        { int t_ = F.tid; asm volatile("" : "+v"(t_)); F.tid = t_; F.lane = t_ & 63; F.wave = __builtin_amdgcn_readfirstlane(t_ >> 6); }
        const rw::ChunkIn cu = nx;
        rw::ChunkPar cp; rw::chunk_par(F, l, F.vcu + j * F.G, cp);
        if (j + 1 < nch) rw::chunk_fetch(F, l, F.vcu + (j + 1) * F.G, nx);
        if (rep == 0 || (DUP_MIX & 1)) rw::chunk_unit(F, l, F.vcu + j * F.G, cu, cp);
        __syncthreads();
        if (((j + F.vcu) & 3) == 3 && je < nec) { if (rep == 0 || (DUP_MIX & 8)) { EcDesc fn{F.ws, l}; run_panels(F, 6 * (F.vcu + je * F.G), 6, 1, fn); } ++je; __syncthreads(); }
    }
#pragma unroll 1
    for (; je < nec; ++je) { if (rep == 0 || (DUP_MIX & 8)) { EcDesc fn{F.ws, l}; run_panels(F, 6 * (F.vcu + je * F.G), 6, 1, fn); } __syncthreads(); }
}
__device__ __forceinline__ void phase_mix_b(Frame& F, int l, int rep) {
    unsigned* qhead = F.ctl + CW_QHEAD + 64 * l + 16 * rep + 8;
    const bf16_t* PROJ = (const bf16_t*)(F.ws + WS_PROJ); bf16_t* OALL = (bf16_t*)(F.ws + WS_OALL);
    for (;;) { int idx; unit_pop(F, qhead, idx);
        if (idx >= 64 + 3072) break;
        if (idx < 64) { if ((rep == 0 || (DUP_MIX & 16)) && F.wave == 0) rw::chain_wave(F, idx); }
        else { const int kq = idx - 64;
            if (kq % 3 == 2) { if (rep == 0 || (DUP_MIX & 8)) { EcDesc fn{F.ws, l}; run_panels(F, 6 * (kq / 3), 6, 1, fn); } }
            else { const int k = (kq / 3) * 2 + kq % 3, qb = 15 - (k >> 7), kk = k & 127, bh = kk >> 1;
                if (kk & 1) { if (rep == 0 || (DUP_MIX & 2)) attn_sb_unit(F, bh >> 4, bh & 15, qb, PROJ, OALL); }
                else { if (rep == 0 || (DUP_MIX & 4)) attn_mla_unit(F, bh >> 4, bh & 15, qb, (const bf16_t*)(F.ws + WS_QMLA), (const bf16_t*)(F.ws + WS_KMLA), (const bf16_t*)(F.ws + WS_KPE), (const bf16_t*)(F.ws + WS_VMLA), OALL + (size_t)2 * T * 1024); } } }
        __syncthreads();
    }
}

__device__ __forceinline__ void phase_select(Frame& F, int l) {
    const float* lgp = (const float*)(F.ws + WS_LGP); const float* rgb = (const float*)ARGP(28) + l * 8; const float* reb = (const float*)ARGP(30) + l * 64;
    int* toke = (int*)(F.ws + WS_TOKE); float* tokw = (float*)(F.ws + WS_TOKW); unsigned* cnt = F.ctl + CW_CNT + 64 * l;
    for (int t = F.gw * 64 + F.lane; t < T; t += F.NGW * 64) {
        float gl[8]; int grp = 0; float gmax;
        { f32x4 a0 = (f32x4){0.f, 0.f, 0.f, 0.f}, a1 = a0;
#pragma unroll
          for (int z = 0; z < 4; ++z) { const f32x4* p = (const f32x4*)(lgp + ((size_t)z * T + t) * 96); a0 += p[0]; a1 += p[1]; }
#pragma unroll
          for (int i = 0; i < 4; ++i) { gl[i] = a0[i] + rgb[i]; gl[4 + i] = a1[i] + rgb[4 + i]; } }
        gmax = gl[0];
#pragma unroll
        for (int i = 1; i < 8; ++i) if (gl[i] > gmax) { gmax = gl[i]; grp = i; }
        float gs = 0.f;
#pragma unroll
        for (int i = 0; i < 8; ++i) gs += __expf(gl[i] - gmax);
        const float pgrp = 1.0f / gs;
        float el[8];
        { f32x4 a0 = (f32x4){0.f, 0.f, 0.f, 0.f}, a1 = a0;
#pragma unroll
          for (int z = 0; z < 4; ++z) { const f32x4* p = (const f32x4*)(lgp + ((size_t)z * T + t) * 96 + 8 + grp * 8); a0 += p[0]; a1 += p[1]; }
#pragma unroll
          for (int i = 0; i < 4; ++i) { el[i] = a0[i] + reb[grp * 8 + i]; el[4 + i] = a1[i] + reb[grp * 8 + 4 + i]; } }
        int i0 = 0; float m0 = el[0];
#pragma unroll
        for (int i = 1; i < 8; ++i) if (el[i] > m0) { m0 = el[i]; i0 = i; }
        int i1 = -1; float m1 = -INFINITY;
#pragma unroll
        for (int i = 0; i < 8; ++i) if (i != i0 && el[i] > m1) { m1 = el[i]; i1 = i; }
        const float e1 = __expf(m1 - m0); const float w0 = pgrp / (1.0f + e1), w1 = pgrp * e1 / (1.0f + e1);
        const int ex0 = grp * 8 + i0, ex1 = grp * 8 + i1;
        toke[2 * t] = ex0; toke[2 * t + 1] = ex1; tokw[2 * t] = w0; tokw[2 * t + 1] = w1;
        __hip_atomic_fetch_add(cnt + ex0, 1u, RLX_AGENT); __hip_atomic_fetch_add(cnt + ex1, 1u, RLX_AGENT);
    }
}

__device__ __forceinline__ void phase_scatter(Frame& F, int l) {
    unsigned* cnt = F.ctl + CW_CNT + 64 * l; unsigned* curs = F.ctl + CW_CUR + 64 * l;
    LAS int* pst = (LAS int*)F.lds; int* blke = (int*)(F.ws + WS_BLKE);
    if (F.tid < 64) pst[64 + F.tid] = (int)((__hip_atomic_load(cnt + F.tid, RLX_AGENT) + 255u) & ~255u);
    __syncthreads();
    if (F.tid == 0) { int acc = 0;
        for (int e = 0; e < 64; ++e) { const int pd = pst[64 + e]; pst[e] = acc;
            if (blockIdx.x == 0) for (int q = 0; q < pd / 256; ++q) blke[1 + acc / 256 + q] = e;
            acc += pd; }
        if (blockIdx.x == 0) blke[0] = acc / 256; }
    __syncthreads();
    const int* toke = (const int*)(F.ws + WS_TOKE); int* pos = (int*)(F.ws + WS_POS); int* rowtok = (int*)(F.ws + WS_ROWTOK);
    for (int i = F.gw * 64 + F.lane; i < 2 * T; i += F.NGW * 64) { const int e = toke[i];
        const int p = pst[e] + (int)__hip_atomic_fetch_add(curs + e, 1u, RLX_AGENT); pos[i] = p; rowtok[p] = i >> 1; }
}

struct SchedLora { pg8::StaticOrder S;
    __device__ __forceinline__ bool next(int i, Unit& u) const { if (!S.next(i, u)) return false; u.z = u.pn >> 2; u.akoff = u.z * 512; return true; } };
struct SchedBranch { pg8::StaticOrder S;
    __device__ __forceinline__ bool next(int i, Unit& u) const { if (!S.tile(i / 3, u.pm, u.pn)) return false; u.z = i % 3; u.am = u.z * 64 + u.pm; u.bn = u.z * 8 + u.pn; u.akoff = 0; u.bkoff = 0; return true; } };
struct SchedMoe { int nblk, ntile, G, vcu; const LAS int* blke; const int* rowtok; int nrows;
    __device__ __forceinline__ bool next(int i, Unit& u) const { const int L = i * G + vcu; if (L >= nblk * ntile) return false;
        const int rb = L / ntile, j = L % ntile, e = blke[1 + rb]; u.pm = rb; u.am = rb; u.pn = j; u.bn = e * ntile + j; u.z = j; u.akoff = 0; u.bkoff = 0; return true; } };

constexpr int NPH_LAYER = 17, PH_FINAL = 1 + DEPTH * NPH_LAYER, NPHASES = PH_FINAL + 1;
__global__ void __launch_bounds__(NWAVES * 64, 2) hybrid_fwd(Args args) {
    extern __shared__ __attribute__((aligned(16))) unsigned char lds_raw[];
    Frame F;
    F.lds = (LAS unsigned char*)lds_raw; F.MISC = (volatile LAS unsigned*)(F.lds + MISC_OFF);
    F.tid = threadIdx.x; F.lane = F.tid & 63; F.wave = __builtin_amdgcn_readfirstlane(F.tid >> 6);
    F.G = gridDim.x; { const int bx = blockIdx.x; F.vcu = (F.G % 8 == 0) ? (bx % 8) * (F.G / 8) + bx / 8 : bx; }
    F.gw = F.vcu * NWAVES + F.wave; F.NGW = F.G * NWAVES;
    F.ws = args.ws; F.ctl = (unsigned*)(args.ws + WS_CTL);
    for (int u = F.tid; u < (LDS_BYTES - RING_BYTES) / 4; u += NWAVES * 64) ((LAS unsigned*)(F.lds + RING_BYTES))[u] = 0u;
    __syncthreads();
    const int lo = args.ph_lo, hi = args.ph_hi;
    XcdBarrier bar; bar.bar = F.ctl + CW_BAR; bar.x = 0; bar.st = F.MISC + 8;
    if (hi - lo > 1) bar = xcd_barrier_post(F.ctl + CW_BAR, F.MISC + 8, threadIdx.x == 0);
    bool ran = false;
#define FRAME_INIT() do { int t_ = wave0_ * 64 + (int)__builtin_amdgcn_mbcnt_hi(~0u, __builtin_amdgcn_mbcnt_lo(~0u, 0u)), bx_ = blockIdx.x, G_ = gridDim.x; asm volatile("" : "+v"(t_)); asm volatile("" : "+s"(bx_), "+s"(G_)); \
        F.tid = t_; F.lane = t_ & 63; F.wave = __builtin_amdgcn_readfirstlane(t_ >> 6); F.G = G_; F.vcu = (G_ % 8 == 0) ? (bx_ % 8) * (G_ / 8) + bx_ / 8 : bx_; \
        F.gw = F.vcu * NWAVES + F.wave; F.NGW = G_ * NWAVES; F.ws = launder(args.ws); F.ctl = (unsigned*)F.ws; cblk = bx_; } while (0)
    int cblk = 0;
    const int wave0_ = __builtin_amdgcn_readfirstlane((int)threadIdx.x >> 6);
#ifndef PHMASK
#define PHMASK 0xFFFFF
#endif
#ifndef DUPMASK
#define DUPMASK 0
#endif
#define GRID_BARRIER() do { XcdBarrier bb_ = bar; bb_.bar = (unsigned*)launder((unsigned char*)bar.bar); xcd_barrier(bb_, wave0_ == 0 && __builtin_amdgcn_mbcnt_hi(~0u, __builtin_amdgcn_mbcnt_lo(~0u, 0u)) == 0u); } while (0)
#if DUPMASK
#define PHASE_BEGIN(p, k) if (((PHMASK >> (k)) & 1) && lo <= (p) && (p) < hi) { if (ran) GRID_BARRIER(); ran = true; \
    int nrep_ = (((DUPMASK >> (k)) & 1) && !(((k) == 8 || (k) == 1) && lcur > 0)) ? 2 : 1; asm volatile("" : "+s"(nrep_)); for (int rep_ = 0; rep_ < nrep_; ++rep_) { if (rep_) GRID_BARRIER(); FRAME_INIT();
#define PHASE_END } }
#else
#define PHASE_BEGIN(p, k) if (((PHMASK >> (k)) & 1) && lo <= (p) && (p) < hi) { if (ran) GRID_BARRIER(); ran = true; FRAME_INIT(); const int rep_ = 0; (void)rep_;
#define PHASE_END }
#endif
    int lcur = 0; (void)lcur;

    PHASE_BEGIN(0, 14) phase_convert(F, args); phase_norm<0>(F, (const float*)ARGP(0), nullptr, (const float*)ARGP(2), (bf16_t*)(F.ws + WS_H), nullptr, nullptr, nullptr, nullptr); PHASE_END

    { constexpr int l = 0;
        const int pb = 1 + l * NPH_LAYER; lcur = l;
        bf16_t* PROJ = (bf16_t*)(F.ws + WS_PROJ); float* X = (float*)(F.ws + WS_X); bf16_t* H = (bf16_t*)(F.ws + WS_H);
        const float* xres = (l == 0) ? (const float*)ARGP(0) : (const float*)X;


        if (l > 0) {
        PHASE_BEGIN(pb + 1, 1)
            phase_norm<1>(F, X, X, (const float*)ARGP(2) + (size_t)l * 2048, H, nullptr, (const bf16_t*)(F.ws + WS_Y), (const int*)(F.ws + WS_POS), (const float*)(F.ws + WS_TOKW));
        PHASE_END
        }

        PHASE_BEGIN(pb + 2, 2) {
            pg8::Gemm g{H, (const bf16_t*)(F.ws + WS_WIN + l * SZ_WIN), 2048, 2048, 2048}; pg8::StaticOrder S; S.init(T / 256, NPROJ / 256, F.G, cblk);
            EpiProj E{PROJ}; pg8::gemm_phase<EpiProj, pg8::StaticOrder, true>(F.lds, F.tid, g, S, E);
            if (l == 0 && rep_ == 0) { const int nu = (T / 256) * (NPROJ / 256), nfull = nu % F.G; if (nfull != 0 && cblk >= nfull) { __syncthreads(); P0Desc fn{F.ws}; const int nh = F.G - nfull, r = cblk - nfull;
                const int np = (P0Desc::NP_L - r + nh - 1) / nh; run_panels(F, P0Desc::NP_L + r, np, nh, fn); }
              else if (nfull == 0) { __syncthreads(); P0Desc fn{F.ws}; const int np = (P0Desc::NP_L - F.vcu + F.G - 1) / F.G; run_panels(F, P0Desc::NP_L + F.vcu, np, F.G, fn); } } }
        PHASE_END

        PHASE_BEGIN(pb + 3, 3) phase_prep(F, args, l); PHASE_END

        PHASE_BEGIN(pb + 4, 4) {
#ifndef P4SUB
#define P4SUB 15
#endif
#ifndef P4DUP
#define P4DUP 15
#endif
#define P4ON(b) ((P4SUB & (b)) && (rep_ == 0 || (P4DUP & (b))))
            if (P4ON(1)) { pg8::Gemm g{PROJ + PC_CQ, (const bf16_t*)(F.ws + WS_WUQ + l * SZ_WUQ), NPROJ, 768, 768}; pg8::StaticOrder S; S.init(T / 256, 6, F.G, cblk);
              EpiMlaQ E{(bf16_t*)(F.ws + WS_QMLA), (const float*)(F.ws + WS_RSTDQ), (const float*)(F.ws + WS_COS), (const float*)(F.ws + WS_SIN)};
              pg8::gemm_phase<EpiMlaQ, pg8::StaticOrder, true>(F.lds, F.tid, g, S, E); }
            { int t_ = F.tid; asm volatile("" : "+v"(t_)); F.tid = t_; }
            if (P4ON(2)) { pg8::Gemm g{PROJ + PC_CKV, (const bf16_t*)(F.ws + WS_WUKV + l * SZ_WUKV), NPROJ, 256, 256}; pg8::StaticOrder S; S.init(T / 256, 8, F.G, cblk);
              EpiMlaKV E{(bf16_t*)(F.ws + WS_KMLA), (bf16_t*)(F.ws + WS_VMLA), (const float*)(F.ws + WS_RSTDKV)};
              pg8::gemm_phase<EpiMlaKV, pg8::StaticOrder, true>(F.lds, F.tid, g, S, E); }
            { int t_ = F.tid; asm volatile("" : "+v"(t_)); F.tid = t_; }
            if (P4ON(4)) { pg8::Gemm g{(const bf16_t*)(F.ws + WS_LORAIN), (const bf16_t*)(F.ws + WS_WLORA + l * SZ_WLORA), 768, 256, 256}; SchedLora S; S.S.init(T / 256, 12, F.G, cblk);
              EpiLora E{(float*)(F.ws + WS_LOGDEC), (float*)(F.ws + WS_AIC), (bf16_t*)(F.ws + WS_GOUT), (const float*)ARGP(5) + l * 1024, (const float*)ARGP(7) + l * 1024};
              pg8::gemm_phase<EpiLora, SchedLora, true>(F.lds, F.tid, g, S, E); }
            { int t_ = F.tid; asm volatile("" : "+v"(t_)); F.tid = t_; }
            if (P4ON(8) && l > 0) { pg8::Gemm g{(const bf16_t*)(F.ws + WS_VS) + (size_t)l * T * 1024, (const bf16_t*)(F.ws + WS_WV1), 1024, 1024, 1024}; pg8::StaticOrder S; S.init(T / 256, 1, F.G, cblk);
              EpiT1 E{(bf16_t*)(F.ws + WS_T1)}; pg8::gemm_phase<EpiT1, pg8::StaticOrder, true>(F.lds, F.tid, g, S, E); } }
        PHASE_END

        if (l > 0) {
        PHASE_BEGIN(pb + 5, 5) { pg8::Gemm g{(const bf16_t*)(F.ws + WS_T1), (const bf16_t*)(F.ws + WS_WV2), 128, 128, 128}; pg8::StaticOrder S; S.init(T / 256, 4, F.G, cblk);
              EpiVGate E{(bf16_t*)(F.ws + WS_VGATE), (const float*)ARGP(15) + (size_t)(l - 1) * 1024}; pg8::gemm_phase<EpiVGate, pg8::StaticOrder, true>(F.lds, F.tid, g, S, E); }
        PHASE_END
        }

        PHASE_BEGIN(pb + 6, 6) phase_mix_a(F, l, rep_); PHASE_END
        PHASE_BEGIN(pb + 7, 16) phase_mix_b(F, l, rep_); PHASE_END
        PHASE_BEGIN(pb + 8, 17) for (int cidx = F.gw; cidx < 4096; cidx += F.NGW) rw::out_wave(F, l, cidx); PHASE_END

        PHASE_BEGIN(pb + 9, 7) { pg8::Gemm g{(const bf16_t*)(F.ws + WS_OALL), (const bf16_t*)(F.ws + WS_WBR + l * SZ_WBR), 1024, 1024, 1024}; SchedBranch S; S.S.init(T / 256, 8, F.G, cblk);
              EpiBranch E{PROJ, (bf16_t*)(F.ws + WS_MERGED)}; pg8::gemm_phase<EpiBranch, SchedBranch, true>(F.lds, F.tid, g, S, E); }
        PHASE_END

        PHASE_BEGIN(pb + 10, 8) { pg8::Gemm g{(const bf16_t*)(F.ws + WS_MERGED), (const bf16_t*)(F.ws + WS_WOUT + l * SZ_WOUT), 2048, 2048, 2048}; pg8::StaticOrder S; S.init(T / 256, 8, F.G, cblk);
              EpiWout E{xres, X}; pg8::gemm_phase<EpiWout, pg8::StaticOrder, true>(F.lds, F.tid, g, S, E); }
        PHASE_END

        PHASE_BEGIN(pb + 11, 9) phase_norm<3>(F, X, nullptr, (const float*)ARGP(26) + (size_t)l * 2048, (bf16_t*)(F.ws + WS_APRIME), nullptr, nullptr, nullptr, nullptr); PHASE_END

        PHASE_BEGIN(pb + 12, 10) { pg8::Gemm g{(const bf16_t*)(F.ws + WS_APRIME), (const bf16_t*)(F.ws + WS_WRT + l * SZ_WRT), 4096, 4096, 1024}; SchedRouter S{F.G, F.vcu};
              EpiRouterPart E{(float*)(F.ws + WS_LGP)}; pg8::gemm_phase<EpiRouterPart, SchedRouter, true>(F.lds, F.tid, g, S, E); }
        PHASE_END

        PHASE_BEGIN(pb + 13, 18) phase_select(F, l); PHASE_END

        PHASE_BEGIN(pb + 14, 11) phase_scatter(F, l); PHASE_END

        PHASE_BEGIN(pb + 15, 12) { LAS int* tab = (LAS int*)(F.lds + RING_BYTES + 1024); const int* blke = (const int*)(F.ws + WS_BLKE);
              if (F.tid < 256) tab[F.tid] = blke[F.tid]; __syncthreads();
              SchedMoe S{tab[0], 4, F.G, F.vcu, tab, (const int*)(F.ws + WS_ROWTOK), T};
              pg8::Gemm g{(const bf16_t*)(F.ws + WS_APRIME), (const bf16_t*)(F.ws + WS_WE1), 4096, 2048, 2048}; EpiE1 E{(bf16_t*)(F.ws + WS_HMOE)};
              pg8::gemm_phase<EpiE1, SchedMoe, true, true>(F.lds, F.tid, g, S, E); }
        PHASE_END

        PHASE_BEGIN(pb + 16, 13) { LAS int* tab = (LAS int*)(F.lds + RING_BYTES + 1024); const int* blke = (const int*)(F.ws + WS_BLKE);
              if (F.tid < 256) tab[F.tid] = blke[F.tid]; __syncthreads();
              SchedMoe S{tab[0], 8, F.G, F.vcu, tab, nullptr, 0};
              pg8::Gemm g{(const bf16_t*)(F.ws + WS_HMOE), (const bf16_t*)(F.ws + WS_WE2), 512, 512, 512}; EpiE2 E{(bf16_t*)(F.ws + WS_Y)};
              pg8::gemm_phase<EpiE2, SchedMoe, true>(F.lds, F.tid, g, S, E); }
        PHASE_END
    }
    { constexpr int l = 1;
        const int pb = 1 + l * NPH_LAYER; lcur = l;
        bf16_t* PROJ = (bf16_t*)(F.ws + WS_PROJ); float* X = (float*)(F.ws + WS_X); bf16_t* H = (bf16_t*)(F.ws + WS_H);
        const float* xres = (l == 0) ? (const float*)ARGP(0) : (const float*)X;


        if (l > 0) {
        PHASE_BEGIN(pb + 1, 1)
            phase_norm<1>(F, X, X, (const float*)ARGP(2) + (size_t)l * 2048, H, nullptr, (const bf16_t*)(F.ws + WS_Y), (const int*)(F.ws + WS_POS), (const float*)(F.ws + WS_TOKW));
        PHASE_END
        }

        PHASE_BEGIN(pb + 2, 2) {
            pg8::Gemm g{H, (const bf16_t*)(F.ws + WS_WIN + l * SZ_WIN), 2048, 2048, 2048}; pg8::StaticOrder S; S.init(T / 256, NPROJ / 256, F.G, cblk);
            EpiProj E{PROJ}; pg8::gemm_phase<EpiProj, pg8::StaticOrder, true>(F.lds, F.tid, g, S, E);
            if (l == 0 && rep_ == 0) { const int nu = (T / 256) * (NPROJ / 256), nfull = nu % F.G; if (nfull != 0 && cblk >= nfull) { __syncthreads(); P0Desc fn{F.ws}; const int nh = F.G - nfull, r = cblk - nfull;
                const int np = (P0Desc::NP_L - r + nh - 1) / nh; run_panels(F, P0Desc::NP_L + r, np, nh, fn); }
              else if (nfull == 0) { __syncthreads(); P0Desc fn{F.ws}; const int np = (P0Desc::NP_L - F.vcu + F.G - 1) / F.G; run_panels(F, P0Desc::NP_L + F.vcu, np, F.G, fn); } } }
        PHASE_END

        PHASE_BEGIN(pb + 3, 3) phase_prep(F, args, l); PHASE_END

        PHASE_BEGIN(pb + 4, 4) {
#ifndef P4SUB
#define P4SUB 15
#endif
#ifndef P4DUP
#define P4DUP 15
#endif
#define P4ON(b) ((P4SUB & (b)) && (rep_ == 0 || (P4DUP & (b))))
            if (P4ON(1)) { pg8::Gemm g{PROJ + PC_CQ, (const bf16_t*)(F.ws + WS_WUQ + l * SZ_WUQ), NPROJ, 768, 768}; pg8::StaticOrder S; S.init(T / 256, 6, F.G, cblk);
              EpiMlaQ E{(bf16_t*)(F.ws + WS_QMLA), (const float*)(F.ws + WS_RSTDQ), (const float*)(F.ws + WS_COS), (const float*)(F.ws + WS_SIN)};
              pg8::gemm_phase<EpiMlaQ, pg8::StaticOrder, true>(F.lds, F.tid, g, S, E); }
            { int t_ = F.tid; asm volatile("" : "+v"(t_)); F.tid = t_; }
            if (P4ON(2)) { pg8::Gemm g{PROJ + PC_CKV, (const bf16_t*)(F.ws + WS_WUKV + l * SZ_WUKV), NPROJ, 256, 256}; pg8::StaticOrder S; S.init(T / 256, 8, F.G, cblk);
              EpiMlaKV E{(bf16_t*)(F.ws + WS_KMLA), (bf16_t*)(F.ws + WS_VMLA), (const float*)(F.ws + WS_RSTDKV)};
              pg8::gemm_phase<EpiMlaKV, pg8::StaticOrder, true>(F.lds, F.tid, g, S, E); }
            { int t_ = F.tid; asm volatile("" : "+v"(t_)); F.tid = t_; }
            if (P4ON(4)) { pg8::Gemm g{(const bf16_t*)(F.ws + WS_LORAIN), (const bf16_t*)(F.ws + WS_WLORA + l * SZ_WLORA), 768, 256, 256}; SchedLora S; S.S.init(T / 256, 12, F.G, cblk);
              EpiLora E{(float*)(F.ws + WS_LOGDEC), (float*)(F.ws + WS_AIC), (bf16_t*)(F.ws + WS_GOUT), (const float*)ARGP(5) + l * 1024, (const float*)ARGP(7) + l * 1024};
              pg8::gemm_phase<EpiLora, SchedLora, true>(F.lds, F.tid, g, S, E); }
            { int t_ = F.tid; asm volatile("" : "+v"(t_)); F.tid = t_; }
            if (P4ON(8) && l > 0) { pg8::Gemm g{(const bf16_t*)(F.ws + WS_VS) + (size_t)l * T * 1024, (const bf16_t*)(F.ws + WS_WV1), 1024, 1024, 1024}; pg8::StaticOrder S; S.init(T / 256, 1, F.G, cblk);
              EpiT1 E{(bf16_t*)(F.ws + WS_T1)}; pg8::gemm_phase<EpiT1, pg8::StaticOrder, true>(F.lds, F.tid, g, S, E); } }
        PHASE_END

        if (l > 0) {
        PHASE_BEGIN(pb + 5, 5) { pg8::Gemm g{(const bf16_t*)(F.ws + WS_T1), (const bf16_t*)(F.ws + WS_WV2), 128, 128, 128}; pg8::StaticOrder S; S.init(T / 256, 4, F.G, cblk);
              EpiVGate E{(bf16_t*)(F.ws + WS_VGATE), (const float*)ARGP(15) + (size_t)(l - 1) * 1024}; pg8::gemm_phase<EpiVGate, pg8::StaticOrder, true>(F.lds, F.tid, g, S, E); }
        PHASE_END
        }

        PHASE_BEGIN(pb + 6, 6) phase_mix_a(F, l, rep_); PHASE_END
        PHASE_BEGIN(pb + 7, 16) phase_mix_b(F, l, rep_); PHASE_END
        PHASE_BEGIN(pb + 8, 17) for (int cidx = F.gw; cidx < 4096; cidx += F.NGW) rw::out_wave(F, l, cidx); PHASE_END

        PHASE_BEGIN(pb + 9, 7) { pg8::Gemm g{(const bf16_t*)(F.ws + WS_OALL), (const bf16_t*)(F.ws + WS_WBR + l * SZ_WBR), 1024, 1024, 1024}; SchedBranch S; S.S.init(T / 256, 8, F.G, cblk);
              EpiBranch E{PROJ, (bf16_t*)(F.ws + WS_MERGED)}; pg8::gemm_phase<EpiBranch, SchedBranch, true>(F.lds, F.tid, g, S, E); }
        PHASE_END

        PHASE_BEGIN(pb + 10, 8) { pg8::Gemm g{(const bf16_t*)(F.ws + WS_MERGED), (const bf16_t*)(F.ws + WS_WOUT + l * SZ_WOUT), 2048, 2048, 2048}; pg8::StaticOrder S; S.init(T / 256, 8, F.G, cblk);
              EpiWout E{xres, X}; pg8::gemm_phase<EpiWout, pg8::StaticOrder, true>(F.lds, F.tid, g, S, E); }
        PHASE_END

        PHASE_BEGIN(pb + 11, 9) phase_norm<3>(F, X, nullptr, (const float*)ARGP(26) + (size_t)l * 2048, (bf16_t*)(F.ws + WS_APRIME), nullptr, nullptr, nullptr, nullptr); PHASE_END

        PHASE_BEGIN(pb + 12, 10) { pg8::Gemm g{(const bf16_t*)(F.ws + WS_APRIME), (const bf16_t*)(F.ws + WS_WRT + l * SZ_WRT), 4096, 4096, 1024}; SchedRouter S{F.G, F.vcu};
              EpiRouterPart E{(float*)(F.ws + WS_LGP)}; pg8::gemm_phase<EpiRouterPart, SchedRouter, true>(F.lds, F.tid, g, S, E); }
        PHASE_END

        PHASE_BEGIN(pb + 13, 18) phase_select(F, l); PHASE_END

        PHASE_BEGIN(pb + 14, 11) phase_scatter(F, l); PHASE_END

        PHASE_BEGIN(pb + 15, 12) { LAS int* tab = (LAS int*)(F.lds + RING_BYTES + 1024); const int* blke = (const int*)(F.ws + WS_BLKE);
              if (F.tid < 256) tab[F.tid] = blke[F.tid]; __syncthreads();
              SchedMoe S{tab[0], 4, F.G, F.vcu, tab, (const int*)(F.ws + WS_ROWTOK), T};
              pg8::Gemm g{(const bf16_t*)(F.ws + WS_APRIME), (const bf16_t*)(F.ws + WS_WE1), 4096, 2048, 2048}; EpiE1 E{(bf16_t*)(F.ws + WS_HMOE)};
              pg8::gemm_phase<EpiE1, SchedMoe, true, true>(F.lds, F.tid, g, S, E); }
        PHASE_END

        PHASE_BEGIN(pb + 16, 13) { LAS int* tab = (LAS int*)(F.lds + RING_BYTES + 1024); const int* blke = (const int*)(F.ws + WS_BLKE);
              if (F.tid < 256) tab[F.tid] = blke[F.tid]; __syncthreads();
              SchedMoe S{tab[0], 8, F.G, F.vcu, tab, nullptr, 0};
              pg8::Gemm g{(const bf16_t*)(F.ws + WS_HMOE), (const bf16_t*)(F.ws + WS_WE2), 512, 512, 512}; EpiE2 E{(bf16_t*)(F.ws + WS_Y)};
              pg8::gemm_phase<EpiE2, SchedMoe, true>(F.lds, F.tid, g, S, E); }
        PHASE_END
    }


    PHASE_BEGIN(PH_FINAL, 15)
        phase_norm<2>(F, (const float*)(F.ws + WS_X), nullptr, (const float*)ARGP(34), nullptr, args.out, (const bf16_t*)(F.ws + WS_Y), (const int*)(F.ws + WS_POS), (const float*)(F.ws + WS_TOKW));
    PHASE_END
#undef PHASE_BEGIN
#undef PHASE_END
}

#ifndef MK_MULTI
#define MK_MULTI 0
#endif
extern "C" void kernel_launch(void* const* d_in, const int* in_sizes, int n_in, void* d_out, int out_size, void* d_ws, size_t ws_size, hipStream_t stream) {
    static int grid = 0;
    if (grid == 0) {
        if (n_in != 35 || out_size != T * DM || ws_size < WS_END) { fprintf(stderr, "kernel_launch: unexpected shapes (n_in %d, out %d, ws %zu, need %zu)\n", n_in, out_size, ws_size, (size_t)WS_END); grid = -1; return; }
        int dev = 0, cus = 0, per_cu = 0;
        if (hipGetDevice(&dev) != hipSuccess || hipDeviceGetAttribute(&cus, hipDeviceAttributeMultiprocessorCount, dev) != hipSuccess) { grid = -1; return; }
        if (hipFuncSetAttribute((const void*)hybrid_fwd, hipFuncAttributeMaxDynamicSharedMemorySize, LDS_BYTES) != hipSuccess) { fprintf(stderr, "kernel_launch: hipFuncSetAttribute failed\n"); grid = -1; return; }
        if (hipOccupancyMaxActiveBlocksPerMultiprocessor(&per_cu, (const void*)hybrid_fwd, NWAVES * 64, LDS_BYTES) != hipSuccess || per_cu < 1)
            fprintf(stderr, "kernel_launch: occupancy query reports %d workgroups per CU\n", per_cu);
        (void)hipGetLastError();
        grid = cus;
    }
    if (grid < 0) return;
    if (hipMemsetAsync((char*)d_ws + WS_CTL, 0, CTL_ZERO_BYTES, stream) != hipSuccess) return;
    Args a{};
    for (int i = 0; i < 35; ++i) a.in[i] = d_in[i];
    a.out = (float*)d_out; a.ws = (unsigned char*)d_ws;
#if MK_MULTI
    for (int p = 0; p < NPHASES; ++p) { a.ph_lo = p; a.ph_hi = p + 1; hipLaunchKernelGGL(hybrid_fwd, dim3(grid), dim3(NWAVES * 64), LDS_BYTES, stream, a); }
#else
    a.ph_lo = 0; a.ph_hi = NPHASES;
    hipLaunchKernelGGL(hybrid_fwd, dim3(grid), dim3(NWAVES * 64), LDS_BYTES, stream, a);
#endif
    const hipError_t le = hipPeekAtLastError();
    if (le != hipSuccess) fprintf(stderr, "kernel_launch: launch failed: %s\n", hipGetErrorName(le));
}
```

```cpp
#include <hip/hip_runtime.h>
#include <cstdio>
#include <cstdint>

#define LAS __attribute__((address_space(3)))
#define GAS __attribute__((address_space(1)))
typedef unsigned short bf16_t;
typedef short bf16x8 __attribute__((ext_vector_type(8)));
typedef short s16x4 __attribute__((ext_vector_type(4)));
typedef short v4i16_t __attribute__((ext_vector_type(4)));
typedef float f32x4 __attribute__((ext_vector_type(4)));
typedef float f32x2 __attribute__((ext_vector_type(2)));
typedef float f32x16 __attribute__((ext_vector_type(16)));
typedef unsigned u32x4 __attribute__((ext_vector_type(4)));
typedef unsigned u32x2 __attribute__((ext_vector_type(2)));
typedef GAS unsigned gu32;
#define RLX_AGENT __ATOMIC_RELAXED, __HIP_MEMORY_SCOPE_AGENT

constexpr int T = 16384, SEQ = 4096, NBATCH = 4, DM = 2048, DEPTH = 2;
constexpr int NHEAD = 16;
constexpr int N_IN_SRC = 13792;
constexpr int NPROJ = 13824;
constexpr int PC_SBQ = 0, PC_SBK = 1024, PC_SBV = 2048, PC_RR = 3072, PC_RK = 4096, PC_RV = 5120;
constexpr int PC_WD = 6144, PC_AD = 6240, PC_KPE = 6336, PC_GD = 6400, PC_CQ = 6656, PC_CKV = 7424, PC_GATE = 7680;
constexpr int GATE_TILE0 = PC_GATE / 256;
constexpr int RWKV_COLS = 3520;
constexpr float NORM_EPS = 1e-6f, GN_EPS = 64e-5f;
constexpr float LOG2E = 1.4426950408889634f;
constexpr int MOE_MAXBLK = 192;
constexpr int MOE_ROWS = MOE_MAXBLK * 256;

__device__ __forceinline__ float bf2f(unsigned b) { return __builtin_bit_cast(float, b << 16); }
__device__ __forceinline__ float bflo(unsigned w) { return __builtin_bit_cast(float, w << 16); }
__device__ __forceinline__ float bfhi(unsigned w) { return __builtin_bit_cast(float, w & 0xffff0000u); }
typedef __bf16 bf16x2_t __attribute__((ext_vector_type(2)));
__device__ __forceinline__ unsigned cvt_pk_bf16(float lo, float hi) { const f32x2 v = {lo, hi}; const bf16x2_t b = __builtin_convertvector(v, bf16x2_t); return __builtin_bit_cast(unsigned, b); }
__device__ __forceinline__ unsigned pk2(float lo, float hi) { return cvt_pk_bf16(lo, hi); }
__device__ __forceinline__ unsigned f2bf(float f) { return cvt_pk_bf16(f, 0.f); }
__device__ __forceinline__ float fast_sigmoid(float v) { return __builtin_amdgcn_rcpf(1.0f + __expf(-v)); }
template <int CTRL> __device__ __forceinline__ float dpp_mov(float v) { return __builtin_bit_cast(float, __builtin_amdgcn_update_dpp(0, __builtin_bit_cast(int, v), CTRL, 0xF, 0xF, false)); }
__device__ __forceinline__ float sum8(float v) {
    v += dpp_mov<0xB1>(v);
    v += dpp_mov<0x4E>(v);
    v += dpp_mov<0x141>(v);
    return v;
}
__device__ __forceinline__ float wave_sum(float v) {
    v = sum8(v); v += dpp_mov<0x140>(v);
    const float a = __builtin_bit_cast(float, __builtin_amdgcn_readlane(__builtin_bit_cast(int, v), 0)), b = __builtin_bit_cast(float, __builtin_amdgcn_readlane(__builtin_bit_cast(int, v), 16)),
                c = __builtin_bit_cast(float, __builtin_amdgcn_readlane(__builtin_bit_cast(int, v), 32)), d = __builtin_bit_cast(float, __builtin_amdgcn_readlane(__builtin_bit_cast(int, v), 48));
    return (a + b) + (c + d);
}
__device__ __forceinline__ void store8_bf16(bf16_t* p, f32x4 v0, f32x4 v1) {
    u32x4 w; w.x = cvt_pk_bf16(v0[0], v0[1]); w.y = cvt_pk_bf16(v0[2], v0[3]); w.z = cvt_pk_bf16(v1[0], v1[1]); w.w = cvt_pk_bf16(v1[2], v1[3]);
    *(u32x4*)p = w;
}
__device__ __forceinline__ void store4_bf16(bf16_t* p, f32x4 v) { u32x2 w; w.x = cvt_pk_bf16(v[0], v[1]); w.y = cvt_pk_bf16(v[2], v[3]); *(u32x2*)p = w; }
__device__ __forceinline__ f32x4 load4_bf16(const bf16_t* p) { const u32x2 w = *(const u32x2*)p; return (f32x4){bflo(w.x), bfhi(w.x), bflo(w.y), bfhi(w.y)}; }
__device__ __forceinline__ void load8f(const bf16_t* p, float (&o)[8]) { const u32x4 w = *(const u32x4*)p; o[0] = bflo(w.x); o[1] = bfhi(w.x); o[2] = bflo(w.y); o[3] = bfhi(w.y); o[4] = bflo(w.z); o[5] = bfhi(w.z); o[6] = bflo(w.w); o[7] = bfhi(w.w); }
__device__ __forceinline__ void unpack8(const u32x4& w, float (&o)[8]) { o[0] = bflo(w.x); o[1] = bfhi(w.x); o[2] = bflo(w.y); o[3] = bfhi(w.y); o[4] = bflo(w.z); o[5] = bfhi(w.z); o[6] = bflo(w.w); o[7] = bfhi(w.w); }
__device__ __forceinline__ void store8f(bf16_t* p, const float (&v)[8]) { u32x4 w; w.x = pk2(v[0], v[1]); w.y = pk2(v[2], v[3]); w.z = pk2(v[4], v[5]); w.w = pk2(v[6], v[7]); *(u32x4*)p = w; }

namespace pg8 {
constexpr int BM = 256, BK = 64, HALF = 128, HTB = HALF * BK * 2  , STAGE_BYTES = 8 * HTB, NXCD = 8, WGM = 8;
__host__ __device__ __forceinline__ int lds_byte(int r, int c) { const int st = (r >> 4) * 2 + (c >> 5), rr = r & 15, cc = c & 31, ob = rr * 64 + cc * 2; return st * 1024 + (ob ^ (((ob >> 9) & 1) << 5)); }
__host__ __device__ __forceinline__ void stage_rc(int b, int& R, int& C) { const int st = b / 1024, sb = b % 1024, swz = sb ^ (((sb >> 9) & 1) << 5); R = (st >> 1) * 16 + swz / 64; C = (st & 1) * 32 + (swz % 64) / 2; }
__host__ __device__ __forceinline__ int perm32(int rho) { const int n = rho >> 4, i = rho & 15; return 8 * (i >> 2) + 4 * n + (i & 3); }

struct Unit { int pm, pn, am, bn, akoff, bkoff, z; };
struct Gemm { const bf16_t* A; const bf16_t* Bt; int lda, ldb, K; };

struct StaticOrder {
    int nM, nN, nwg, G, c;
    __device__ __forceinline__ void init(int nM_, int nN_, int G_, int c_) { nM = nM_; nN = nN_; nwg = nM * nN; G = G_; c = c_; }
    __device__ __forceinline__ bool tile(int i, int& pm, int& pn) const {
        const long L = (long)i * G + c; if (L >= nwg) return false;
        int wgid = (int)L; { const int q = nwg / NXCD, r = nwg % NXCD, xcd = wgid % NXCD, off = wgid / NXCD; wgid = (xcd < r ? xcd * (q + 1) : r * (q + 1) + (xcd - r) * q) + off; }
        const int nig = WGM * nN, gid = wgid / nig, fm = gid * WGM, gsz = (nM - fm) < WGM ? (nM - fm) : WGM;
        pm = fm + ((wgid % nig) % gsz); pn = (wgid % nig) / gsz; return true;
    }
    __device__ __forceinline__ bool next(int i, Unit& u) const { if (!tile(i, u.pm, u.pn)) return false; u.am = u.pm; u.bn = u.pn; u.akoff = 0; u.bkoff = 0; u.z = 0; return true; }
};

template <class E> constexpr auto epi_chain(int) -> decltype(E::CHAIN) { return E::CHAIN; }
template <class E> constexpr bool epi_chain(long) { return false; }
template <class Epi, class Sched, bool ALIGN_EPI, bool GATHER = false>
__device__ __forceinline__ void gemm_phase(LAS unsigned char* lds, const int tid, const Gemm g, const Sched& S, const Epi& E) {
    const int wid = __builtin_amdgcn_readfirstlane(tid >> 6), lane = tid & 63, wr = wid >> 2, wc = wid & 3, fr = lane & 15, fq = lane >> 4;
    int K = g.K; asm volatile("" : "+s"(K)); const int nt = K / BK;
    unsigned voffA[2], voffB[2];
#pragma unroll
    for (int i = 0; i < 2; ++i) { int R, C; stage_rc(tid * 16 + i * 8192, R, C); const int Rb = Epi::PERM ? ((R & ~31) + perm32(R & 31)) : R;
        voffA[i] = (unsigned)(R * g.lda + C) * 2u; voffB[i] = (unsigned)(Rb * g.ldb + C) * 2u; }
    unsigned gc[2][2], gn[2][2];
#define PG8_GLOAD(dst, unit) do { _Pragma("unroll") for (int _h = 0; _h < 2; ++_h) _Pragma("unroll") for (int _i = 0; _i < 2; ++_i) { int R_, C_; stage_rc(tid * 16 + _i * 8192, R_, C_); \
        unsigned tk_ = (unsigned)S.rowtok[(unit).pm * 256 + _h * 128 + R_]; tk_ = tk_ < (unsigned)S.nrows ? tk_ : 0u; dst[_h][_i] = (tk_ * (unsigned)g.lda + (unsigned)C_) * 2u; } } while (0)
    const size_t kstep = (size_t)(BK * 2);
    const size_t hstepA = GATHER ? 0 : (size_t)HALF * g.lda * 2, hstepB = (size_t)HALF * g.ldb * 2;
    const size_t tstepA = 2 * hstepA, tstepB = 2 * hstepB;
    const unsigned ldsw = (unsigned)wid * 1024u;
    const int aoff = lds_byte(wr * 64 + fr, fq * 8), boff = lds_byte(wc * 32 + fr, fq * 8);
#define PG8_SA(b, h) (((b) * 2 + (h)) * HTB)
#define PG8_SB(b, h) ((4 + (b) * 2 + (h)) * HTB)
#define PG8_STAGE(bufoff, gbase, voff) do { _Pragma("unroll") for (int _i = 0; _i < 2; ++_i) \
        __builtin_amdgcn_global_load_lds((const unsigned*)((const char*)(gbase) + (voff)[_i]), (LAS unsigned*)(lds + (bufoff) + ldsw + _i * 8192), 16, 0, 0); } while (0)
#define PG8_STAGEA(b, h, gbase, nx) do { if constexpr (GATHER) { _Pragma("unroll") for (int _i = 0; _i < 2; ++_i) { const unsigned o_ = (nx) ? gn[h][_i] : gc[h][_i]; \
        __builtin_amdgcn_global_load_lds((const unsigned*)((const char*)(gbase) + o_), (LAS unsigned*)(lds + PG8_SA(b, h) + ldsw + _i * 8192), 16, 0, 0); } } \
    else { PG8_STAGE(PG8_SA(b, h), (gbase) + (h) * hstepA, voffA); } } while (0)
#define PG8_LDA(dst, b, h) do { _Pragma("unroll") for (int m = 0; m < 4; ++m) _Pragma("unroll") for (int k = 0; k < 2; ++k) dst[m][k] = *(const LAS bf16x8*)(lds + PG8_SA(b, h) + aoff + m * 2048 + k * 1024); } while (0)
#define PG8_LDB(dst, b, h) do { _Pragma("unroll") for (int n = 0; n < 2; ++n) _Pragma("unroll") for (int k = 0; k < 2; ++k) dst[n][k] = *(const LAS bf16x8*)(lds + PG8_SB(b, h) + boff + n * 2048 + k * 1024); } while (0)
#define PG8_MMA(ai, bj, At, Bt) do { __builtin_amdgcn_s_setprio(1); _Pragma("unroll") for (int m = 0; m < 4; ++m) _Pragma("unroll") for (int n = 0; n < 2; ++n) _Pragma("unroll") for (int k = 0; k < 2; ++k) \
        acc[ai][bj][m][n] = __builtin_amdgcn_mfma_f32_16x16x32_bf16(Bt[n][k], At[m][k], acc[ai][bj][m][n], 0, 0, 0); __builtin_amdgcn_s_setprio(0); } while (0)
#define PG8_WAIT_V(n) asm volatile("s_waitcnt vmcnt(" #n ")" ::: "memory")
#define PG8_WAIT_L(n) asm volatile("s_waitcnt lgkmcnt(" #n ")" ::: "memory")
#define PG8_BAR __builtin_amdgcn_s_barrier()
#define PG8_SCHED __builtin_amdgcn_sched_barrier(0)
    Unit cur, nxt; int ui = 0;
    if (!S.next(0, cur)) return;
    f32x4 acc[2][2][4][2];
#pragma unroll
    for (int a = 0; a < 2; ++a)
#pragma unroll
        for (int b = 0; b < 2; ++b)
#pragma unroll
            for (int m = 0; m < 4; ++m)
#pragma unroll
                for (int n = 0; n < 2; ++n) acc[a][b][m][n] = (f32x4){0.f, 0.f, 0.f, 0.f};
    bf16x8 At[4][2], B0[2][2], B1[2][2];
    const char* cA = (const char*)g.A + (GATHER ? (size_t)0 : (size_t)cur.am * tstepA) + cur.akoff; const char* cB = (const char*)g.Bt + (size_t)cur.bn * tstepB + cur.bkoff;
    if constexpr (GATHER) PG8_GLOAD(gc, cur);
    {
        PG8_STAGE(PG8_SB(0, 0), cB, voffB); PG8_STAGE(PG8_SB(0, 1), cB + hstepB, voffB); PG8_STAGEA(0, 0, cA, false); PG8_STAGEA(0, 1, cA, false);
        if (wr == 1) PG8_BAR;
        PG8_WAIT_V(2); PG8_BAR;
        PG8_STAGE(PG8_SB(1, 0), cB + kstep, voffB); PG8_STAGEA(1, 0, cA + kstep, false); PG8_STAGE(PG8_SB(1, 1), cB + hstepB + kstep, voffB);
        PG8_WAIT_V(6); PG8_BAR;
    }
    for (;;) {
        const bool has_next = S.next(ui + 1, nxt);
        const char* nA = has_next ? (const char*)g.A + (GATHER ? (size_t)0 : (size_t)nxt.am * tstepA) + nxt.akoff : cA;
        if constexpr (GATHER) { if (has_next) PG8_GLOAD(gn, nxt); else { gn[0][0] = gc[0][0]; gn[0][1] = gc[0][1]; gn[1][0] = gc[1][0]; gn[1][1] = gc[1][1]; } } const char* nB = has_next ? (const char*)g.Bt + (size_t)nxt.bn * tstepB + nxt.bkoff : cB;
#pragma unroll 1
        for (int t = 0; t < nt; t += 2) {
            const bool last = (t == nt - 2);
            const char* a1 = cA + (size_t)(t + 1) * kstep;
            const char* a2 = last ? nA : cA + (size_t)(t + 2) * kstep; const char* b2 = last ? nB : cB + (size_t)(t + 2) * kstep;
            const char* a3 = a2 + kstep; const char* b3 = b2 + kstep;
            PG8_LDB(B0, 0, 0); PG8_LDB(B1, 0, 1); PG8_SCHED; PG8_LDA(At, 0, 0); PG8_STAGEA(1, 1, a1, false);
            PG8_WAIT_V(8); PG8_WAIT_L(0); PG8_BAR; PG8_MMA(0, 0, At, B0); PG8_MMA(0, 1, At, B1); PG8_BAR; PG8_SCHED;
            PG8_LDA(At, 0, 1); PG8_STAGE(PG8_SB(0, 0), b2, voffB); PG8_STAGE(PG8_SB(0, 1), b2 + hstepB, voffB); PG8_STAGEA(0, 0, a2, last);
            PG8_WAIT_V(8); PG8_WAIT_L(0); PG8_BAR; PG8_MMA(1, 0, At, B0); PG8_MMA(1, 1, At, B1); PG8_BAR; PG8_SCHED;
            PG8_LDB(B0, 1, 0); PG8_LDB(B1, 1, 1); PG8_SCHED; PG8_LDA(At, 1, 0); PG8_STAGEA(0, 1, a2, last);
            PG8_WAIT_V(8); PG8_WAIT_L(0); PG8_BAR; PG8_MMA(0, 0, At, B0); PG8_MMA(0, 1, At, B1); PG8_BAR; PG8_SCHED;
            PG8_LDA(At, 1, 1); PG8_STAGE(PG8_SB(1, 0), b3, voffB); PG8_STAGE(PG8_SB(1, 1), b3 + hstepB, voffB); PG8_STAGEA(1, 0, a3, last);
            PG8_WAIT_V(8); PG8_WAIT_L(0); PG8_BAR; PG8_MMA(1, 0, At, B0); PG8_MMA(1, 1, At, B1); PG8_BAR; PG8_SCHED;
        }
        if constexpr (ALIGN_EPI) { if (wr == 0) PG8_BAR; }
        if constexpr (!Epi::AFTER_DRAIN) { E(acc, cur, wr, wc, fr, fq); }
        if (!has_next) break;
        if (!(epi_chain<Epi>(0) && nxt.z != 0))
#pragma unroll
        for (int a = 0; a < 2; ++a)
#pragma unroll
            for (int b = 0; b < 2; ++b)
#pragma unroll
                for (int m = 0; m < 4; ++m)
#pragma unroll
                    for (int n = 0; n < 2; ++n) acc[a][b][m][n] = (f32x4){0.f, 0.f, 0.f, 0.f};
        cur = nxt; cA = nA; cB = nB; ++ui;
        if constexpr (GATHER) { gc[0][0] = gn[0][0]; gc[0][1] = gn[0][1]; gc[1][0] = gn[1][0]; gc[1][1] = gn[1][1]; }
        if constexpr (ALIGN_EPI) { if (wr == 1) PG8_BAR; }
    }
    PG8_WAIT_V(0);
    if constexpr (!ALIGN_EPI) { if (wr == 0) PG8_BAR; }
    PG8_BAR;
    if constexpr (Epi::AFTER_DRAIN) { E.fused(acc, cur, wr, wc, fr, fq, lds, wid, lane); }
#undef PG8_SA
#undef PG8_SB
#undef PG8_STAGE
#undef PG8_STAGEA
#undef PG8_GLOAD
#undef PG8_LDA
#undef PG8_LDB
#undef PG8_MMA
#undef PG8_WAIT_V
#undef PG8_WAIT_L
#undef PG8_BAR
#undef PG8_SCHED
}
}
using pg8::Unit;
typedef f32x4 AccT[2][2][4][2];

#define EPI_ROW(u, ai, m) ((u).pm * 256 + (ai) * 128 + wr * 64 + (m) * 16 + fr)
struct EpiProj { static constexpr bool PERM = true, AFTER_DRAIN = false; bf16_t* O;
    __device__ __forceinline__ void operator()(const AccT& acc, const Unit& u, int wr, int wc, int fr, int fq) const {
        const bool sig = u.pn >= GATE_TILE0; const int col0 = u.pn * 256 + wc * 32 + 8 * fq;
#pragma unroll
        for (int ai = 0; ai < 2; ++ai)
#pragma unroll
            for (int m = 0; m < 4; ++m) { bf16_t* rowp = O + (size_t)EPI_ROW(u, ai, m) * NPROJ + col0;
#pragma unroll
                for (int bj = 0; bj < 2; ++bj) { f32x4 v0 = acc[ai][bj][m][0], v1 = acc[ai][bj][m][1];
                    if (sig) {
#pragma unroll
                        for (int e = 0; e < 4; ++e) { v0[e] = fast_sigmoid(v0[e]); v1[e] = fast_sigmoid(v1[e]); } }
                    store8_bf16(rowp + bj * 128, v0, v1); } }
    }
};
struct EpiMlaQ { static constexpr bool PERM = false, AFTER_DRAIN = false; bf16_t* Q; const float* rstd; const float* cosb; const float* sinb;
    __device__ __forceinline__ void operator()(const AccT& acc, const Unit& u, int wr, int wc, int fr, int fq) const {
        float rs[2][4];
#pragma unroll
        for (int ai = 0; ai < 2; ++ai)
#pragma unroll
            for (int m = 0; m < 4; ++m) rs[ai][m] = rstd[EPI_ROW(u, ai, m)];
        if (u.pn < 4) {
#pragma unroll
            for (int ai = 0; ai < 2; ++ai)
#pragma unroll
                for (int m = 0; m < 4; ++m) { bf16_t* qrow = Q + (size_t)EPI_ROW(u, ai, m) * 1536;
#pragma unroll
                    for (int bj = 0; bj < 2; ++bj)
#pragma unroll
                        for (int n = 0; n < 2; ++n) { const int c = u.pn * 256 + bj * 128 + wc * 32 + n * 16 + fq * 4; const int head = c >> 6, d = c & 63;
                            store4_bf16(qrow + head * 96 + d, acc[ai][bj][m][n] * rs[ai][m]); } }
        } else {
#pragma unroll
            for (int ai = 0; ai < 2; ++ai) { f32x4 cs[4], sn[4];
#pragma unroll
                for (int m = 0; m < 4; ++m) { const int row = EPI_ROW(u, ai, m); cs[m] = *(const f32x4*)(cosb + (size_t)row * 16 + fq * 4); sn[m] = *(const f32x4*)(sinb + (size_t)row * 16 + fq * 4); }
#pragma unroll
                for (int m = 0; m < 4; ++m) { bf16_t* qrow = Q + (size_t)EPI_ROW(u, ai, m) * 1536; const float r = rs[ai][m];
#pragma unroll
                    for (int bj = 0; bj < 2; ++bj) { const int head = (u.pn - 4) * 8 + bj * 4 + wc; const f32x4 x1 = acc[ai][bj][m][0] * r, x2 = acc[ai][bj][m][1] * r;
                        store4_bf16(qrow + head * 96 + 64 + fq * 4, x1 * cs[m] - x2 * sn[m]); store4_bf16(qrow + head * 96 + 80 + fq * 4, x2 * cs[m] + x1 * sn[m]); } } }
        }
    }
};
struct EpiMlaKV { static constexpr bool PERM = true, AFTER_DRAIN = false; bf16_t* Kd; bf16_t* Vd; const float* rstd;
    __device__ __forceinline__ void operator()(const AccT& acc, const Unit& u, int wr, int wc, int fr, int fq) const {
        float rs[2][4];
#pragma unroll
        for (int ai = 0; ai < 2; ++ai)
#pragma unroll
            for (int m = 0; m < 4; ++m) rs[ai][m] = rstd[EPI_ROW(u, ai, m)];
        bf16_t* base = (u.pn < 4) ? Kd + u.pn * 256 : Vd + (u.pn * 256 - 1024);
#pragma unroll
        for (int ai = 0; ai < 2; ++ai)
#pragma unroll
            for (int m = 0; m < 4; ++m) { const int row = EPI_ROW(u, ai, m); const float r = rs[ai][m];
#pragma unroll
                for (int bj = 0; bj < 2; ++bj) store8_bf16(base + (size_t)row * 1024 + bj * 128 + wc * 32 + 8 * fq, acc[ai][bj][m][0] * r, acc[ai][bj][m][1] * r); }
    }
};
struct EpiLora { static constexpr bool PERM = false, AFTER_DRAIN = false; float* logdec; float* aic; bf16_t* gout; const float* w0; const float* a0;
    __device__ __forceinline__ void operator()(const AccT& acc, const Unit& u, int wr, int wc, int fr, int fq) const {
        const int colb = (u.pn & 3) * 256 + wc * 32 + fq * 4;
        f32x4 bias[2][2];
        { const float* bp = (u.z == 0) ? w0 : a0;
#pragma unroll
          for (int bj = 0; bj < 2; ++bj)
#pragma unroll
              for (int n = 0; n < 2; ++n) bias[bj][n] = (u.z < 2) ? *(const f32x4*)(bp + colb + bj * 128 + n * 16) : (f32x4){0.f, 0.f, 0.f, 0.f}; }
        if (u.z == 0) {
#pragma unroll
            for (int ai = 0; ai < 2; ++ai)
#pragma unroll
                for (int m = 0; m < 4; ++m) { float* rowp = logdec + (size_t)EPI_ROW(u, ai, m) * 1024 + colb;
#pragma unroll
                    for (int bj = 0; bj < 2; ++bj)
#pragma unroll
                        for (int n = 0; n < 2; ++n) { f32x4 v = acc[ai][bj][m][n] + bias[bj][n];
#pragma unroll
                            for (int e = 0; e < 4; ++e) { const float x = -v[e]; const float sp = fmaxf(x, 0.f) + __logf(1.0f + __expf(-fabsf(x))); v[e] = -__expf(-sp - 0.5f); }
                            *(f32x4*)(rowp + bj * 128 + n * 16) = v; } }
        } else if (u.z == 1) {
#pragma unroll
            for (int ai = 0; ai < 2; ++ai)
#pragma unroll
                for (int m = 0; m < 4; ++m) { float* rowp = aic + (size_t)EPI_ROW(u, ai, m) * 1024 + colb;
#pragma unroll
                    for (int bj = 0; bj < 2; ++bj)
#pragma unroll
                        for (int n = 0; n < 2; ++n) { f32x4 v = acc[ai][bj][m][n] + bias[bj][n];
#pragma unroll
                            for (int e = 0; e < 4; ++e) v[e] = fast_sigmoid(v[e]);
                            *(f32x4*)(rowp + bj * 128 + n * 16) = v; } }
        } else {
#pragma unroll
            for (int ai = 0; ai < 2; ++ai)
#pragma unroll
                for (int m = 0; m < 4; ++m) { bf16_t* rowp = gout + (size_t)EPI_ROW(u, ai, m) * 1024 + colb;
#pragma unroll
                    for (int bj = 0; bj < 2; ++bj)
#pragma unroll
                        for (int n = 0; n < 2; ++n) store4_bf16(rowp + bj * 128 + n * 16, acc[ai][bj][m][n]); }
        }
    }
};
struct EpiT1 { static constexpr bool PERM = true, AFTER_DRAIN = false; bf16_t* O;
    __device__ __forceinline__ void operator()(const AccT& acc, const Unit& u, int wr, int wc, int fr, int fq) const {
#pragma unroll
        for (int ai = 0; ai < 2; ++ai)
#pragma unroll
            for (int m = 0; m < 4; ++m) store8_bf16(O + (size_t)EPI_ROW(u, ai, m) * 128 + wc * 32 + 8 * fq, acc[ai][0][m][0], acc[ai][0][m][1]);
    }
};
struct EpiVGate { static constexpr bool PERM = true, AFTER_DRAIN = false; bf16_t* O; const float* v0;
    __device__ __forceinline__ void operator()(const AccT& acc, const Unit& u, int wr, int wc, int fr, int fq) const {
#pragma unroll
        for (int bj = 0; bj < 2; ++bj) { const int col = u.pn * 256 + bj * 128 + wc * 32 + 8 * fq; const f32x4 b0 = *(const f32x4*)(v0 + col), b1 = *(const f32x4*)(v0 + col + 4);
#pragma unroll
            for (int ai = 0; ai < 2; ++ai)
#pragma unroll
                for (int m = 0; m < 4; ++m) { f32x4 x0 = acc[ai][bj][m][0] + b0, x1 = acc[ai][bj][m][1] + b1;
#pragma unroll
                    for (int e = 0; e < 4; ++e) { x0[e] = fast_sigmoid(x0[e]); x1[e] = fast_sigmoid(x1[e]); }
                    store8_bf16(O + (size_t)EPI_ROW(u, ai, m) * 1024 + col, x0, x1); } }
    }
};
struct EpiBranch { static constexpr bool PERM = true, AFTER_DRAIN = false, CHAIN = true; const bf16_t* proj; bf16_t* merged;
    __device__ __forceinline__ void operator()(AccT& acc, const Unit& u, int wr, int wc, int fr, int fq) const {
        const int colb = u.pn * 256 + wc * 32 + 8 * fq; const bool more = u.z < 2;
#pragma unroll
        for (int ai = 0; ai < 2; ++ai) {
            u32x4 gt[4][2], gn[4][2];
#pragma unroll
            for (int m = 0; m < 4; ++m)
#pragma unroll
                for (int bj = 0; bj < 2; ++bj) gt[m][bj] = *(const u32x4*)(proj + (size_t)EPI_ROW(u, ai, m) * NPROJ + PC_GATE + u.z * 2048 + colb + bj * 128);
            if (more) {
#pragma unroll
                for (int m = 0; m < 4; ++m)
#pragma unroll
                    for (int bj = 0; bj < 2; ++bj) gn[m][bj] = *(const u32x4*)(proj + (size_t)EPI_ROW(u, ai, m) * NPROJ + PC_GATE + u.z * 2048 + 2048 + colb + bj * 128);
            } else {
#pragma unroll
                for (int m = 0; m < 4; ++m)
#pragma unroll
                    for (int bj = 0; bj < 2; ++bj) gn[m][bj] = (u32x4){0x3f803f80u, 0x3f803f80u, 0x3f803f80u, 0x3f803f80u};
            }
#pragma unroll
            for (int m = 0; m < 4; ++m)
#pragma unroll
                for (int bj = 0; bj < 2; ++bj) { float a[8], b[8]; unpack8(gt[m][bj], a); unpack8(gn[m][bj], b);
#pragma unroll
                    for (int e = 0; e < 8; ++e) a[e] = fmaxf(a[e], 1e-30f) * __builtin_amdgcn_rcpf(fmaxf(b[e], 1e-30f));
#pragma unroll
                    for (int e = 0; e < 4; ++e) { acc[ai][bj][m][0][e] *= a[e]; acc[ai][bj][m][1][e] *= a[4 + e]; }
                    if (!more) store8_bf16(merged + (size_t)EPI_ROW(u, ai, m) * 2048 + colb + bj * 128, acc[ai][bj][m][0], acc[ai][bj][m][1]); }
        }
    }
};
struct EpiWout { static constexpr bool PERM = false, AFTER_DRAIN = false; const float* xres; float* X;
    __device__ __forceinline__ void operator()(const AccT& acc, const Unit& u, int wr, int wc, int fr, int fq) const {
        const int colb = u.pn * 256 + wc * 32 + fq * 4;
#pragma unroll
        for (int ai = 0; ai < 2; ++ai) {
            f32x4 r[4][2][2];
#pragma unroll
            for (int m = 0; m < 4; ++m)
#pragma unroll
                for (int bj = 0; bj < 2; ++bj)
#pragma unroll
                    for (int n = 0; n < 2; ++n) r[m][bj][n] = *(const f32x4*)(xres + (size_t)EPI_ROW(u, ai, m) * 2048 + colb + bj * 128 + n * 16);
#pragma unroll
            for (int m = 0; m < 4; ++m)
#pragma unroll
                for (int bj = 0; bj < 2; ++bj)
#pragma unroll
                    for (int n = 0; n < 2; ++n) *(f32x4*)(X + (size_t)EPI_ROW(u, ai, m) * 2048 + colb + bj * 128 + n * 16) = r[m][bj][n] + acc[ai][bj][m][n];
        }
    }
};
struct EpiE1 { static constexpr bool PERM = true, AFTER_DRAIN = false; bf16_t* H;
    __device__ __forceinline__ void operator()(const AccT& acc, const Unit& u, int wr, int wc, int fr, int fq) const {
#pragma unroll
        for (int ai = 0; ai < 2; ++ai)
#pragma unroll
            for (int m = 0; m < 4; ++m) { f32x4 h0, h1;
#pragma unroll
                for (int e = 0; e < 4; ++e) { const float g0 = acc[ai][0][m][0][e], g1 = acc[ai][0][m][1][e];
                    h0[e] = g0 * fast_sigmoid(g0) * acc[ai][1][m][0][e]; h1[e] = g1 * fast_sigmoid(g1) * acc[ai][1][m][1][e]; }
                store8_bf16(H + (size_t)EPI_ROW(u, ai, m) * 512 + u.z * 128 + wc * 32 + 8 * fq, h0, h1); }
    }
};
struct EpiE2 { static constexpr bool PERM = true, AFTER_DRAIN = false; bf16_t* Y;
    __device__ __forceinline__ void operator()(const AccT& acc, const Unit& u, int wr, int wc, int fr, int fq) const {
#pragma unroll
        for (int ai = 0; ai < 2; ++ai)
#pragma unroll
            for (int m = 0; m < 4; ++m) { bf16_t* rowp = Y + (size_t)EPI_ROW(u, ai, m) * 2048 + u.z * 256 + wc * 32 + 8 * fq;
#pragma unroll
                for (int bj = 0; bj < 2; ++bj) store8_bf16(rowp + bj * 128, acc[ai][bj][m][0], acc[ai][bj][m][1]); }
    }
};
struct EpiRouterPart { static constexpr bool PERM = false, AFTER_DRAIN = false; float* lgp;
    __device__ __forceinline__ void operator()(const AccT& acc, const Unit& u, int wr, int wc, int fr, int fq) const {
        if (wc < 3) {
#pragma unroll
            for (int ai = 0; ai < 2; ++ai)
#pragma unroll
                for (int m = 0; m < 4; ++m) { float* rowp = lgp + ((size_t)u.z * T + EPI_ROW(u, ai, m)) * 96 + wc * 32 + fq * 4;
#pragma unroll
                    for (int n = 0; n < 2; ++n) *(f32x4*)(rowp + n * 16) = acc[ai][0][m][n] + acc[ai][1][m][n]; } }
    }
};
struct SchedRouter { int G, vcu;
    __device__ __forceinline__ bool next(int i, Unit& u) const { const int L = i * G + vcu; if (L >= 256) return false;
        u.pm = L >> 2; u.am = u.pm; u.pn = 0; u.bn = 0; u.z = L & 3; u.akoff = u.z * 2048; u.bkoff = u.z * 2048; return true; } };
constexpr size_t MiB = 1u << 20;
constexpr size_t WS_CTL = 0, CTL_ZERO_BYTES = 1 * MiB;
constexpr size_t WS_MISC = 1 * MiB;
constexpr size_t WS_COS = WS_MISC, WS_SIN = WS_COS + (size_t)T * 16 * 4, WS_RSTDQ = WS_SIN + (size_t)T * 16 * 4, WS_RSTDKV = WS_RSTDQ + (size_t)T * 4,
                 WS_TOKE = WS_RSTDKV + (size_t)T * 4, WS_TOKW = WS_TOKE + (size_t)T * 8, WS_POS = WS_TOKW + (size_t)T * 8, WS_BLKE = WS_POS + (size_t)T * 8;
static_assert(WS_BLKE + 4096 <= 4 * MiB, "misc region");
constexpr size_t WS_ROWTOK = WS_BLKE + 4096;
static_assert(WS_ROWTOK + (size_t)MOE_ROWS * 4 <= 4 * MiB, "misc region");
constexpr size_t WS_WIN = 4 * MiB;
constexpr size_t SZ_WIN = (size_t)NPROJ * 2048 * 2;
constexpr size_t WS_WUQ = WS_WIN + 2 * SZ_WIN;
constexpr size_t SZ_WUQ = (size_t)1536 * 768 * 2;
constexpr size_t WS_WUKV = WS_WUQ + 2 * SZ_WUQ;
constexpr size_t SZ_WUKV = (size_t)2048 * 256 * 2;
constexpr size_t WS_WLORA = WS_WUKV + 2 * SZ_WUKV;
constexpr size_t SZ_WLORA = (size_t)3072 * 256 * 2;
constexpr size_t WS_WV1 = WS_WLORA + 2 * SZ_WLORA;
constexpr size_t WS_WV2 = WS_WV1 + (size_t)256 * 1024 * 2;
constexpr size_t WS_WBR = WS_WV2 + (size_t)1024 * 128 * 2;
constexpr size_t SZ_WBR = (size_t)3 * 2048 * 1024 * 2;
constexpr size_t WS_WOUT = WS_WBR + 2 * SZ_WBR;
constexpr size_t SZ_WOUT = (size_t)2048 * 2048 * 2;
constexpr size_t WS_WRT = WS_WOUT + 2 * SZ_WOUT;
constexpr size_t SZ_WRT = (size_t)256 * 4096 * 2;
constexpr size_t WS_WE1 = WS_WRT + 2 * SZ_WRT;
constexpr size_t WS_WE2 = WS_WE1 + (size_t)64 * 1024 * 2048 * 2;
constexpr size_t WS_REGA = WS_WE2 + (size_t)64 * 2048 * 512 * 2;
constexpr size_t WS_PROJ = WS_REGA;
constexpr size_t WS_QMLA = WS_PROJ + (size_t)T * NPROJ * 2;
constexpr size_t WS_KMLA = WS_QMLA + (size_t)T * 1536 * 2;
constexpr size_t WS_KPE = WS_KMLA + (size_t)T * 1024 * 2;
constexpr size_t WS_VMLA = WS_KMLA + (size_t)T * 1536 * 2;
constexpr size_t WS_REGA_END = WS_VMLA + (size_t)T * 1024 * 2;
constexpr size_t WS_APRIME = WS_REGA;
constexpr size_t WS_XG = WS_APRIME + (size_t)T * 4096 * 2;
constexpr size_t WS_HMOE = WS_XG + (size_t)MOE_ROWS * 2048 * 2;
constexpr size_t WS_Y = WS_HMOE + (size_t)MOE_ROWS * 512 * 2;
static_assert(WS_Y + (size_t)MOE_ROWS * 2048 * 2 <= WS_REGA_END, "MoE overlay fits region A");
constexpr size_t WS_X = WS_REGA_END;
constexpr size_t WS_H = WS_X + (size_t)T * 2048 * 4;
constexpr size_t WS_LGP = WS_H;
constexpr size_t WS_MERGED = WS_H + (size_t)T * 2048 * 2;
constexpr size_t WS_RK = WS_MERGED + (size_t)T * 2048 * 2;
constexpr size_t WS_VS = WS_RK + (size_t)T * 2048 * 2;
constexpr size_t WS_LORAIN = WS_VS + (size_t)2 * T * 1024 * 2;
constexpr size_t WS_LOGDEC = WS_LORAIN + (size_t)T * 768 * 2;
constexpr size_t WS_AIC = WS_LOGDEC + (size_t)T * 1024 * 4;
constexpr size_t WS_MACC = WS_LOGDEC;
constexpr size_t WS_GOUT = WS_AIC + (size_t)T * 1024 * 4;
constexpr size_t WS_T1 = WS_GOUT + (size_t)T * 1024 * 2;
constexpr size_t WS_VGATE = WS_T1 + (size_t)T * 128 * 2;
constexpr size_t WS_OALL = WS_VGATE + (size_t)T * 1024 * 2;
constexpr size_t WS_VMIX = WS_OALL + (size_t)3 * T * 1024 * 2;
constexpr size_t WS_BC = WS_VMIX + (size_t)T * 1024 * 2;
constexpr size_t WS_RWS = WS_BC + (size_t)T * 16 * 4;
constexpr size_t WS_END = WS_RWS + (size_t)4096 * 49152;
static_assert(WS_END <= (size_t)2048 * MiB, "workspace map fits 2 GiB");
static_assert(DEPTH == 2, "the phase program is written out for two layers");
constexpr int CW_BAR = 4096;
constexpr int CW_QHEAD = 8192;
constexpr int CW_CNT = 8448;
constexpr int CW_CUR = 8704;
constexpr int RING_BYTES = 131072, MISC_OFF = RING_BYTES + 320, LDS_BYTES = 147456;
constexpr int NWAVES = 8;

#define XB_TMO      128
#define XB_XCNT(j)  (256  + 64 * (j))
#define XB_XSUB(j)  (1280 + 64 * (j))
#define XB_XGEN(j)  (2304 + 64 * (j))
#define XB_TOP      3328
#define XB_TOPGEN   3392
#define XCD_BAR_WORDS 3456
#define XB_SPIN_CAP (1u << 18)
__device__ __forceinline__ unsigned xb_ld(unsigned* p)              { return __hip_atomic_load(p, __ATOMIC_RELAXED, __HIP_MEMORY_SCOPE_AGENT); }
__device__ __forceinline__ unsigned xb_add(unsigned* p, unsigned v) { return __hip_atomic_fetch_add(p, v, __ATOMIC_RELAXED, __HIP_MEMORY_SCOPE_AGENT); }
__device__ __forceinline__ unsigned xb_xcc_id() { return (unsigned)__builtin_amdgcn_s_getreg((3 << 11) | 20) & 0xFu; }
#define XB_SPIN(cond, bar) do { unsigned _sp = 0; while (cond) { __builtin_amdgcn_s_sleep(1); \
    if ((++_sp & 255u) == 0u) { if (xb_ld(&(bar)[XB_TMO])) break; if (_sp > XB_SPIN_CAP) { atomicAdd(&(bar)[XB_TMO], 1u); break; } } } } while (0)
struct XcdBarrier { unsigned* bar; unsigned x; volatile LAS unsigned* st; };
__device__ __forceinline__ XcdBarrier xcd_barrier_post(unsigned* bar, volatile LAS unsigned* st, bool leader) {
    XcdBarrier b; b.bar = bar; b.x = xb_xcc_id(); b.st = st;
    if (leader) (void)xb_add(&bar[XB_XCNT(b.x)], 1u);
    return b;
}
__device__ __forceinline__ void xcd_barrier_complete(unsigned* bar, unsigned x, unsigned& nloc, unsigned& nx) {
    const unsigned G = gridDim.x * gridDim.y * gridDim.z;
    unsigned sum, cnt, mine, sp = 0u;
    for (;;) {
        sum = 0u; cnt = 0u; mine = 0u;
#pragma unroll
        for (unsigned j = 0; j < 16; ++j) { const unsigned c = xb_ld(&bar[XB_XCNT(j)]); sum += c; cnt += (c > 0u) ? 1u : 0u; mine = (j == x) ? c : mine; }
        if (sum == G) break;
        __builtin_amdgcn_s_sleep(1);
        if ((++sp & 255u) == 0u) { if (xb_ld(&bar[XB_TMO])) break; if (sp > XB_SPIN_CAP) { atomicAdd(&bar[XB_TMO], 1u); break; } }
    }
    nloc = mine > 0u ? mine : 1u; nx = cnt > 0u ? cnt : 1u;
}
__device__ __forceinline__ void xcd_barrier(const XcdBarrier& b, bool leader) {
    asm volatile("s_waitcnt vmcnt(0)" ::: "memory");
    __syncthreads();
    if (leader) {
        unsigned* bar = b.bar;
        __builtin_amdgcn_s_waitcnt(0);
        unsigned nloc = b.st[0], nx = b.st[1];
        if (nloc == 0u) { xcd_barrier_complete(bar, b.x, nloc, nx); b.st[0] = nloc; b.st[1] = nx; }
        const unsigned old = xb_add(&bar[XB_XSUB(b.x)], 1u);
        const unsigned gen = old / nloc;
        if (old + 1u == (gen + 1u) * nloc) {
            __builtin_amdgcn_fence(__ATOMIC_RELEASE, "agent");
            asm volatile("s_waitcnt vmcnt(0)" ::: "memory");
            const unsigned og = xb_add(&bar[XB_TOP], 1u);
            const unsigned tg = og / nx;
            if (og + 1u == (tg + 1u) * nx) xb_add(&bar[XB_TOPGEN], 1u);
            else XB_SPIN(xb_ld(&bar[XB_TOPGEN]) == tg, bar);
            __builtin_amdgcn_fence(__ATOMIC_ACQUIRE, "agent");
            xb_add(&bar[XB_XGEN(b.x)], 1u);
            asm volatile("s_waitcnt vmcnt(0)" ::: "memory");
        } else {
            XB_SPIN(xb_ld(&bar[XB_XGEN(b.x)]) == gen, bar);
            __builtin_amdgcn_fence(__ATOMIC_ACQUIRE, "agent");
            asm volatile("s_waitcnt vmcnt(0)" ::: "memory");
        }
    }
    __syncthreads();
}

struct Args { const void* in[35]; float* out; unsigned char* ws; int ph_lo, ph_hi; };
struct Frame {
    LAS unsigned char* lds; volatile LAS unsigned* MISC; unsigned* ctl; unsigned char* ws;
    int tid, lane, wave, vcu, G, gw, NGW;
};
#define LDS_WAIT() asm volatile("s_waitcnt lgkmcnt(0)" ::: "memory")
template <int IDX> __device__ __forceinline__ const void* kernarg_in() {
    const auto ka = __builtin_amdgcn_kernarg_segment_ptr(); unsigned long long r;
    asm volatile("s_load_dwordx2 %0, %1, %2\n\ts_waitcnt lgkmcnt(0)" : "=s"(r) : "s"(ka), "n"(IDX * 8));
    return (const void*)(const GAS void*)r;
}
#define ARGP(i) (kernarg_in<(i)>())
__device__ __forceinline__ unsigned char* launder(unsigned char* p) { unsigned long long v = (unsigned long long)p; asm volatile("" : "+s"(v)); return (unsigned char*)(GAS unsigned char*)v; }

__device__ __forceinline__ void conv_item(const float* W, int ldw, int Ksrc, int k0, int n0src, bf16_t* WT, int ldt, int row0dst, int kdst0, float scale, const float* kscale, bool lo_mode, LAS float* scr, int lane) {
    const float* ks = kscale ? kscale : W;
    const float gs = kscale ? 1.f : 0.f;
#pragma unroll 1
    for (int h = 0; h < 2; ++h) { float w[16], g[16];
#pragma unroll
        for (int i = 0; i < 16; ++i) { const int k = k0 + 32 * h + 2 * i + (lane >> 5), kc = k < Ksrc ? k : Ksrc - 1; w[i] = W[(size_t)kc * ldw + n0src + (lane & 31)]; g[i] = ks[kc]; }
#pragma unroll
        for (int i = 0; i < 16; ++i) { const int kk = 32 * h + 2 * i + (lane >> 5), k = k0 + kk; const float msk = (k < Ksrc) ? scale : 0.f;
            float v = w[i] * msk * (g[i] * gs + (1.f - gs));
            if (lo_mode) v = v - bf2f(f2bf(v));
            scr[kk * 33 + (lane & 31)] = v; } }
    LDS_WAIT(); asm volatile("" ::: "memory");
    const int c = lane & 7;
#pragma unroll
    for (int j = 0; j < 4; ++j) { const int n = (lane >> 3) + 8 * j; const LAS float* s = scr + (8 * c) * 33 + n;
        u32x4 o; o.x = pk2(s[0 * 33], s[1 * 33]); o.y = pk2(s[2 * 33], s[3 * 33]); o.z = pk2(s[4 * 33], s[5 * 33]); o.w = pk2(s[6 * 33], s[7 * 33]);
        *(u32x4*)(WT + (size_t)(row0dst + n) * ldt + kdst0 + k0 + 8 * c) = o; }
    LDS_WAIT(); asm volatile("" ::: "memory");
}
__device__ __forceinline__ void conv_job(Frame& F, int& base, const float* W, int ldw, int Ksrc, int Kdst, int col0, int ncols, bf16_t* WT, int ldt, int row0, int kdst0, float scale, const float* kscale, bool lo_mode) {
    LAS float* scr = (LAS float*)(F.lds + F.wave * 16384);
    const int nkb = Kdst / 64, nnb = ncols / 32, nitems = nkb * nnb;
    int it = (F.gw + F.NGW - (base % F.NGW)) % F.NGW; base += nitems;
    for (; it < nitems; it += F.NGW) { const int kb = it / nnb, nb = it % nnb;
        conv_item(W, ldw, Ksrc, kb * 64, col0 + nb * 32, WT, ldt, row0 + nb * 32, kdst0, scale, kscale, lo_mode, scr, F.lane); }
}
__device__ __forceinline__ void zero_rows(Frame& F, bf16_t* WT, int ldt, int row0, int nrows) {
    const size_t n16 = (size_t)nrows * ldt / 8; u32x4* p = (u32x4*)(WT + (size_t)row0 * ldt);
    for (size_t i = (size_t)F.gw * 64 + F.lane; i < n16; i += (size_t)F.NGW * 64) p[i] = (u32x4){0u, 0u, 0u, 0u};
}


constexpr int PANEL_PITCH = 1028;
struct PanelDesc { const float* W; bf16_t* WT; int ldw, k0, c0, ncols, ldt, kind, p0, p1; };
__device__ __forceinline__ void panel_map(const PanelDesc& d, int c, int& drow, float& sc) {
    sc = 1.f;
    if (d.kind == 0) drow = d.p0 * 1024 + 256 * (c >> 7) + 128 * d.p1 + (c & 127);
    else if (d.kind == 1) drow = d.p0 * 2048 + c;
    else if (d.kind == 2) { drow = c < 6336 ? c : c < 7616 ? c + 64 : c < 7648 ? c - 1280 : c + 32; sc = c < 1024 ? 0.125f * LOG2E : 1.f; }
    else drow = d.p0 + c;
}
__device__ __forceinline__ void panel_load(Frame& F, const PanelDesc& d, f32x4 (&v)[16]) {
#pragma unroll
    for (int i = 0; i < 16; ++i) { const int f = F.tid + 512 * i, kk = f >> 7, n4 = f & 127;
        v[i] = (4 * n4 < d.ncols) ? __builtin_nontemporal_load((const f32x4*)(d.W + (size_t)(d.k0 + kk) * d.ldw + d.c0 + 4 * n4)) : (f32x4){0.f, 0.f, 0.f, 0.f}; }
}
__device__ __forceinline__ void panel_finish(Frame& F, const PanelDesc& d, const f32x4 (&v)[16]) {
    const int tid = F.tid; LAS unsigned char* L = F.lds;
#pragma unroll
    for (int i = 0; i < 16; ++i) { const int f = tid + 512 * i, kk = f >> 7, n4 = f & 127; LAS unsigned* o = (LAS unsigned*)(L + kk * PANEL_PITCH + n4 * 8);
        o[0] = cvt_pk_bf16(v[i][0], v[i][1]); o[1] = cvt_pk_bf16(v[i][2], v[i][3]); }
    __syncthreads();
    const int c = tid & 7, nl = tid >> 3;
#pragma unroll
    for (int j = 0; j < 4; ++j) { const int n = 2 * nl + 128 * j;
        if (n < d.ncols) { int drow; float sc; panel_map(d, d.c0 + n, drow, sc);
            float x0[8], x1[8];
#pragma unroll
            for (int q = 0; q < 8; ++q) { const unsigned w = *(const LAS unsigned*)(L + (8 * c + q) * PANEL_PITCH + n * 2); x0[q] = bflo(w) * sc; x1[q] = bfhi(w) * sc; }
            u32x4 o0, o1; o0.x = pk2(x0[0], x0[1]); o0.y = pk2(x0[2], x0[3]); o0.z = pk2(x0[4], x0[5]); o0.w = pk2(x0[6], x0[7]);
            o1.x = pk2(x1[0], x1[1]); o1.y = pk2(x1[2], x1[3]); o1.z = pk2(x1[4], x1[5]); o1.w = pk2(x1[6], x1[7]);
            *(u32x4*)(d.WT + (size_t)drow * d.ldt + d.k0 + 8 * c) = o0; *(u32x4*)(d.WT + (size_t)(drow + 1) * d.ldt + d.k0 + 8 * c) = o1; } }
    __syncthreads();
}
template <class DescFn>
__device__ __forceinline__ void run_panels(Frame& F, int first, int n, int stride, const DescFn& fn) {
    if (n <= 0) return;
    f32x4 va[16], vb[16]; PanelDesc da = fn(first), db = da; panel_load(F, da, va);
    for (int q = 0; q < n; q += 2) {
        const bool hb = q + 1 < n; if (hb) { db = fn(first + (q + 1) * stride); panel_load(F, db, vb); }
        panel_finish(F, da, va);
        if (q + 2 < n) { da = fn(first + (q + 2) * stride); panel_load(F, da, va); }
        if (hb) panel_finish(F, db, vb);
    }
}
__device__ __forceinline__ void router_conv(Frame& F, int& base, const float* rgw, const float* rew, bf16_t* WT) {
    LAS float* scr = (LAS float*)(F.lds + F.wave * 16384);
    const int nitems = 32 * 4 * 3;
    int it = (F.gw + F.NGW - (base % F.NGW)) % F.NGW; base += nitems;
    for (; it < nitems; it += F.NGW) { const int var = it / 128, r = it % 128, kb = r / 4, nb = r % 4, k0 = kb * 64, lane = F.lane;
        const int n = nb * 32 + (lane & 31); const bool ok = n < 72; const float okf = ok ? 1.f : 0.f;
#pragma unroll 1
        for (int h = 0; h < 2; ++h) { float w[16];
#pragma unroll
            for (int i = 0; i < 16; ++i) { const int k = k0 + 32 * h + 2 * i + (lane >> 5);
                const float* sp = (n < 8) ? rgw + (size_t)k * 8 + n : rew + (size_t)k * 64 + (ok ? n - 8 : 0);
                w[i] = *sp; }
#pragma unroll
            for (int i = 0; i < 16; ++i) { const int kk = 32 * h + 2 * i + (lane >> 5); float v = w[i] * okf;
                if (var == 2) v = v - bf2f(f2bf(v));
                scr[kk * 33 + (lane & 31)] = v; } }
        LDS_WAIT(); asm volatile("" ::: "memory");
        const int c = lane & 7; const int row0 = (var == 2 ? 128 : 0) + nb * 32, kd0 = (var == 1 ? 2048 : 0);
#pragma unroll
        for (int j = 0; j < 4; ++j) { const int n = (lane >> 3) + 8 * j; const LAS float* s = scr + (8 * c) * 33 + n;
            u32x4 o; o.x = pk2(s[0 * 33], s[1 * 33]); o.y = pk2(s[2 * 33], s[3 * 33]); o.z = pk2(s[4 * 33], s[5 * 33]); o.w = pk2(s[6 * 33], s[7 * 33]);
            *(u32x4*)(WT + (size_t)(row0 + n) * 4096 + kd0 + k0 + 8 * c) = o; }
        LDS_WAIT(); asm volatile("" ::: "memory");
    }
    for (int i = F.gw * 64 + F.lane; i < 128 * 256; i += F.NGW * 64) { const int row = 128 + i / 256, c8 = i % 256; *(u32x4*)(WT + (size_t)row * 4096 + 2048 + c8 * 8) = (u32x4){0u, 0u, 0u, 0u}; }
}

struct P0Desc { unsigned char* ws; static constexpr int NP_WIN = 27 * 32, NP_BR = 4 * 16, NP_OUT = 4 * 32, NP_L = NP_WIN + 3 * NP_BR + NP_OUT;
    __device__ __forceinline__ PanelDesc operator()(int pi) const { const int l = pi / NP_L; int r = pi % NP_L; PanelDesc d; d.p1 = 0;
        if (r < NP_WIN) { const int cp = r % 27, kb = r / 27; d.c0 = cp * 512; d.ncols = (N_IN_SRC - d.c0) < 512 ? (N_IN_SRC - d.c0) : 512;
            d.W = (const float*)ARGP(3) + (size_t)l * 2048 * N_IN_SRC; d.ldw = N_IN_SRC; d.k0 = kb * 64; d.WT = (bf16_t*)(ws + WS_WIN + l * SZ_WIN); d.ldt = 2048; d.kind = 2; d.p0 = 0; return d; }
        r -= NP_WIN;
        if (r < 3 * NP_BR) { const int br = r / NP_BR, q = r % NP_BR, cp = q & 3, kb = q >> 2; d.W = (const float*)(br == 0 ? ARGP(22) : br == 1 ? ARGP(23) : ARGP(24)) + (size_t)l * 1024 * 2048;
            d.ldw = 2048; d.k0 = kb * 64; d.c0 = cp * 512; d.ncols = 512; d.WT = (bf16_t*)(ws + WS_WBR + l * SZ_WBR); d.ldt = 1024; d.kind = 3; d.p0 = br * 2048; return d; }
        r -= 3 * NP_BR;
        { const int cp = r & 3, kb = r >> 2; d.W = (const float*)ARGP(25) + (size_t)l * 2048 * 2048; d.ldw = 2048; d.k0 = kb * 64; d.c0 = cp * 512; d.ncols = 512;
          d.WT = (bf16_t*)(ws + WS_WOUT + l * SZ_WOUT); d.ldt = 2048; d.kind = 3; d.p0 = 0; return d; } } };
__device__ __forceinline__ void phase_convert(Frame& F, const Args& a) {
    int base = 0;
    for (int l = 0; l < DEPTH; ++l) {
        zero_rows(F, (bf16_t*)(F.ws + WS_WIN + l * SZ_WIN), 2048, PC_KPE + 32, 32);
        const float* wuq = (const float*)ARGP(19) + (size_t)l * 768 * 1536; bf16_t* WUQ = (bf16_t*)(F.ws + WS_WUQ + l * SZ_WUQ); const float* qg = (const float*)ARGP(18) + l * 768;
        const float qs = 0.10206207261596575f * LOG2E;
        for (int hd = 0; hd < 16; ++hd) { conv_job(F, base, wuq, 1536, 768, 768, hd * 96, 64, WUQ, 768, hd * 64, 0, qs, qg, false);
                                           conv_job(F, base, wuq, 1536, 768, 768, hd * 96 + 64, 32, WUQ, 768, 1024 + hd * 32, 0, qs, qg, false); }
        const float* wukv = (const float*)ARGP(21) + (size_t)l * 256 * 2048; bf16_t* WUKV = (bf16_t*)(F.ws + WS_WUKV + l * SZ_WUKV); const float* kvg = (const float*)ARGP(20) + l * 256;
        for (int hd = 0; hd < 16; ++hd) { conv_job(F, base, wukv, 2048, 256, 256, hd * 128, 64, WUKV, 256, hd * 64, 0, 1.f, kvg, false);
                                           conv_job(F, base, wukv, 2048, 256, 256, hd * 128 + 64, 64, WUKV, 256, 1024 + hd * 64, 0, 1.f, kvg, false); }
        bf16_t* WLORA = (bf16_t*)(F.ws + WS_WLORA + l * SZ_WLORA);
        conv_job(F, base, (const float*)ARGP(6) + (size_t)l * 96 * 1024, 1024, 96, 256, 0, 1024, WLORA, 256, 0, 0, 1.f, nullptr, false);
        conv_job(F, base, (const float*)ARGP(8) + (size_t)l * 96 * 1024, 1024, 96, 256, 0, 1024, WLORA, 256, 1024, 0, 1.f, nullptr, false);
        conv_job(F, base, (const float*)ARGP(9) + (size_t)l * 256 * 1024, 1024, 256, 256, 0, 1024, WLORA, 256, 2048, 0, 1.f, nullptr, false);
        router_conv(F, base, (const float*)ARGP(27) + (size_t)l * 2048 * 8, (const float*)ARGP(29) + (size_t)l * 2048 * 64, (bf16_t*)(F.ws + WS_WRT + l * SZ_WRT));
    }
    conv_job(F, base, (const float*)ARGP(16), 64, 1024, 1024, 0, 64, (bf16_t*)(F.ws + WS_WV1), 1024, 0, 0, 1.f, nullptr, false);
    zero_rows(F, (bf16_t*)(F.ws + WS_WV1), 1024, 64, 192);
    conv_job(F, base, (const float*)ARGP(17), 1024, 64, 128, 0, 1024, (bf16_t*)(F.ws + WS_WV2), 128, 0, 0, 1.f, nullptr, false);
    { const int* pos = (const int*)ARGP(1); float* cosb = (float*)(F.ws + WS_COS); float* sinb = (float*)(F.ws + WS_SIN);
      for (int i = F.gw * 64 + F.lane; i < T * 16; i += F.NGW * 64) { const int t = i >> 4, j = i & 15;
          const double fr4 = (j & 3) == 0 ? 1.0 : (j & 3) == 1 ? 0.5623413251903491 : (j & 3) == 2 ? 0.31622776601683794 : 0.1778279410038923;
          const double dec = (j >> 2) == 0 ? 1.0 : (j >> 2) == 1 ? 0.1 : (j >> 2) == 2 ? 0.01 : 0.001;
          const double rev = (double)pos[t] * fr4 * dec * 0.15915494309189535;
          const double fr = rev - __builtin_floor(rev);
          const float ang = (float)(fr * 6.283185307179586);
          cosb[i] = __cosf(ang); sinb[i] = __sinf(ang); } }
    __syncthreads();
    { P0Desc fn{F.ws}; const int np = (P0Desc::NP_L - F.vcu + F.G - 1) / F.G; run_panels(F, F.vcu, np, F.G, fn); }
}
constexpr int EC_PANELS = 64 * (2 * 32 + 8 * 4);
struct EcDesc { unsigned char* ws; int l;
    __device__ __forceinline__ PanelDesc operator()(int pidx) const { const int e = pidx / 96, r = pidx % 96; PanelDesc d;
        if (r < 64) { const int which = r >> 5, kb = r & 31; d.W = (const float*)(which ? ARGP(32) : ARGP(31)) + ((size_t)l * 64 + e) * 2048 * 512; d.WT = (bf16_t*)(ws + WS_WE1);
            d.ldw = 512; d.k0 = kb * 64; d.c0 = 0; d.ncols = 512; d.ldt = 2048; d.kind = 0; d.p0 = e; d.p1 = which; }
        else { const int rr = r - 64, kb = rr >> 2, nq = rr & 3; d.W = (const float*)ARGP(33) + ((size_t)l * 64 + e) * 512 * 2048; d.WT = (bf16_t*)(ws + WS_WE2);
            d.ldw = 2048; d.k0 = kb * 64; d.c0 = nq * 512; d.ncols = 512; d.ldt = 512; d.kind = 1; d.p0 = e; d.p1 = 0; }
        return d; } };

#ifndef DBG_NOMOE
#define DBG_NOMOE 0
#endif
template <int MODE>
__device__ __forceinline__ void phase_norm(Frame& F, const float* xin, float* X, const float* g, bf16_t* H, float* out, const bf16_t* Y, const int* pos, const float* tokw) {
    f32x4 gv[8];
    { const f32x4* gr = (const f32x4*)g + F.lane;
#pragma unroll
      for (int j = 0; j < 8; ++j) gv[j] = gr[64 * j]; }
    int p0n = 0, p1n = 0; float w0n = 0.f, w1n = 0.f;
    if ((MODE == 1 || MODE == 2) && !DBG_NOMOE) { if (F.gw < T) { p0n = pos[2 * F.gw]; p1n = pos[2 * F.gw + 1]; w0n = tokw[2 * F.gw]; w1n = tokw[2 * F.gw + 1]; } }
    for (int t = F.gw; t < T; t += F.NGW) {
        f32x4 v[8]; float ss = 0.f;
        const f32x4* xr = (const f32x4*)(xin + (size_t)t * 2048) + F.lane;
#pragma unroll
        for (int j = 0; j < 8; ++j) v[j] = xr[64 * j];
        if ((MODE == 1 || MODE == 2) && !DBG_NOMOE) {
            const int p0 = p0n, p1 = p1n; const float w0 = w0n, w1 = w1n;
            const bf16_t* y0 = Y + (size_t)p0 * 2048 + 4 * F.lane; const bf16_t* y1 = Y + (size_t)p1 * 2048 + 4 * F.lane;
            u32x2 ya[8], yb[8];
#pragma unroll
            for (int j = 0; j < 8; ++j) { ya[j] = *(const u32x2*)(y0 + 256 * j); yb[j] = *(const u32x2*)(y1 + 256 * j); }
            { const int tn = (t + F.NGW < T) ? t + F.NGW : t; p0n = pos[2 * tn]; p1n = pos[2 * tn + 1]; w0n = tokw[2 * tn]; w1n = tokw[2 * tn + 1]; }
            __builtin_amdgcn_sched_barrier(0);
#pragma unroll
            for (int j = 0; j < 8; ++j) { const f32x4 a = (f32x4){bflo(ya[j].x), bfhi(ya[j].x), bflo(ya[j].y), bfhi(ya[j].y)}, bq = (f32x4){bflo(yb[j].x), bfhi(yb[j].x), bflo(yb[j].y), bfhi(yb[j].y)};
                v[j] += w0 * a + w1 * bq; }
            if (MODE == 1) { f32x4* xw = (f32x4*)(X + (size_t)t * 2048) + F.lane;
#pragma unroll
                for (int j = 0; j < 8; ++j) xw[64 * j] = v[j]; }
        }
#pragma unroll
        for (int j = 0; j < 8; ++j) ss += (v[j][0] * v[j][0] + v[j][1] * v[j][1]) + (v[j][2] * v[j][2] + v[j][3] * v[j][3]);
        const float rstd = rsqrtf(wave_sum(ss) * (1.f / 2048.f) + NORM_EPS);
#pragma unroll
        for (int j = 0; j < 8; ++j) { const f32x4 o = v[j] * rstd * gv[j];
            if (MODE == 2) ((f32x4*)(out + (size_t)t * 2048) + F.lane)[64 * j] = o;
            else if (MODE == 3) { u32x2 hi; hi.x = pk2(o[0], o[1]); hi.y = pk2(o[2], o[3]);
                const f32x4 lo = (f32x4){o[0] - bflo(hi.x), o[1] - bfhi(hi.x), o[2] - bflo(hi.y), o[3] - bfhi(hi.y)};
                *(u32x2*)(H + (size_t)t * 4096 + 4 * F.lane + 256 * j) = hi; store4_bf16(H + (size_t)t * 4096 + 2048 + 4 * F.lane + 256 * j, lo); }
            else store4_bf16(H + (size_t)t * 2048 + 4 * F.lane + 256 * j, o); }
    }
}

__device__ __forceinline__ void shift8(const bf16_t* cur, const bf16_t* prv, bool has_prev, const float* mu, float (&o)[8]) {
    float c[8], p[8]; load8f(cur, c);
    if (has_prev) load8f(prv, p); else {
#pragma unroll
        for (int i = 0; i < 8; ++i) p[i] = 0.f; }
#pragma unroll
    for (int i = 0; i < 8; ++i) o[i] = c[i] + (p[i] - c[i]) * mu[i];
}
__device__ __forceinline__ void phase_prep(Frame& F, const Args& a, int l) {
    const bf16_t* PROJ = (const bf16_t*)(F.ws + WS_PROJ); bf16_t* RK = (bf16_t*)(F.ws + WS_RK); bf16_t* VS = (bf16_t*)(F.ws + WS_VS) + (size_t)l * T * 1024;
    bf16_t* LORAIN = (bf16_t*)(F.ws + WS_LORAIN); bf16_t* KPE = (bf16_t*)(F.ws + WS_KPE);
    float* rstdq = (float*)(F.ws + WS_RSTDQ); float* rstdkv = (float*)(F.ws + WS_RSTDKV);
    const float* cosb = (const float*)(F.ws + WS_COS); const float* sinb = (const float*)(F.ws + WS_SIN);
    const float* mu = (const float*)ARGP(4) + (size_t)l * RWKV_COLS; const int lane = F.lane, l31 = lane & 31, l15 = lane & 15;
    const bool isW = lane < 12, isA = lane >= 32 && lane < 44;
    const int offX = isW ? PC_WD + 8 * lane : isA ? PC_AD + 8 * (lane - 32) : PC_WD, muX = isW ? 3072 + 8 * lane : isA ? 3168 + 8 * (lane - 32) : 3072;
    const float lowf = lane < 32 ? 1.f : 0.f;
    f32x4 mm[6][2];
#pragma unroll
    for (int j = 0; j < 6; ++j) { mm[j][0] = *(const f32x4*)(mu + j * 512 + lane * 8); mm[j][1] = *(const f32x4*)(mu + j * 512 + lane * 8 + 4); }
    for (int t = F.gw; t < T; t += F.NGW) {
        const bool hp = (t % SEQ) != 0; const float hpf = hp ? 1.f : 0.f;
        const bf16_t* prow = PROJ + (size_t)t * NPROJ; const bf16_t* pprev = hp ? prow - NPROJ : prow;
        u32x4 cur[6], prv[6];
#pragma unroll
        for (int j = 0; j < 6; ++j) { cur[j] = *(const u32x4*)(prow + PC_RR + j * 512 + lane * 8); prv[j] = *(const u32x4*)(pprev + PC_RR + j * 512 + lane * 8); }
        const u32x4 xc = *(const u32x4*)(prow + offX), xp = *(const u32x4*)(pprev + offX), gc = *(const u32x4*)(prow + PC_GD + 8 * l31), gp = *(const u32x4*)(pprev + PC_GD + 8 * l31);
        const u32x4 q0 = *(const u32x4*)(prow + PC_CQ + 8 * lane), q1 = *(const u32x4*)(prow + PC_CQ + 512 + 8 * l31), kv = *(const u32x4*)(prow + PC_CKV + 8 * l31);
        const f32x4 mx0 = *(const f32x4*)(mu + muX), mx1 = *(const f32x4*)(mu + muX + 4), mg0 = *(const f32x4*)(mu + 3264 + 8 * l31), mg1 = *(const f32x4*)(mu + 3264 + 8 * l31 + 4);
        const unsigned short kr1 = prow[PC_KPE + l15], kr2 = prow[PC_KPE + 16 + l15]; const float kcs = cosb[(size_t)t * 16 + l15], ksn = sinb[(size_t)t * 16 + l15];
        __builtin_amdgcn_sched_barrier(0);
        const float kx1 = bf2f(kr1), kx2 = bf2f(kr2);
#pragma unroll
        for (int j = 0; j < 6; ++j) { float c[8], pv[8], o[8]; unpack8(cur[j], c); unpack8(prv[j], pv);
#pragma unroll
            for (int i = 0; i < 8; ++i) o[i] = c[i] + (pv[i] * hpf - c[i]) * mm[j][i >> 2][i & 3];
            if (j < 4) store8f(RK + (size_t)t * 2048 + j * 512 + lane * 8, o); else store8f(VS + (size_t)t * 1024 + (j - 4) * 512 + lane * 8, o); }
        { float c[8], pv[8], o[8]; unpack8(xc, c); unpack8(xp, pv);
#pragma unroll
          for (int i = 0; i < 8; ++i) { const float m = i < 4 ? mx0[i & 3] : mx1[i & 3]; const float x = c[i] + (pv[i] * hpf - c[i]) * m;
              const float th = 1.0f - 2.0f * __builtin_amdgcn_rcpf(__expf(2.0f * x) + 1.0f); o[i] = isW ? th : isA ? x : 0.f; }
          store8f(LORAIN + (size_t)t * 768 + 8 * lane, o);
          unpack8(gc, c); unpack8(gp, pv);
#pragma unroll
          for (int i = 0; i < 8; ++i) { const float m = i < 4 ? mg0[i & 3] : mg1[i & 3]; o[i] = fast_sigmoid(c[i] + (pv[i] * hpf - c[i]) * m); }
          if (lane < 32) store8f(LORAIN + (size_t)t * 768 + 512 + 8 * lane, o); }
        { float a0[8], a1[8], a2[8], s1 = 0.f, s1b = 0.f, s2 = 0.f; unpack8(q0, a0); unpack8(q1, a1); unpack8(kv, a2);
#pragma unroll
          for (int i = 0; i < 8; ++i) { s1 += a0[i] * a0[i]; s1b += a1[i] * a1[i]; s2 += a2[i] * a2[i]; }
          s1 = wave_sum(s1 + s1b * lowf); s2 = wave_sum(s2 * lowf);
          if (lane == 0) { rstdq[t] = rsqrtf(s1 * (1.f / 768.f) + NORM_EPS); rstdkv[t] = rsqrtf(s2 * (1.f / 256.f) + NORM_EPS); } }
        if (lane < 16) { KPE[(size_t)t * 32 + lane] = (bf16_t)f2bf(kx1 * kcs - kx2 * ksn); KPE[(size_t)t * 32 + 16 + lane] = (bf16_t)f2bf(kx2 * kcs + kx1 * ksn); }
    }
}

__device__ __forceinline__ int crow(int r, int hi) { return (r & 3) + 8 * (r >> 2) + 4 * hi; }
__device__ __forceinline__ s16x4 vtr(const LAS unsigned char* p) { return __builtin_bit_cast(s16x4, __builtin_amdgcn_ds_read_tr16_b64_v4i16((LAS v4i16_t*)p)); }
#define MFMA32(a, b, c) __builtin_amdgcn_mfma_f32_32x32x16_bf16((a), (b), (c), 0, 0, 0)

__device__ __forceinline__ void pv_tile(f32x16 (&o)[2], const LAS unsigned char* Vbuf, const u32x4 (&pw)[4], int lane) {
    const int hi = lane >> 5; const LAS unsigned char* vb = Vbuf + ((lane >> 4) & 1) * 32 + (lane & 3) * 8 + (4 * hi + ((lane & 15) >> 2)) * 64;
#pragma unroll
    for (int d0 = 0; d0 < 2; ++d0)
#pragma unroll
        for (int s = 0; s < 4; ++s) { const s16x4 lo = vtr(vb + d0 * 4096 + s * 1024), hh = vtr(vb + d0 * 4096 + s * 1024 + 512);
            const bf16x8 vf = (bf16x8){lo[0], lo[1], lo[2], lo[3], hh[0], hh[1], hh[2], hh[3]};
            o[d0] = MFMA32(vf, __builtin_bit_cast(bf16x8, pw[s]), o[d0]); }
}
__device__ __forceinline__ void pack_p(u32x4 (&pw)[4], const f32x16& p0, const f32x16& p1) {
    pw[0] = (u32x4){cvt_pk_bf16(p0[0], p0[1]), cvt_pk_bf16(p0[2], p0[3]), cvt_pk_bf16(p0[4], p0[5]), cvt_pk_bf16(p0[6], p0[7])};
    pw[1] = (u32x4){cvt_pk_bf16(p0[8], p0[9]), cvt_pk_bf16(p0[10], p0[11]), cvt_pk_bf16(p0[12], p0[13]), cvt_pk_bf16(p0[14], p0[15])};
    pw[2] = (u32x4){cvt_pk_bf16(p1[0], p1[1]), cvt_pk_bf16(p1[2], p1[3]), cvt_pk_bf16(p1[4], p1[5]), cvt_pk_bf16(p1[6], p1[7])};
    pw[3] = (u32x4){cvt_pk_bf16(p1[8], p1[9]), cvt_pk_bf16(p1[10], p1[11]), cvt_pk_bf16(p1[12], p1[13]), cvt_pk_bf16(p1[14], p1[15])};
}
__device__ __forceinline__ void store_o(bf16_t* Orow, const f32x16 (&o)[2], float sc, int hi) {
#pragma unroll
    for (int d0 = 0; d0 < 2; ++d0)
#pragma unroll
        for (int rg = 0; rg < 4; ++rg) { const f32x4 v = (f32x4){o[d0][4 * rg] * sc, o[d0][4 * rg + 1] * sc, o[d0][4 * rg + 2] * sc, o[d0][4 * rg + 3] * sc};
            store4_bf16(Orow + 32 * d0 + 8 * rg + 4 * hi, v); }
}
__device__ __forceinline__ float other_half(float x, int hi) {
    auto rr = __builtin_amdgcn_permlane32_swap(__float_as_uint(x), __float_as_uint(x), false, false);
    return __uint_as_float(hi ? rr[0] : rr[1]);
}

constexpr float SB_DEAD_THR = 1e-30f;
__device__ __forceinline__ void glds16(const void* gsrc, unsigned lds_dst) { unsigned keep;
    asm volatile("s_mov_b32 %0, m0\n\ts_mov_b32 m0, %2\n\ts_nop 0\n\tglobal_load_lds_dwordx4 %1, off\n\ts_mov_b32 m0, %0" : "=&s"(keep) : "v"(gsrc), "s"(lds_dst) : "memory"); }
#define ATT_WAIT_BAR(N) asm volatile("s_waitcnt vmcnt(" #N ") lgkmcnt(0)\n\ts_barrier" ::: "memory")
__device__ __forceinline__ void attn_sb_unit(Frame& F, int b, int h, int qb, const bf16_t* PROJ, bf16_t* O) {
    const int lane = F.lane, wid = F.wave, r32 = lane & 31, hi = lane >> 5;
    const int q0 = qb * 256, qw0 = q0 + wid * 32; const size_t rowbase = (size_t)b * SEQ;
    const bf16_t* Qp = PROJ + (rowbase + qw0 + r32) * NPROJ + PC_SBQ + h * 64;
    bf16x8 qf[4];
#pragma unroll
    for (int d0 = 0; d0 < 4; ++d0) qf[d0] = *(const bf16x8*)(Qp + d0 * 16 + hi * 8);
    const bf16_t* Kg = PROJ + rowbase * NPROJ + PC_SBK + h * 64 + (size_t)lane * NPROJ + wid * 8;
    const bf16_t* Vg = PROJ + rowbase * NPROJ + PC_SBV + h * 64 + (size_t)(16 * (wid & 3) + (lane >> 2)) * NPROJ + (wid >> 2) * 32 + (lane & 3) * 8;
    constexpr int SLOT = 16384; const unsigned lds0 = (unsigned)(uintptr_t)F.lds;
    const int NT = 4 * qb + 4;
#define SB_ISSUE(itx) do { const int kt_ = NT - 1 - (itx); const unsigned so_ = (unsigned)__builtin_amdgcn_readfirstlane((int)(lds0 + ((itx) % 3) * SLOT + wid * 1024)); \
        glds16(Kg + (size_t)kt_ * 64 * NPROJ, so_); glds16(Vg + (size_t)kt_ * 64 * NPROJ, so_ + 8192); } while (0)
    SB_ISSUE(0); SB_ISSUE(1);
    f32x16 o[2]; o[0] = (f32x16){}; o[1] = (f32x16){}; float carry = 1.0f;
    const int tq = qw0 + r32;
    for (int it = 0; it < NT; ++it) {
        if (it + 1 < NT) ATT_WAIT_BAR(2); else ATT_WAIT_BAR(0);
        if (it > 0) { unsigned alld = 1u;
#pragma unroll
            for (int q = 0; q < 8; ++q) alld &= F.MISC[16 + ((it - 1) & 1) * 8 + q];
            if (alld) break; }
        if (it + 2 < NT) SB_ISSUE(it + 2);
        const int kt = NT - 1 - it, cur = (it % 3) * SLOT, k0 = kt * 64;
        if (k0 < qw0 + 31) {
            f32x16 p0, p1; const LAS unsigned char* kb = F.lds + cur + hi * 1024 + r32 * 16;
#pragma unroll
            for (int d0 = 0; d0 < 4; ++d0) { const bf16x8 b0 = *(const LAS bf16x8*)(kb + d0 * 2048), b1 = *(const LAS bf16x8*)(kb + d0 * 2048 + 512);
                if (d0 == 0) { p0 = MFMA32(b0, qf[0], (f32x16){}); p1 = MFMA32(b1, qf[0], (f32x16){}); } else { p0 = MFMA32(b0, qf[d0], p0); p1 = MFMA32(b1, qf[d0], p1); } }
#pragma unroll
            for (int r = 0; r < 16; ++r) { p0[r] = __builtin_amdgcn_rcpf(1.0f + __builtin_amdgcn_exp2f(p0[r])); p1[r] = __builtin_amdgcn_rcpf(1.0f + __builtin_amdgcn_exp2f(p1[r])); }
            if (k0 + 63 >= qw0) {
#pragma unroll
                for (int r = 0; r < 16; ++r) { const int key = k0 + crow(r, hi); if (key >= tq) p0[r] = 1.0f; if (key + 32 >= tq) p1[r] = 1.0f; } }
            float tot[8], toto[8];
#pragma unroll
            for (int g = 0; g < 4; ++g) { tot[g] = (p0[4 * g] * p0[4 * g + 1]) * (p0[4 * g + 2] * p0[4 * g + 3]); tot[4 + g] = (p1[4 * g] * p1[4 * g + 1]) * (p1[4 * g + 2] * p1[4 * g + 3]); }
#pragma unroll
            for (int g = 0; g < 8; ++g) toto[g] = other_half(tot[g], hi);
            float A = carry;
#pragma unroll
            for (int g = 7; g >= 0; --g) {
                const float ag = hi ? A : A * toto[g]; A *= tot[g] * toto[g];
                float e = ag;
                if (g >= 4) { const int r = 4 * (g - 4);
                    const float k3 = p1[r + 3], k2 = p1[r + 2], k1 = p1[r + 1], k0_ = p1[r];
                    p1[r + 3] = (1.0f - k3) * e; e *= k3; p1[r + 2] = (1.0f - k2) * e; e *= k2; p1[r + 1] = (1.0f - k1) * e; e *= k1; p1[r] = (1.0f - k0_) * e;
                } else { const int r = 4 * g;
                    const float k3 = p0[r + 3], k2 = p0[r + 2], k1 = p0[r + 1], k0_ = p0[r];
                    p0[r + 3] = (1.0f - k3) * e; e *= k3; p0[r + 2] = (1.0f - k2) * e; e *= k2; p0[r + 1] = (1.0f - k1) * e; e *= k1; p0[r] = (1.0f - k0_) * e; }
            }
            carry = A;
            u32x4 pw[4]; pack_p(pw, p0, p1);
            pv_tile(o, F.lds + cur + 8192, pw, lane);
        }
        { const unsigned dflag = __all(carry < SB_DEAD_THR) ? 1u : 0u; if (lane == 0) F.MISC[16 + (it & 1) * 8 + wid] = dflag; }
    }
#undef SB_ISSUE
    ATT_WAIT_BAR(0);
    store_o(O + (rowbase + qw0 + r32) * 1024 + h * 64, o, 1.0f, hi);
}

__device__ __forceinline__ float max3f(float a, float b, float c) { return __builtin_fmaxf(__builtin_fmaxf(a, b), c); }
__device__ __forceinline__ float max2f(float a, float b) { float r; asm("v_max_f32_e32 %0, %1, %2" : "=v"(r) : "v"(a), "v"(b)); return r; }
__device__ __forceinline__ void attn_mla_unit(Frame& F, int b, int h, int qb, const bf16_t* Q, const bf16_t* Kt, const bf16_t* Kpe, const bf16_t* Vt, bf16_t* O) {
    const int lane = F.lane, wid = F.wave, r32 = lane & 31, hi = lane >> 5;
    const int q0 = qb * 256, qw0 = q0 + wid * 32; const size_t rowbase = (size_t)b * SEQ;
    const bf16_t* Qp = Q + (rowbase + qw0 + r32) * 1536 + h * 96;
    bf16x8 qf[6];
#pragma unroll
    for (int d0 = 0; d0 < 6; ++d0) qf[d0] = *(const bf16x8*)(Qp + d0 * 16 + hi * 8);
    const bf16_t* Kg = Kt + rowbase * 1024 + h * 64 + (size_t)lane * 1024 + wid * 8;
    const bf16_t* Kp = Kpe + rowbase * 32 + (size_t)lane * 32 + (wid & 3) * 8;
    const bf16_t* Vg = Vt + rowbase * 1024 + h * 64 + (size_t)(16 * (wid & 3) + (lane >> 2)) * 1024 + (wid >> 2) * 32 + (lane & 3) * 8;
    const bool two = wid < 4; constexpr int SLOT = 20480; const unsigned lds0 = (unsigned)(uintptr_t)F.lds;
    const int NT = 4 * qb + 4;
#define MLA_ISSUE(itx) do { const int kt_ = (itx); const unsigned so_ = (unsigned)__builtin_amdgcn_readfirstlane((int)(lds0 + ((itx) & 3) * SLOT + wid * 1024)); \
        glds16(Kg + (size_t)kt_ * 64 * 1024, so_); if (two) glds16(Kp + (size_t)kt_ * 64 * 32, so_ + 8192); glds16(Vg + (size_t)kt_ * 64 * 1024, so_ + 12288); } while (0)
#define MLA_QK(P0, P1, kt_) do { const int k0_ = (kt_) * 64; const LAS unsigned char* kb = F.lds + ((kt_) & 3) * SLOT + hi * 1024 + r32 * 16; \
        _Pragma("unroll") for (int d0 = 0; d0 < 6; ++d0) { const bf16x8 b0 = *(const LAS bf16x8*)(kb + d0 * 2048), b1 = *(const LAS bf16x8*)(kb + d0 * 2048 + 512); \
            if (d0 == 0) { P0 = MFMA32(b0, qf[0], negm); P1 = MFMA32(b1, qf[0], negm); } else { P0 = MFMA32(b0, qf[d0], P0); P1 = MFMA32(b1, qf[d0], P1); } } \
        if (k0_ + 63 > qw0) { _Pragma("unroll") for (int r = 0; r < 16; ++r) { const int key = k0_ + crow(r, hi); if (key > tq) P0[r] = -INFINITY; if (key + 32 > tq) P1[r] = -INFINITY; } } } while (0)
#define MLA_SM_PV(P0, P1, N0, N1, kt_) do { \
        float ma = max3f(P0[0], P0[1], P1[0]), mb = max3f(P0[2], P0[3], P1[1]); ma = max3f(ma, P1[2], P1[3]); \
        _Pragma("unroll") for (int r = 4; r < 16; r += 4) { ma = max3f(ma, P0[r], P0[r + 1]); mb = max3f(mb, P0[r + 2], P0[r + 3]); ma = max3f(ma, P1[r], P1[r + 1]); mb = max3f(mb, P1[r + 2], P1[r + 3]); } \
        float mx = max2f(ma, mb); mx = max2f(mx, other_half(mx, hi)); \
        if (first || __any(mx > 8.0f)) { const float dl = first ? mx : fmaxf(mx, 0.f); const float f = first ? 1.0f : __builtin_amdgcn_exp2f(-dl); first = false; mref += dl; lrun *= f; \
            _Pragma("unroll") for (int r = 0; r < 16; ++r) { P0[r] -= dl; P1[r] -= dl; N0[r] -= dl; N1[r] -= dl; o[0][r] *= f; o[1][r] *= f; negm[r] = -mref; } } \
        float ls0 = 0.f, ls1 = 0.f, e0_[16], e1_[16];     \
        _Pragma("unroll") for (int r = 0; r < 16; ++r) { e0_[r] = __builtin_amdgcn_exp2f(P0[r]); e1_[r] = __builtin_amdgcn_exp2f(P1[r]); ls0 += e0_[r]; ls1 += e1_[r]; } \
        lrun += ls0 + ls1; u32x4 pw[4]; \
        pw[0] = (u32x4){cvt_pk_bf16(e0_[0], e0_[1]), cvt_pk_bf16(e0_[2], e0_[3]), cvt_pk_bf16(e0_[4], e0_[5]), cvt_pk_bf16(e0_[6], e0_[7])}; \
        pw[1] = (u32x4){cvt_pk_bf16(e0_[8], e0_[9]), cvt_pk_bf16(e0_[10], e0_[11]), cvt_pk_bf16(e0_[12], e0_[13]), cvt_pk_bf16(e0_[14], e0_[15])}; \
        pw[2] = (u32x4){cvt_pk_bf16(e1_[0], e1_[1]), cvt_pk_bf16(e1_[2], e1_[3]), cvt_pk_bf16(e1_[4], e1_[5]), cvt_pk_bf16(e1_[6], e1_[7])}; \
        pw[3] = (u32x4){cvt_pk_bf16(e1_[8], e1_[9]), cvt_pk_bf16(e1_[10], e1_[11]), cvt_pk_bf16(e1_[12], e1_[13]), cvt_pk_bf16(e1_[14], e1_[15])}; \
        pv_tile(o, F.lds + ((kt_) & 3) * SLOT + 12288, pw, lane); } while (0)
#define MLA_STEP(t_, PA0, PA1, PB0, PB1) do { if ((t_) + 2 < NT) { if (two) ATT_WAIT_BAR(3); else ATT_WAIT_BAR(2); } else ATT_WAIT_BAR(0); \
        if ((t_) + 3 < NT) MLA_ISSUE((t_) + 3); \
        if ((t_) + 1 < nact) { MLA_QK(PB0, PB1, (t_) + 1); } \
        if ((t_) < nact) { MLA_SM_PV(PA0, PA1, PB0, PB1, (t_)); } } while (0)
    MLA_ISSUE(0); MLA_ISSUE(1); MLA_ISSUE(2);
    f32x16 o[2]; o[0] = (f32x16){}; o[1] = (f32x16){}; float mref = 0.f, lrun = 0.f; f32x16 negm = (f32x16){};
    const int tq = qw0 + r32; bool first = true; f32x16 pa0, pa1, pb0 = (f32x16){}, pb1 = (f32x16){};
    const int nact = (qw0 + 31) / 64 + 1;
    if (two) ATT_WAIT_BAR(6); else ATT_WAIT_BAR(4);
    MLA_QK(pa0, pa1, 0);
    for (int kt = 0; kt < NT; kt += 2) { MLA_STEP(kt, pa0, pa1, pb0, pb1); MLA_STEP(kt + 1, pb0, pb1, pa0, pa1); }
#undef MLA_ISSUE
#undef MLA_QK
#undef MLA_SM_PV
#undef MLA_STEP
    ATT_WAIT_BAR(0);
    const float ltot = lrun + other_half(lrun, hi);
    store_o(O + (rowbase + qw0 + r32) * 1024 + h * 64, o, __builtin_amdgcn_rcpf(ltot), hi);
}

namespace rw {
constexpr int RM = 136;
constexpr int L_AT = 0, L_RT = 8704, L_BT = 17408, L_KT = 26112, L_Q = 34816, L_PK0 = 43520, L_PK1 = 52224, L_T = 60928;
constexpr int L_N = L_AT, L_M = L_BT, L_P = L_KT;
constexpr int L_ATV = 69632, L_VV = 77824, L_BHV = 86016, L_KHV = 94208;
constexpr int L_LW = 102400, L_GT = 118784, L_WC = 120832;
static_assert(L_WC + 256 <= RING_BYTES, "rwkv chunk LDS map");
constexpr size_t CH_G = 0, CH_H = 8192, CH_RF = 24576, CH_YF = 32768, CH_ZF = 40960, CH_BYTES = 49152;
#define RW_BAR() asm volatile("s_waitcnt vmcnt(0) lgkmcnt(0)\n\ts_barrier" ::: "memory")

__device__ __forceinline__ bf16x8 frag_rm(const LAS unsigned char* img, int row, int s4, int hi) {
    const LAS unsigned char* p = img + row * RM + s4 * 32 + hi * 8;
    const u32x2 a = *(const LAS u32x2*)p, b = *(const LAS u32x2*)(p + 16);
    return __builtin_bit_cast(bf16x8, (u32x4){a.x, a.y, b.x, b.y});
}
__device__ __forceinline__ bf16x8 frag_vi(const LAS unsigned char* img, int cb, int s4, int lane) {
    const int hi = lane >> 5; const LAS unsigned char* vb = img + ((lane >> 4) & 1) * 32 + (lane & 3) * 8 + (4 * hi + ((lane & 15) >> 2)) * 64 + cb * 4096 + s4 * 1024;
    const s16x4 lo = vtr(vb), hh = vtr(vb + 512); return (bf16x8){lo[0], lo[1], lo[2], lo[3], hh[0], hh[1], hh[2], hh[3]};
}
template <int HALF> __device__ __forceinline__ bf16x8 frag_acc(const f32x16& t) {
    const u32x4 w = (u32x4){cvt_pk_bf16(t[8 * HALF + 0], t[8 * HALF + 1]), cvt_pk_bf16(t[8 * HALF + 2], t[8 * HALF + 3]), cvt_pk_bf16(t[8 * HALF + 4], t[8 * HALF + 5]), cvt_pk_bf16(t[8 * HALF + 6], t[8 * HALF + 7])};
    return __builtin_bit_cast(bf16x8, w);
}
__device__ __forceinline__ void frags_of(bf16x8 (&f)[4], const f32x16 (&X)[2]) { f[0] = frag_acc<0>(X[0]); f[1] = frag_acc<1>(X[0]); f[2] = frag_acc<0>(X[1]); f[3] = frag_acc<1>(X[1]); }
__device__ __forceinline__ void tile_to_rm(LAS unsigned char* img, const f32x16& t, int mb, int nb, int r32, int hi) {
#pragma unroll
    for (int r = 0; r < 16; r += 2) { const unsigned w = cvt_pk_bf16(t[r], t[r + 1]);
        LAS unsigned char* q = img + (32 * mb + crow(r, hi)) * RM + (32 * nb + r32) * 2;
        *(LAS bf16_t*)q = (bf16_t)w; *(LAS bf16_t*)(q + RM) = (bf16_t)(w >> 16); }
}

struct ChunkIn { u32x4 r, k, v, vf, gt; f32x4 a0, a1, l0, l1; };
struct ChunkPar { f32x4 p0[2], p1[2], p2[2]; };
__device__ __forceinline__ void chunk_par(Frame& F, int l, int cidx, ChunkPar& cp) {
    const int h = (cidx >> 6) & 15, gch = h * 64 + (F.tid & 7) * 8;
    { const f32x4* p = (const f32x4*)((const float*)ARGP(10) + l * 1024 + gch); cp.p0[0] = p[0]; cp.p0[1] = p[1]; }
    { const f32x4* p = (const f32x4*)((const float*)ARGP(11) + l * 1024 + gch); cp.p1[0] = p[0]; cp.p1[1] = p[1]; }
    { const f32x4* p = (const f32x4*)((const float*)ARGP(12) + l * 1024 + gch); cp.p2[0] = p[0]; cp.p2[1] = p[1]; }
}
__device__ __forceinline__ void chunk_fetch(Frame& F, int l, int cidx, ChunkIn& in) {
    const int tid = F.tid, bh = cidx >> 6, c = cidx & 63, b = bh >> 4, h = bh & 15, t = tid >> 3, cg = tid & 7, gch = h * 64 + cg * 8; const size_t row = (size_t)b * SEQ + c * 64 + t;
    const bf16_t* RK = (const bf16_t*)(F.ws + WS_RK); const bf16_t* VS = (const bf16_t*)(F.ws + WS_VS) + (size_t)l * T * 1024;
    in.r = *(const u32x4*)(RK + row * 2048 + gch); in.k = *(const u32x4*)(RK + row * 2048 + 1024 + gch); in.v = *(const u32x4*)(VS + row * 1024 + gch);
    if (l > 0) { in.vf = *(const u32x4*)((const bf16_t*)(F.ws + WS_VS) + row * 1024 + gch); in.gt = *(const u32x4*)((const bf16_t*)(F.ws + WS_VGATE) + row * 1024 + gch); }
    else { in.vf = in.v; in.gt = in.v; }
    const f32x4* pa = (const f32x4*)((const float*)(F.ws + WS_AIC) + row * 1024 + gch); in.a0 = pa[0]; in.a1 = pa[1];
    const f32x4* pl = (const f32x4*)((const float*)(F.ws + WS_LOGDEC) + row * 1024 + gch); in.l0 = pl[0]; in.l1 = pl[1];
}
__device__ __forceinline__ void chunk_unit(Frame& F, int l, int cidx, const ChunkIn& in, const ChunkPar& cp) {
    const int tid = F.tid, lane = F.lane, w = F.wave, r32 = lane & 31, hi = lane >> 5;
    const int bh = cidx >> 6, c = cidx & 63, b = bh >> 4, h = bh & 15;
    LAS unsigned char* L = F.lds;
    unsigned char* gs = F.ws + WS_RWS + (size_t)cidx * CH_BYTES;
    {
        const int t = tid >> 3, cg = tid & 7, ch0 = cg * 8, gch = h * 64 + ch0; const size_t row = (size_t)b * SEQ + c * 64 + t;
        float r[8], k[8], v[8], aa[8], ld[8], kc[8];
        unpack8(in.r, r); unpack8(in.k, k); unpack8(in.v, v);
        if (l > 0) { float vf[8], gt[8]; unpack8(in.vf, vf); unpack8(in.gt, gt);
#pragma unroll
            for (int i = 0; i < 8; ++i) v[i] = v[i] + (vf[i] - v[i]) * gt[i]; }
#pragma unroll
        for (int i = 0; i < 4; ++i) { aa[i] = in.a0[i]; aa[4 + i] = in.a1[i]; ld[i] = in.l0[i]; ld[4 + i] = in.l1[i]; }
        float kk[8], kmod[8]; float n2 = 0.f, bc = 0.f;
        { const f32x4 c0 = cp.p0[0], c1 = cp.p0[1];
#pragma unroll
          for (int i = 0; i < 4; ++i) { kc[i] = c0[i]; kc[4 + i] = c1[i]; } }
#pragma unroll
        for (int i = 0; i < 8; ++i) { kk[i] = k[i] * kc[i]; n2 += kk[i] * kk[i]; }
        { const f32x4 c0 = cp.p1[0], c1 = cp.p1[1];
#pragma unroll
          for (int i = 0; i < 4; ++i) { kc[i] = c0[i]; kc[4 + i] = c1[i]; } }
#pragma unroll
        for (int i = 0; i < 8; ++i) kmod[i] = k[i] * (1.0f + (aa[i] - 1.0f) * kc[i]);
        { const f32x4 c0 = cp.p2[0], c1 = cp.p2[1];
#pragma unroll
          for (int i = 0; i < 4; ++i) { kc[i] = c0[i]; kc[4 + i] = c1[i]; } }
#pragma unroll
        for (int i = 0; i < 8; ++i) bc += r[i] * kmod[i] * kc[i];
        n2 = sum8(n2); bc = sum8(bc);
        const float inv = 1.0f / fmaxf(sqrtf(n2), 1e-12f);
        if (cg == 0) ((float*)(F.ws + WS_BC))[row * 16 + h] = bc;
        store8f((bf16_t*)(F.ws + WS_VMIX) + row * 1024 + gch, v);
        LAS float* LW = (LAS float*)(L + L_LW); LAS float* GT = (LAS float*)(L + L_GT);
#pragma unroll
        for (int i = 0; i < 8; ++i) LW[t * 64 + ch0 + i] = ld[i];
        RW_BAR();
        { const int ch = tid & 63, tq = tid >> 6; float run = 0.f;
#pragma unroll
          for (int i = 0; i < 8; ++i) { run += LW[(8 * tq + i) * 64 + ch]; LW[(8 * tq + i) * 64 + ch] = run; }
          GT[tq * 64 + ch] = run; }
        RW_BAR();
        float lc[8], tot[8];
#pragma unroll
        for (int i = 0; i < 8; ++i) { lc[i] = LW[t * 64 + ch0 + i]; tot[i] = 0.f; }
#pragma unroll
        for (int q = 0; q < 8; ++q) {
#pragma unroll
            for (int i = 0; i < 8; ++i) { const float g = GT[q * 64 + ch0 + i]; tot[i] += g; if (q < (t >> 3)) lc[i] += g; } }
        float At[8], Rt[8], Bt[8], Kt[8], Bh[8], Kh[8];
#pragma unroll
        for (int i = 0; i < 8; ++i) { const float wi = __expf(lc[i]), we = __expf(lc[i] - ld[i]), wn = __expf(-lc[i]), wr = __expf(tot[i] - lc[i]);
            const float ap = -kk[i] * inv, bp = kk[i] * inv * aa[i];
            At[i] = ap * we; Rt[i] = r[i] * wi; Bt[i] = bp * wn; Kt[i] = kmod[i] * wn; Bh[i] = bp * wr; Kh[i] = kmod[i] * wr; }
        const int rmo = t * RM + cg * 16, vio = ((cg >> 2) * 4 + (t >> 4)) * 1024 + (t & 15) * 64 + (cg & 3) * 16;
        { u32x4 x;
          x = (u32x4){pk2(At[0], At[1]), pk2(At[2], At[3]), pk2(At[4], At[5]), pk2(At[6], At[7])}; *(LAS u32x2*)(L + L_AT + rmo) = (u32x2){x.x, x.y}; *(LAS u32x2*)(L + L_AT + rmo + 8) = (u32x2){x.z, x.w}; *(LAS u32x4*)(L + L_ATV + vio) = x;
          x = (u32x4){pk2(Rt[0], Rt[1]), pk2(Rt[2], Rt[3]), pk2(Rt[4], Rt[5]), pk2(Rt[6], Rt[7])}; *(LAS u32x2*)(L + L_RT + rmo) = (u32x2){x.x, x.y}; *(LAS u32x2*)(L + L_RT + rmo + 8) = (u32x2){x.z, x.w};
          x = (u32x4){pk2(Bt[0], Bt[1]), pk2(Bt[2], Bt[3]), pk2(Bt[4], Bt[5]), pk2(Bt[6], Bt[7])}; *(LAS u32x2*)(L + L_BT + rmo) = (u32x2){x.x, x.y}; *(LAS u32x2*)(L + L_BT + rmo + 8) = (u32x2){x.z, x.w};
          x = (u32x4){pk2(Kt[0], Kt[1]), pk2(Kt[2], Kt[3]), pk2(Kt[4], Kt[5]), pk2(Kt[6], Kt[7])}; *(LAS u32x2*)(L + L_KT + rmo) = (u32x2){x.x, x.y}; *(LAS u32x2*)(L + L_KT + rmo + 8) = (u32x2){x.z, x.w};
          x = (u32x4){pk2(v[0], v[1]), pk2(v[2], v[3]), pk2(v[4], v[5]), pk2(v[6], v[7])}; *(LAS u32x4*)(L + L_VV + vio) = x;
          x = (u32x4){pk2(Bh[0], Bh[1]), pk2(Bh[2], Bh[3]), pk2(Bh[4], Bh[5]), pk2(Bh[6], Bh[7])}; *(LAS u32x4*)(L + L_BHV + vio) = x;
          x = (u32x4){pk2(Kh[0], Kh[1]), pk2(Kh[2], Kh[3]), pk2(Kh[4], Kh[5]), pk2(Kh[6], Kh[7])}; *(LAS u32x4*)(L + L_KHV + vio) = x; }
        if (t == 0) { LAS float* WC = (LAS float*)(L + L_WC);
#pragma unroll
            for (int i = 0; i < 8; ++i) WC[ch0 + i] = __expf(tot[i]); }
        RW_BAR();
    }
#ifndef RWDBG
#define RWDBG 9
#endif
    if (RWDBG < 1) return;
    __builtin_amdgcn_sched_barrier(0);
    f32x16 X0[2];
    { const int mat = w >> 1, nb = w & 1; const LAS unsigned char* Ai = L + ((mat < 2) ? L_AT : L_RT); const LAS unsigned char* Bi = L + ((mat & 1) ? L_KT : L_BT);
      X0[0] = (f32x16){}; X0[1] = (f32x16){};
#pragma unroll
      for (int s4 = 0; s4 < 4; ++s4) { const bf16x8 bf = frag_rm(Bi, 32 * nb + r32, s4, hi);
#pragma unroll
          for (int mb = 0; mb < 2; ++mb) X0[mb] = MFMA32(frag_rm(Ai, 32 * mb + r32, s4, hi), bf, X0[mb]); __builtin_amdgcn_sched_barrier(0); }
      const int scol = 32 * nb + r32;
#pragma unroll
      for (int mb = 0; mb < 2; ++mb)
#pragma unroll
          for (int r = 0; r < 16; ++r) { const int trow = 32 * mb + crow(r, hi); const bool keep = (mat < 2) ? (scol < trow) : (scol <= trow); X0[mb][r] = keep ? X0[mb][r] : 0.f; }
      RW_BAR();
      LAS unsigned char* Oi = L + (mat == 0 ? L_N : mat == 1 ? L_M : mat == 2 ? L_P : L_Q);
      tile_to_rm(Oi, X0[0], 0, nb, r32, hi); tile_to_rm(Oi, X0[1], 1, nb, r32, hi);
      RW_BAR(); }
    if (RWDBG < 2) return;
    if (w < 2 && RWDBG != 3 && RWDBG != 4) {
        f32x16 P = (w == 0) ? X0[0] : X0[1]; f32x16 Tt = P;
#pragma unroll
        for (int r = 0; r < 16; ++r) if (crow(r, hi) == r32) Tt[r] += 1.0f;
        LAS unsigned char* own = L + (w == 0 ? L_PK0 : L_PK1);
#pragma unroll
        for (int k = 0; k < 5; ++k) {
            const LAS unsigned char* Ai = (k == 0) ? (const LAS unsigned char*)(L + L_N) : (const LAS unsigned char*)own;
            const bf16x8 bP0 = frag_acc<0>(P), bP1 = frag_acc<1>(P), bT0 = frag_acc<0>(Tt), bT1 = frag_acc<1>(Tt);
            const bf16x8 af0 = frag_rm(Ai, 32 * w + r32, 2 * w, hi), af1 = frag_rm(Ai, 32 * w + r32, 2 * w + 1, hi);
            if (k > 0) { Tt = MFMA32(af0, bT0, Tt); Tt = MFMA32(af1, bT1, Tt); }
            if (k < 4) { f32x16 nP = MFMA32(af0, bP0, (f32x16){}); nP = MFMA32(af1, bP1, nP); P = nP; tile_to_rm(own, P, w, w, r32, hi); }
            __builtin_amdgcn_sched_barrier(0);
        }
        f32x16 Y = (f32x16){};
        if (w == 0) { Y = MFMA32(frag_rm(L + L_N, 32 + r32, 0, hi), frag_acc<0>(Tt), Y); Y = MFMA32(frag_rm(L + L_N, 32 + r32, 1, hi), frag_acc<1>(Tt), Y); tile_to_rm(L + L_T, Tt, 0, 0, r32, hi); }
        else { tile_to_rm(L + L_T, Tt, 1, 1, r32, hi); const f32x16 zt = (f32x16){}; tile_to_rm(L + L_T, zt, 0, 1, r32, hi); }
        RW_BAR();
        if (w == 0) { f32x16 T21 = MFMA32(frag_rm(L + L_T, 32 + r32, 2, hi), frag_acc<0>(Y), (f32x16){}); T21 = MFMA32(frag_rm(L + L_T, 32 + r32, 3, hi), frag_acc<1>(Y), T21); tile_to_rm(L + L_T, T21, 1, 0, r32, hi); }
        RW_BAR();
        RW_BAR();
    } else if (w < 4 && RWDBG != 2 && RWDBG != 4) {
        const int ib = w - 2; f32x16 MV[2], Y[2], Hh[2];
        MV[0] = (f32x16){}; MV[1] = (f32x16){}; Y[0] = (f32x16){}; Y[1] = (f32x16){}; Hh[0] = (f32x16){}; Hh[1] = (f32x16){};
#pragma unroll
        for (int s4 = 0; s4 < 4; ++s4) { const bf16x8 vf = frag_vi(L + L_VV, ib, s4, lane);
#pragma unroll
            for (int q = 0; q < 2; ++q) { MV[q] = MFMA32(frag_rm(L + L_M, 32 * q + r32, s4, hi), vf, MV[q]);
                Y[q] = MFMA32(vf, frag_rm(L + L_Q, 32 * q + r32, s4, hi), Y[q]);
                Hh[q] = MFMA32(frag_vi(L + L_KHV, q, s4, lane), vf, Hh[q]); __builtin_amdgcn_sched_barrier(0); } }
        RW_BAR(); RW_BAR();
        f32x16 U0[2]; U0[0] = (f32x16){}; U0[1] = (f32x16){};
        { bf16x8 bm[4]; frags_of(bm, MV);
#pragma unroll
          for (int s4 = 0; s4 < 4; ++s4)
#pragma unroll
              for (int mb = 0; mb < 2; ++mb) { U0[mb] = MFMA32(frag_rm(L + L_T, 32 * mb + r32, s4, hi), bm[s4], U0[mb]); __builtin_amdgcn_sched_barrier(0); } }
        { bf16x8 bu[4]; frags_of(bu, U0);
#pragma unroll
          for (int s4 = 0; s4 < 4; ++s4)
#pragma unroll
              for (int q = 0; q < 2; ++q) { Y[q] = MFMA32(bu[s4], frag_rm(L + L_P, 32 * q + r32, s4, hi), Y[q]); Hh[q] = MFMA32(frag_vi(L + L_BHV, q, s4, lane), bu[s4], Hh[q]); __builtin_amdgcn_sched_barrier(0); } }
        unsigned* yf = (unsigned*)(gs + CH_YF); float* hf = (float*)(gs + CH_H);
#pragma unroll
        for (int tb = 0; tb < 2; ++tb)
#pragma unroll
            for (int q = 0; q < 8; ++q) { yf[((ib * 2 + tb) * 8 + q) * 64 + lane] = cvt_pk_bf16(Y[tb][2 * q], Y[tb][2 * q + 1]); if ((q & 3) == 3) __builtin_amdgcn_sched_barrier(0); }
#pragma unroll
        for (int jb = 0; jb < 2; ++jb)
#pragma unroll
            for (int r = 0; r < 16; ++r) { hf[((jb * 2 + ib) * 16 + r) * 64 + lane] = Hh[jb][r]; if ((r & 3) == 3) __builtin_amdgcn_sched_barrier(0); }
        RW_BAR();
    } else if (w < 6 && RWDBG != 2 && RWDBG != 3) {
        const int jc = w - 4;
        RW_BAR(); RW_BAR();
        f32x16 A2[2]; A2[0] = (f32x16){}; A2[1] = (f32x16){};
#pragma unroll
        for (int s4 = 0; s4 < 4; ++s4) { const bf16x8 af = frag_vi(L + L_ATV, jc, s4, lane);
#pragma unroll
            for (int mb = 0; mb < 2; ++mb) { A2[mb] = MFMA32(frag_rm(L + L_T, 32 * mb + r32, s4, hi), af, A2[mb]); __builtin_amdgcn_sched_barrier(0); } }
        bf16x8 ba[4]; frags_of(ba, A2);
        f32x16 R2[2], Gt[2]; R2[0] = (f32x16){}; R2[1] = (f32x16){}; Gt[0] = (f32x16){}; Gt[1] = (f32x16){};
#pragma unroll
        for (int s4 = 0; s4 < 4; ++s4)
#pragma unroll
            for (int q = 0; q < 2; ++q) { R2[q] = MFMA32(ba[s4], frag_rm(L + L_P, 32 * q + r32, s4, hi), R2[q]); Gt[q] = MFMA32(frag_vi(L + L_BHV, q, s4, lane), ba[s4], Gt[q]); __builtin_amdgcn_sched_barrier(0); }
#pragma unroll
        for (int tb = 0; tb < 2; ++tb)
#pragma unroll
            for (int rg = 0; rg < 4; ++rg) { const u32x2 x = *(const LAS u32x2*)(L + L_RT + (32 * tb + r32) * RM + (32 * jc + 8 * rg + 4 * hi) * 2);
                R2[tb][4 * rg] += bflo(x.x); R2[tb][4 * rg + 1] += bfhi(x.x); R2[tb][4 * rg + 2] += bflo(x.y); R2[tb][4 * rg + 3] += bfhi(x.y); }
        { const LAS float* WC = (const LAS float*)(L + L_WC);
          const float wc_ = WC[32 * jc + r32];
#pragma unroll
          for (int jb = 0; jb < 2; ++jb) { const float ad_ = (jb == jc) ? wc_ : 0.f;
#pragma unroll
              for (int r = 0; r < 16; ++r) if (crow(r, hi) == r32) Gt[jb][r] += ad_; } }
        u32x4* rf = (u32x4*)(gs + CH_RF);
#pragma unroll
        for (int tb = 0; tb < 2; ++tb) { rf[(tb * 4 + 2 * jc) * 64 + lane] = __builtin_bit_cast(u32x4, frag_acc<0>(R2[tb])); rf[(tb * 4 + 2 * jc + 1) * 64 + lane] = __builtin_bit_cast(u32x4, frag_acc<1>(R2[tb])); }
        bf16_t* gg = (bf16_t*)(gs + CH_G);
#pragma unroll
        for (int jb = 0; jb < 2; ++jb)
#pragma unroll
            for (int r = 0; r < 16; r += 2) { const unsigned w_ = cvt_pk_bf16(Gt[jb][r], Gt[jb][r + 1]); bf16_t* q_ = gg + (32 * jb + crow(r, hi)) * 64 + 32 * jc + r32;
                q_[0] = (bf16_t)w_; q_[64] = (bf16_t)(w_ >> 16); if ((r & 3) == 2) __builtin_amdgcn_sched_barrier(0); }
        RW_BAR();
    } else {
        RW_BAR(); RW_BAR(); RW_BAR();
    }
}

__device__ __forceinline__ void chain_wave(Frame& F, int bh) {
    const int lane = F.lane, r32 = lane & 31, hi = lane >> 5;
    f32x16 Z[2][2];
#pragma unroll
    for (int a = 0; a < 2; ++a)
#pragma unroll
        for (int bq = 0; bq < 2; ++bq) Z[a][bq] = (f32x16){};
    for (int c = 0; c < 64; ++c) {
        unsigned char* gs = F.ws + WS_RWS + (size_t)(bh * 64 + c) * CH_BYTES;
        bf16x8 zf[2][4];
#pragma unroll
        for (int ib = 0; ib < 2; ++ib) { zf[ib][0] = frag_acc<0>(Z[0][ib]); zf[ib][1] = frag_acc<1>(Z[0][ib]); zf[ib][2] = frag_acc<0>(Z[1][ib]); zf[ib][3] = frag_acc<1>(Z[1][ib]); }
        u32x4* zo = (u32x4*)(gs + CH_ZF);
#pragma unroll
        for (int ib = 0; ib < 2; ++ib)
#pragma unroll
            for (int s4 = 0; s4 < 4; ++s4) zo[(ib * 4 + s4) * 64 + lane] = __builtin_bit_cast(u32x4, zf[ib][s4]);
        if (c == 63) break;
        const float* hf = (const float*)(gs + CH_H); const bf16_t* gg = (const bf16_t*)(gs + CH_G);
        f32x16 Zn[2][2];
#pragma unroll
        for (int jb = 0; jb < 2; ++jb)
#pragma unroll
            for (int ib = 0; ib < 2; ++ib)
#pragma unroll
                for (int r = 0; r < 16; ++r) Zn[jb][ib][r] = hf[((jb * 2 + ib) * 16 + r) * 64 + lane];
#pragma unroll
        for (int jb = 0; jb < 2; ++jb)
#pragma unroll
            for (int s4 = 0; s4 < 4; ++s4) { const bf16_t* p = gg + (32 * jb + r32) * 64 + 16 * s4 + 4 * hi; const u32x2 a = *(const u32x2*)p, bb = *(const u32x2*)(p + 8);
                const bf16x8 gf = __builtin_bit_cast(bf16x8, (u32x4){a.x, a.y, bb.x, bb.y});
#pragma unroll
                for (int ib = 0; ib < 2; ++ib) Zn[jb][ib] = MFMA32(gf, zf[ib][s4], Zn[jb][ib]); }
#pragma unroll
        for (int jb = 0; jb < 2; ++jb)
#pragma unroll
            for (int ib = 0; ib < 2; ++ib) Z[jb][ib] = Zn[jb][ib];
    }
}

__device__ __forceinline__ void out_wave(Frame& F, int l, int cidx) {
    const int lane = F.lane, r32 = lane & 31, hi = lane >> 5; const int bh = cidx >> 6, c = cidx & 63, b = bh >> 4, h = bh & 15;
    const unsigned char* gs = F.ws + WS_RWS + (size_t)cidx * CH_BYTES;
    const unsigned* yf = (const unsigned*)(gs + CH_YF); const u32x4* zf = (const u32x4*)(gs + CH_ZF); const u32x4* rf = (const u32x4*)(gs + CH_RF);
    f32x16 Y[2][2];
#pragma unroll
    for (int ib = 0; ib < 2; ++ib)
#pragma unroll
        for (int tb = 0; tb < 2; ++tb)
#pragma unroll
            for (int q = 0; q < 8; ++q) { const unsigned x = yf[((ib * 2 + tb) * 8 + q) * 64 + lane]; Y[ib][tb][2 * q] = bflo(x); Y[ib][tb][2 * q + 1] = bfhi(x); }
#pragma unroll
    for (int s4 = 0; s4 < 4; ++s4) { bf16x8 za[2], rb[2];
#pragma unroll
        for (int q = 0; q < 2; ++q) { za[q] = __builtin_bit_cast(bf16x8, zf[(q * 4 + s4) * 64 + lane]); rb[q] = __builtin_bit_cast(bf16x8, rf[(q * 4 + s4) * 64 + lane]); }
#pragma unroll
        for (int ib = 0; ib < 2; ++ib)
#pragma unroll
            for (int tb = 0; tb < 2; ++tb) Y[ib][tb] = MFMA32(za[ib], rb[tb], Y[ib][tb]); }
    const float* lng = (const float*)ARGP(13) + l * 1024 + h * 64; const float* lnb = (const float*)ARGP(14) + l * 1024 + h * 64;
    const bf16_t* VM = (const bf16_t*)(F.ws + WS_VMIX); const bf16_t* GO = (const bf16_t*)(F.ws + WS_GOUT); const float* BC = (const float*)(F.ws + WS_BC);
    bf16_t* O = (bf16_t*)(F.ws + WS_OALL) + (size_t)1 * T * 1024;
#pragma unroll
    for (int tb = 0; tb < 2; ++tb) { const size_t row = (size_t)b * SEQ + c * 64 + 32 * tb + r32;
        float sm = 0.f;
#pragma unroll
        for (int ib = 0; ib < 2; ++ib)
#pragma unroll
            for (int r = 0; r < 16; ++r) sm += Y[ib][tb][r];
        sm += other_half(sm, hi); const float mean = sm * (1.f / 64.f);
        float sq = 0.f;
#pragma unroll
        for (int ib = 0; ib < 2; ++ib)
#pragma unroll
            for (int r = 0; r < 16; ++r) { const float d = Y[ib][tb][r] - mean; sq += d * d; }
        sq += other_half(sq, hi); const float rstd = rsqrtf(sq * (1.f / 64.f) + GN_EPS);
        const float bcv = BC[row * 16 + h];
        u32x2 vvr[2][4], gor[2][4];
#pragma unroll
        for (int ib = 0; ib < 2; ++ib)
#pragma unroll
            for (int rg = 0; rg < 4; ++rg) { const int i0 = 32 * ib + 8 * rg + 4 * hi; vvr[ib][rg] = *(const u32x2*)(VM + row * 1024 + h * 64 + i0); gor[ib][rg] = *(const u32x2*)(GO + row * 1024 + h * 64 + i0); }
#pragma unroll
        for (int ib = 0; ib < 2; ++ib) { f32x4 gln[4], bln[4];
#pragma unroll
            for (int rg = 0; rg < 4; ++rg) { const int i0 = 32 * ib + 8 * rg + 4 * hi; gln[rg] = *(const f32x4*)(lng + i0); bln[rg] = *(const f32x4*)(lnb + i0); }
#pragma unroll
            for (int rg = 0; rg < 4; ++rg) { const int i0 = 32 * ib + 8 * rg + 4 * hi;
                const f32x4 vv = (f32x4){bflo(vvr[ib][rg].x), bfhi(vvr[ib][rg].x), bflo(vvr[ib][rg].y), bfhi(vvr[ib][rg].y)}, go = (f32x4){bflo(gor[ib][rg].x), bfhi(gor[ib][rg].x), bflo(gor[ib][rg].y), bfhi(gor[ib][rg].y)};
                f32x4 o;
#pragma unroll
                for (int e = 0; e < 4; ++e) o[e] = ((Y[ib][tb][4 * rg + e] - mean) * rstd * gln[rg][e] + bln[rg][e] + bcv * vv[e]) * go[e];
                store4_bf16(O + row * 1024 + h * 64 + i0, o); }
            asm volatile("" ::: "memory"); } }
}
}


#ifndef DUP_MIX
#define DUP_MIX 0
#endif
__device__ __forceinline__ void unit_pop(Frame& F, unsigned* qhead, int& idx) {
    if (F.tid == 0) F.MISC[0] = __hip_atomic_fetch_add(qhead, 1u, RLX_AGENT);
    __syncthreads(); idx = (int)F.MISC[0]; __syncthreads();
    { int t_ = F.tid; asm volatile("" : "+v"(t_)); F.tid = t_; F.lane = t_ & 63; F.wave = __builtin_amdgcn_readfirstlane(t_ >> 6); }
}
__device__ __forceinline__ void phase_mix_a(Frame& F, int l, int rep) {
    const int nch = (4096 - F.vcu + F.G - 1) / F.G, nec = 0;
    rw::ChunkIn nx; if (nch > 0) rw::chunk_fetch(F, l, F.vcu, nx);
    int je = 0;
#pragma unroll 1
    for (int j = 0; j < nch; ++j) {
        { int t_ = F.tid; asm volatile("" : "+v"(t_)); F.tid = t_; F.lane = t_ & 63; F.wave = __builtin_amdgcn_readfirstlane(t_ >> 6); }
        const rw::ChunkIn cu = nx;
        rw::ChunkPar cp; rw::chunk_par(F, l, F.vcu + j * F.G, cp);
        if (j + 1 < nch) rw::chunk_fetch(F, l, F.vcu + (j + 1) * F.G, nx);
        if (rep == 0 || (DUP_MIX & 1)) rw::chunk_unit(F, l, F.vcu + j * F.G, cu, cp);
        __syncthreads();
        if (((j + F.vcu) & 3) == 3 && je < nec) { if (rep == 0 || (DUP_MIX & 8)) { EcDesc fn{F.ws, l}; run_panels(F, 6 * (F.vcu + je * F.G), 6, 1, fn); } ++je; __syncthreads(); }
    }
#pragma unroll 1
    for (; je < nec; ++je) { if (rep == 0 || (DUP_MIX & 8)) { EcDesc fn{F.ws, l}; run_panels(F, 6 * (F.vcu + je * F.G), 6, 1, fn); } __syncthreads(); }
}
__device__ __forceinline__ void phase_mix_b(Frame& F, int l, int rep) {
    unsigned* qhead = F.ctl + CW_QHEAD + 64 * l + 16 * rep + 8;
    const bf16_t* PROJ = (const bf16_t*)(F.ws + WS_PROJ); bf16_t* OALL = (bf16_t*)(F.ws + WS_OALL);
    for (;;) { int idx; unit_pop(F, qhead, idx);
        if (idx >= 64 + 3072) break;
        if (idx < 64) { if ((rep == 0 || (DUP_MIX & 16)) && F.wave == 0) rw::chain_wave(F, idx); }
        else { const int kq = idx - 64;
            if (kq % 3 == 2) { if (rep == 0 || (DUP_MIX & 8)) { EcDesc fn{F.ws, l}; run_panels(F, 6 * (kq / 3), 6, 1, fn); } }
            else { const int k = (kq / 3) * 2 + kq % 3, qb = 15 - (k >> 7), kk = k & 127, bh = kk >> 1;
                if (kk & 1) { if (rep == 0 || (DUP_MIX & 2)) attn_sb_unit(F, bh >> 4, bh & 15, qb, PROJ, OALL); }
                else { if (rep == 0 || (DUP_MIX & 4)) attn_mla_unit(F, bh >> 4, bh & 15, qb, (const bf16_t*)(F.ws + WS_QMLA), (const bf16_t*)(F.ws + WS_KMLA), (const bf16_t*)(F.ws + WS_KPE), (const bf16_t*)(F.ws + WS_VMLA), OALL + (size_t)2 * T * 1024); } } }
        __syncthreads();
    }
}

__device__ __forceinline__ void phase_select(Frame& F, int l) {
    const float* lgp = (const float*)(F.ws + WS_LGP); const float* rgb = (const float*)ARGP(28) + l * 8; const float* reb = (const float*)ARGP(30) + l * 64;
    int* toke = (int*)(F.ws + WS_TOKE); float* tokw = (float*)(F.ws + WS_TOKW); unsigned* cnt = F.ctl + CW_CNT + 64 * l;
    for (int t = F.gw * 64 + F.lane; t < T; t += F.NGW * 64) {
        float gl[8]; int grp = 0; float gmax;
        { f32x4 a0 = (f32x4){0.f, 0.f, 0.f, 0.f}, a1 = a0;
#pragma unroll
          for (int z = 0; z < 4; ++z) { const f32x4* p = (const f32x4*)(lgp + ((size_t)z * T + t) * 96); a0 += p[0]; a1 += p[1]; }
#pragma unroll
          for (int i = 0; i < 4; ++i) { gl[i] = a0[i] + rgb[i]; gl[4 + i] = a1[i] + rgb[4 + i]; } }
        gmax = gl[0];
#pragma unroll
        for (int i = 1; i < 8; ++i) if (gl[i] > gmax) { gmax = gl[i]; grp = i; }
        float gs = 0.f;
#pragma unroll
        for (int i = 0; i < 8; ++i) gs += __expf(gl[i] - gmax);
        const float pgrp = 1.0f / gs;
        float el[8];
        { f32x4 a0 = (f32x4){0.f, 0.f, 0.f, 0.f}, a1 = a0;
#pragma unroll
          for (int z = 0; z < 4; ++z) { const f32x4* p = (const f32x4*)(lgp + ((size_t)z * T + t) * 96 + 8 + grp * 8); a0 += p[0]; a1 += p[1]; }
#pragma unroll
          for (int i = 0; i < 4; ++i) { el[i] = a0[i] + reb[grp * 8 + i]; el[4 + i] = a1[i] + reb[grp * 8 + 4 + i]; } }
        int i0 = 0; float m0 = el[0];
#pragma unroll
        for (int i = 1; i < 8; ++i) if (el[i] > m0) { m0 = el[i]; i0 = i; }
        int i1 = -1; float m1 = -INFINITY;
#pragma unroll
        for (int i = 0; i < 8; ++i) if (i != i0 && el[i] > m1) { m1 = el[i]; i1 = i; }
        const float e1 = __expf(m1 - m0); const float w0 = pgrp / (1.0f + e1), w1 = pgrp * e1 / (1.0f + e1);
        const int ex0 = grp * 8 + i0, ex1 = grp * 8 + i1;
        toke[2 * t] = ex0; toke[2 * t + 1] = ex1; tokw[2 * t] = w0; tokw[2 * t + 1] = w1;
        __hip_atomic_fetch_add(cnt + ex0, 1u, RLX_AGENT); __hip_atomic_fetch_add(cnt + ex1, 1u, RLX_AGENT);
    }
}

__device__ __forceinline__ void phase_scatter(Frame& F, int l) {
    unsigned* cnt = F.ctl + CW_CNT + 64 * l; unsigned* curs = F.ctl + CW_CUR + 64 * l;
    LAS int* pst = (LAS int*)F.lds; int* blke = (int*)(F.ws + WS_BLKE);
    if (F.tid < 64) pst[64 + F.tid] = (int)((__hip_atomic_load(cnt + F.tid, RLX_AGENT) + 255u) & ~255u);
    __syncthreads();
    if (F.tid == 0) { int acc = 0;
        for (int e = 0; e < 64; ++e) { const int pd = pst[64 + e]; pst[e] = acc;
            if (blockIdx.x == 0) for (int q = 0; q < pd / 256; ++q) blke[1 + acc / 256 + q] = e;
            acc += pd; }
        if (blockIdx.x == 0) blke[0] = acc / 256; }
    __syncthreads();
    const int* toke = (const int*)(F.ws + WS_TOKE); int* pos = (int*)(F.ws + WS_POS); int* rowtok = (int*)(F.ws + WS_ROWTOK);
    for (int i = F.gw * 64 + F.lane; i < 2 * T; i += F.NGW * 64) { const int e = toke[i];
        const int p = pst[e] + (int)__hip_atomic_fetch_add(curs + e, 1u, RLX_AGENT); pos[i] = p; rowtok[p] = i >> 1; }
}

struct SchedLora { pg8::StaticOrder S;
    __device__ __forceinline__ bool next(int i, Unit& u) const { if (!S.next(i, u)) return false; u.z = u.pn >> 2; u.akoff = u.z * 512; return true; } };
struct SchedBranch { pg8::StaticOrder S;
    __device__ __forceinline__ bool next(int i, Unit& u) const { if (!S.tile(i / 3, u.pm, u.pn)) return false; u.z = i % 3; u.am = u.z * 64 + u.pm; u.bn = u.z * 8 + u.pn; u.akoff = 0; u.bkoff = 0; return true; } };
struct SchedMoe { int nblk, ntile, G, vcu; const LAS int* blke; const int* rowtok; int nrows;
    __device__ __forceinline__ bool next(int i, Unit& u) const { const int L = i * G + vcu; if (L >= nblk * ntile) return false;
        const int rb = L / ntile, j = L % ntile, e = blke[1 + rb]; u.pm = rb; u.am = rb; u.pn = j; u.bn = e * ntile + j; u.z = j; u.akoff = 0; u.bkoff = 0; return true; } };

constexpr int NPH_LAYER = 17, PH_FINAL = 1 + DEPTH * NPH_LAYER, NPHASES = PH_FINAL + 1;
__global__ void __launch_bounds__(NWAVES * 64, 2) hybrid_fwd(Args args) {
    extern __shared__ __attribute__((aligned(16))) unsigned char lds_raw[];
    Frame F;
    F.lds = (LAS unsigned char*)lds_raw; F.MISC = (volatile LAS unsigned*)(F.lds + MISC_OFF);
    F.tid = threadIdx.x; F.lane = F.tid & 63; F.wave = __builtin_amdgcn_readfirstlane(F.tid >> 6);
    F.G = gridDim.x; { const int bx = blockIdx.x; F.vcu = (F.G % 8 == 0) ? (bx % 8) * (F.G / 8) + bx / 8 : bx; }
    F.gw = F.vcu * NWAVES + F.wave; F.NGW = F.G * NWAVES;
    F.ws = args.ws; F.ctl = (unsigned*)(args.ws + WS_CTL);
    for (int u = F.tid; u < (LDS_BYTES - RING_BYTES) / 4; u += NWAVES * 64) ((LAS unsigned*)(F.lds + RING_BYTES))[u] = 0u;
    __syncthreads();
    const int lo = args.ph_lo, hi = args.ph_hi;
    XcdBarrier bar; bar.bar = F.ctl + CW_BAR; bar.x = 0; bar.st = F.MISC + 8;
    if (hi - lo > 1) bar = xcd_barrier_post(F.ctl + CW_BAR, F.MISC + 8, threadIdx.x == 0);
    bool ran = false;
#define FRAME_INIT() do { int t_ = wave0_ * 64 + (int)__builtin_amdgcn_mbcnt_hi(~0u, __builtin_amdgcn_mbcnt_lo(~0u, 0u)), bx_ = blockIdx.x, G_ = gridDim.x; asm volatile("" : "+v"(t_)); asm volatile("" : "+s"(bx_), "+s"(G_)); \
        F.tid = t_; F.lane = t_ & 63; F.wave = __builtin_amdgcn_readfirstlane(t_ >> 6); F.G = G_; F.vcu = (G_ % 8 == 0) ? (bx_ % 8) * (G_ / 8) + bx_ / 8 : bx_; \
        F.gw = F.vcu * NWAVES + F.wave; F.NGW = G_ * NWAVES; F.ws = launder(args.ws); F.ctl = (unsigned*)F.ws; cblk = bx_; } while (0)
    int cblk = 0;
    const int wave0_ = __builtin_amdgcn_readfirstlane((int)threadIdx.x >> 6);
#ifndef PHMASK
#define PHMASK 0xFFFFF
#endif
#ifndef DUPMASK
#define DUPMASK 0
#endif
#define GRID_BARRIER() do { XcdBarrier bb_ = bar; bb_.bar = (unsigned*)launder((unsigned char*)bar.bar); xcd_barrier(bb_, wave0_ == 0 && __builtin_amdgcn_mbcnt_hi(~0u, __builtin_amdgcn_mbcnt_lo(~0u, 0u)) == 0u); } while (0)
#if DUPMASK
#define PHASE_BEGIN(p, k) if (((PHMASK >> (k)) & 1) && lo <= (p) && (p) < hi) { if (ran) GRID_BARRIER(); ran = true; \
    int nrep_ = (((DUPMASK >> (k)) & 1) && !(((k) == 8 || (k) == 1) && lcur > 0)) ? 2 : 1; asm volatile("" : "+s"(nrep_)); for (int rep_ = 0; rep_ < nrep_; ++rep_) { if (rep_) GRID_BARRIER(); FRAME_INIT();
#define PHASE_END } }
#else
#define PHASE_BEGIN(p, k) if (((PHMASK >> (k)) & 1) && lo <= (p) && (p) < hi) { if (ran) GRID_BARRIER(); ran = true; FRAME_INIT(); const int rep_ = 0; (void)rep_;
#define PHASE_END }
#endif
    int lcur = 0; (void)lcur;

    PHASE_BEGIN(0, 14) phase_convert(F, args); phase_norm<0>(F, (const float*)ARGP(0), nullptr, (const float*)ARGP(2), (bf16_t*)(F.ws + WS_H), nullptr, nullptr, nullptr, nullptr); PHASE_END

    { constexpr int l = 0;
        const int pb = 1 + l * NPH_LAYER; lcur = l;
        bf16_t* PROJ = (bf16_t*)(F.ws + WS_PROJ); float* X = (float*)(F.ws + WS_X); bf16_t* H = (bf16_t*)(F.ws + WS_H);
        const float* xres = (l == 0) ? (const float*)ARGP(0) : (const float*)X;


        if (l > 0) {
        PHASE_BEGIN(pb + 1, 1)
            phase_norm<1>(F, X, X, (const float*)ARGP(2) + (size_t)l * 2048, H, nullptr, (const bf16_t*)(F.ws + WS_Y), (const int*)(F.ws + WS_POS), (const float*)(F.ws + WS_TOKW));
        PHASE_END
        }

        PHASE_BEGIN(pb + 2, 2) {
            pg8::Gemm g{H, (const bf16_t*)(F.ws + WS_WIN + l * SZ_WIN), 2048, 2048, 2048}; pg8::StaticOrder S; S.init(T / 256, NPROJ / 256, F.G, cblk);
            EpiProj E{PROJ}; pg8::gemm_phase<EpiProj, pg8::StaticOrder, true>(F.lds, F.tid, g, S, E);
            if (l == 0 && rep_ == 0) { const int nu = (T / 256) * (NPROJ / 256), nfull = nu % F.G; if (nfull != 0 && cblk >= nfull) { __syncthreads(); P0Desc fn{F.ws}; const int nh = F.G - nfull, r = cblk - nfull;
                const int np = (P0Desc::NP_L - r + nh - 1) / nh; run_panels(F, P0Desc::NP_L + r, np, nh, fn); }
              else if (nfull == 0) { __syncthreads(); P0Desc fn{F.ws}; const int np = (P0Desc::NP_L - F.vcu + F.G - 1) / F.G; run_panels(F, P0Desc::NP_L + F.vcu, np, F.G, fn); } } }
        PHASE_END

        PHASE_BEGIN(pb + 3, 3) phase_prep(F, args, l); PHASE_END

        PHASE_BEGIN(pb + 4, 4) {
#ifndef P4SUB
#define P4SUB 15
#endif
#ifndef P4DUP
#define P4DUP 15
#endif
#define P4ON(b) ((P4SUB & (b)) && (rep_ == 0 || (P4DUP & (b))))
            if (P4ON(1)) { pg8::Gemm g{PROJ + PC_CQ, (const bf16_t*)(F.ws + WS_WUQ + l * SZ_WUQ), NPROJ, 768, 768}; pg8::StaticOrder S; S.init(T / 256, 6, F.G, cblk);
              EpiMlaQ E{(bf16_t*)(F.ws + WS_QMLA), (const float*)(F.ws + WS_RSTDQ), (const float*)(F.ws + WS_COS), (const float*)(F.ws + WS_SIN)};
              pg8::gemm_phase<EpiMlaQ, pg8::StaticOrder, true>(F.lds, F.tid, g, S, E); }
            { int t_ = F.tid; asm volatile("" : "+v"(t_)); F.tid = t_; }
            if (P4ON(2)) { pg8::Gemm g{PROJ + PC_CKV, (const bf16_t*)(F.ws + WS_WUKV + l * SZ_WUKV), NPROJ, 256, 256}; pg8::StaticOrder S; S.init(T / 256, 8, F.G, cblk);
              EpiMlaKV E{(bf16_t*)(F.ws + WS_KMLA), (bf16_t*)(F.ws + WS_VMLA), (const float*)(F.ws + WS_RSTDKV)};
              pg8::gemm_phase<EpiMlaKV, pg8::StaticOrder, true>(F.lds, F.tid, g, S, E); }
            { int t_ = F.tid; asm volatile("" : "+v"(t_)); F.tid = t_; }
            if (P4ON(4)) { pg8::Gemm g{(const bf16_t*)(F.ws + WS_LORAIN), (const bf16_t*)(F.ws + WS_WLORA + l * SZ_WLORA), 768, 256, 256}; SchedLora S; S.S.init(T / 256, 12, F.G, cblk);
              EpiLora E{(float*)(F.ws + WS_LOGDEC), (float*)(F.ws + WS_AIC), (bf16_t*)(F.ws + WS_GOUT), (const float*)ARGP(5) + l * 1024, (const float*)ARGP(7) + l * 1024};
              pg8::gemm_phase<EpiLora, SchedLora, true>(F.lds, F.tid, g, S, E); }
            { int t_ = F.tid; asm volatile("" : "+v"(t_)); F.tid = t_; }
            if (P4ON(8) && l > 0) { pg8::Gemm g{(const bf16_t*)(F.ws + WS_VS) + (size_t)l * T * 1024, (const bf16_t*)(F.ws + WS_WV1), 1024, 1024, 1024}; pg8::StaticOrder S; S.init(T / 256, 1, F.G, (cblk + F.G / 2) % F.G);
              EpiT1 E{(bf16_t*)(F.ws + WS_T1)}; pg8::gemm_phase<EpiT1, pg8::StaticOrder, true>(F.lds, F.tid, g, S, E); } }
        PHASE_END

        if (l > 0) {
        PHASE_BEGIN(pb + 5, 5) { pg8::Gemm g{(const bf16_t*)(F.ws + WS_T1), (const bf16_t*)(F.ws + WS_WV2), 128, 128, 128}; pg8::StaticOrder S; S.init(T / 256, 4, F.G, cblk);
              EpiVGate E{(bf16_t*)(F.ws + WS_VGATE), (const float*)ARGP(15) + (size_t)(l - 1) * 1024}; pg8::gemm_phase<EpiVGate, pg8::StaticOrder, true>(F.lds, F.tid, g, S, E); }
        PHASE_END
        }

        PHASE_BEGIN(pb + 6, 6) phase_mix_a(F, l, rep_); PHASE_END
        PHASE_BEGIN(pb + 7, 16) phase_mix_b(F, l, rep_); PHASE_END
        PHASE_BEGIN(pb + 8, 17) for (int cidx = F.gw; cidx < 4096; cidx += F.NGW) rw::out_wave(F, l, cidx); PHASE_END

        PHASE_BEGIN(pb + 9, 7) { pg8::Gemm g{(const bf16_t*)(F.ws + WS_OALL), (const bf16_t*)(F.ws + WS_WBR + l * SZ_WBR), 1024, 1024, 1024}; SchedBranch S; S.S.init(T / 256, 8, F.G, cblk);
              EpiBranch E{PROJ, (bf16_t*)(F.ws + WS_MERGED)}; pg8::gemm_phase<EpiBranch, SchedBranch, true>(F.lds, F.tid, g, S, E); }
        PHASE_END

        PHASE_BEGIN(pb + 10, 8) { pg8::Gemm g{(const bf16_t*)(F.ws + WS_MERGED), (const bf16_t*)(F.ws + WS_WOUT + l * SZ_WOUT), 2048, 2048, 2048}; pg8::StaticOrder S; S.init(T / 256, 8, F.G, cblk);
              EpiWout E{xres, X}; pg8::gemm_phase<EpiWout, pg8::StaticOrder, true>(F.lds, F.tid, g, S, E); }
        PHASE_END

        PHASE_BEGIN(pb + 11, 9) phase_norm<3>(F, X, nullptr, (const float*)ARGP(26) + (size_t)l * 2048, (bf16_t*)(F.ws + WS_APRIME), nullptr, nullptr, nullptr, nullptr); PHASE_END

        PHASE_BEGIN(pb + 12, 10) { pg8::Gemm g{(const bf16_t*)(F.ws + WS_APRIME), (const bf16_t*)(F.ws + WS_WRT + l * SZ_WRT), 4096, 4096, 1024}; SchedRouter S{F.G, F.vcu};
              EpiRouterPart E{(float*)(F.ws + WS_LGP)}; pg8::gemm_phase<EpiRouterPart, SchedRouter, true>(F.lds, F.tid, g, S, E); }
        PHASE_END

        PHASE_BEGIN(pb + 13, 18) phase_select(F, l); PHASE_END

        PHASE_BEGIN(pb + 14, 11) phase_scatter(F, l); PHASE_END

        PHASE_BEGIN(pb + 15, 12) { LAS int* tab = (LAS int*)(F.lds + RING_BYTES + 1024); const int* blke = (const int*)(F.ws + WS_BLKE);
              if (F.tid < 256) tab[F.tid] = blke[F.tid]; __syncthreads();
              SchedMoe S{tab[0], 4, F.G, F.vcu, tab, (const int*)(F.ws + WS_ROWTOK), T};
              pg8::Gemm g{(const bf16_t*)(F.ws + WS_APRIME), (const bf16_t*)(F.ws + WS_WE1), 4096, 2048, 2048}; EpiE1 E{(bf16_t*)(F.ws + WS_HMOE)};
              pg8::gemm_phase<EpiE1, SchedMoe, true, true>(F.lds, F.tid, g, S, E); }
        PHASE_END

        PHASE_BEGIN(pb + 16, 13) { LAS int* tab = (LAS int*)(F.lds + RING_BYTES + 1024); const int* blke = (const int*)(F.ws + WS_BLKE);
              if (F.tid < 256) tab[F.tid] = blke[F.tid]; __syncthreads();
              SchedMoe S{tab[0], 8, F.G, F.vcu, tab, nullptr, 0};
              pg8::Gemm g{(const bf16_t*)(F.ws + WS_HMOE), (const bf16_t*)(F.ws + WS_WE2), 512, 512, 512}; EpiE2 E{(bf16_t*)(F.ws + WS_Y)};
              pg8::gemm_phase<EpiE2, SchedMoe, true>(F.lds, F.tid, g, S, E); }
        PHASE_END
    }
    { constexpr int l = 1;
        const int pb = 1 + l * NPH_LAYER; lcur = l;
        bf16_t* PROJ = (bf16_t*)(F.ws + WS_PROJ); float* X = (float*)(F.ws + WS_X); bf16_t* H = (bf16_t*)(F.ws + WS_H);
        const float* xres = (l == 0) ? (const float*)ARGP(0) : (const float*)X;


        if (l > 0) {
        PHASE_BEGIN(pb + 1, 1)
            phase_norm<1>(F, X, X, (const float*)ARGP(2) + (size_t)l * 2048, H, nullptr, (const bf16_t*)(F.ws + WS_Y), (const int*)(F.ws + WS_POS), (const float*)(F.ws + WS_TOKW));
        PHASE_END
        }

        PHASE_BEGIN(pb + 2, 2) {
            pg8::Gemm g{H, (const bf16_t*)(F.ws + WS_WIN + l * SZ_WIN), 2048, 2048, 2048}; pg8::StaticOrder S; S.init(T / 256, NPROJ / 256, F.G, cblk);
            EpiProj E{PROJ}; pg8::gemm_phase<EpiProj, pg8::StaticOrder, true>(F.lds, F.tid, g, S, E);
            if (l == 0 && rep_ == 0) { const int nu = (T / 256) * (NPROJ / 256), nfull = nu % F.G; if (nfull != 0 && cblk >= nfull) { __syncthreads(); P0Desc fn{F.ws}; const int nh = F.G - nfull, r = cblk - nfull;
                const int np = (P0Desc::NP_L - r + nh - 1) / nh; run_panels(F, P0Desc::NP_L + r, np, nh, fn); }
              else if (nfull == 0) { __syncthreads(); P0Desc fn{F.ws}; const int np = (P0Desc::NP_L - F.vcu + F.G - 1) / F.G; run_panels(F, P0Desc::NP_L + F.vcu, np, F.G, fn); } } }
        PHASE_END

        PHASE_BEGIN(pb + 3, 3) phase_prep(F, args, l); PHASE_END

        PHASE_BEGIN(pb + 4, 4) {
#ifndef P4SUB
#define P4SUB 15
#endif
#ifndef P4DUP
#define P4DUP 15
#endif
#define P4ON(b) ((P4SUB & (b)) && (rep_ == 0 || (P4DUP & (b))))
            if (P4ON(1)) { pg8::Gemm g{PROJ + PC_CQ, (const bf16_t*)(F.ws + WS_WUQ + l * SZ_WUQ), NPROJ, 768, 768}; pg8::StaticOrder S; S.init(T / 256, 6, F.G, cblk);
              EpiMlaQ E{(bf16_t*)(F.ws + WS_QMLA), (const float*)(F.ws + WS_RSTDQ), (const float*)(F.ws + WS_COS), (const float*)(F.ws + WS_SIN)};
              pg8::gemm_phase<EpiMlaQ, pg8::StaticOrder, true>(F.lds, F.tid, g, S, E); }
            { int t_ = F.tid; asm volatile("" : "+v"(t_)); F.tid = t_; }
            if (P4ON(2)) { pg8::Gemm g{PROJ + PC_CKV, (const bf16_t*)(F.ws + WS_WUKV + l * SZ_WUKV), NPROJ, 256, 256}; pg8::StaticOrder S; S.init(T / 256, 8, F.G, cblk);
              EpiMlaKV E{(bf16_t*)(F.ws + WS_KMLA), (bf16_t*)(F.ws + WS_VMLA), (const float*)(F.ws + WS_RSTDKV)};
              pg8::gemm_phase<EpiMlaKV, pg8::StaticOrder, true>(F.lds, F.tid, g, S, E); }
            { int t_ = F.tid; asm volatile("" : "+v"(t_)); F.tid = t_; }
            if (P4ON(4)) { pg8::Gemm g{(const bf16_t*)(F.ws + WS_LORAIN), (const bf16_t*)(F.ws + WS_WLORA + l * SZ_WLORA), 768, 256, 256}; SchedLora S; S.S.init(T / 256, 12, F.G, cblk);
              EpiLora E{(float*)(F.ws + WS_LOGDEC), (float*)(F.ws + WS_AIC), (bf16_t*)(F.ws + WS_GOUT), (const float*)ARGP(5) + l * 1024, (const float*)ARGP(7) + l * 1024};
              pg8::gemm_phase<EpiLora, SchedLora, true>(F.lds, F.tid, g, S, E); }
            { int t_ = F.tid; asm volatile("" : "+v"(t_)); F.tid = t_; }
            if (P4ON(8) && l > 0) { pg8::Gemm g{(const bf16_t*)(F.ws + WS_VS) + (size_t)l * T * 1024, (const bf16_t*)(F.ws + WS_WV1), 1024, 1024, 1024}; pg8::StaticOrder S; S.init(T / 256, 1, F.G, (cblk + F.G / 2) % F.G);
              EpiT1 E{(bf16_t*)(F.ws + WS_T1)}; pg8::gemm_phase<EpiT1, pg8::StaticOrder, true>(F.lds, F.tid, g, S, E); } }
        PHASE_END

        if (l > 0) {
        PHASE_BEGIN(pb + 5, 5) { pg8::Gemm g{(const bf16_t*)(F.ws + WS_T1), (const bf16_t*)(F.ws + WS_WV2), 128, 128, 128}; pg8::StaticOrder S; S.init(T / 256, 4, F.G, cblk);
              EpiVGate E{(bf16_t*)(F.ws + WS_VGATE), (const float*)ARGP(15) + (size_t)(l - 1) * 1024}; pg8::gemm_phase<EpiVGate, pg8::StaticOrder, true>(F.lds, F.tid, g, S, E); }
        PHASE_END
        }

        PHASE_BEGIN(pb + 6, 6) phase_mix_a(F, l, rep_); PHASE_END
        PHASE_BEGIN(pb + 7, 16) phase_mix_b(F, l, rep_); PHASE_END
        PHASE_BEGIN(pb + 8, 17) for (int cidx = F.gw; cidx < 4096; cidx += F.NGW) rw::out_wave(F, l, cidx); PHASE_END

        PHASE_BEGIN(pb + 9, 7) { pg8::Gemm g{(const bf16_t*)(F.ws + WS_OALL), (const bf16_t*)(F.ws + WS_WBR + l * SZ_WBR), 1024, 1024, 1024}; SchedBranch S; S.S.init(T / 256, 8, F.G, cblk);
              EpiBranch E{PROJ, (bf16_t*)(F.ws + WS_MERGED)}; pg8::gemm_phase<EpiBranch, SchedBranch, true>(F.lds, F.tid, g, S, E); }
        PHASE_END

        PHASE_BEGIN(pb + 10, 8) { pg8::Gemm g{(const bf16_t*)(F.ws + WS_MERGED), (const bf16_t*)(F.ws + WS_WOUT + l * SZ_WOUT), 2048, 2048, 2048}; pg8::StaticOrder S; S.init(T / 256, 8, F.G, cblk);
              EpiWout E{xres, X}; pg8::gemm_phase<EpiWout, pg8::StaticOrder, true>(F.lds, F.tid, g, S, E); }
        PHASE_END

        PHASE_BEGIN(pb + 11, 9) phase_norm<3>(F, X, nullptr, (const float*)ARGP(26) + (size_t)l * 2048, (bf16_t*)(F.ws + WS_APRIME), nullptr, nullptr, nullptr, nullptr); PHASE_END

        PHASE_BEGIN(pb + 12, 10) { pg8::Gemm g{(const bf16_t*)(F.ws + WS_APRIME), (const bf16_t*)(F.ws + WS_WRT + l * SZ_WRT), 4096, 4096, 1024}; SchedRouter S{F.G, F.vcu};
              EpiRouterPart E{(float*)(F.ws + WS_LGP)}; pg8::gemm_phase<EpiRouterPart, SchedRouter, true>(F.lds, F.tid, g, S, E); }
        PHASE_END

        PHASE_BEGIN(pb + 13, 18) phase_select(F, l); PHASE_END

        PHASE_BEGIN(pb + 14, 11) phase_scatter(F, l); PHASE_END

        PHASE_BEGIN(pb + 15, 12) { LAS int* tab = (LAS int*)(F.lds + RING_BYTES + 1024); const int* blke = (const int*)(F.ws + WS_BLKE);
              if (F.tid < 256) tab[F.tid] = blke[F.tid]; __syncthreads();
              SchedMoe S{tab[0], 4, F.G, F.vcu, tab, (const int*)(F.ws + WS_ROWTOK), T};
              pg8::Gemm g{(const bf16_t*)(F.ws + WS_APRIME), (const bf16_t*)(F.ws + WS_WE1), 4096, 2048, 2048}; EpiE1 E{(bf16_t*)(F.ws + WS_HMOE)};
              pg8::gemm_phase<EpiE1, SchedMoe, true, true>(F.lds, F.tid, g, S, E); }
        PHASE_END

        PHASE_BEGIN(pb + 16, 13) { LAS int* tab = (LAS int*)(F.lds + RING_BYTES + 1024); const int* blke = (const int*)(F.ws + WS_BLKE);
              if (F.tid < 256) tab[F.tid] = blke[F.tid]; __syncthreads();
              SchedMoe S{tab[0], 8, F.G, F.vcu, tab, nullptr, 0};
              pg8::Gemm g{(const bf16_t*)(F.ws + WS_HMOE), (const bf16_t*)(F.ws + WS_WE2), 512, 512, 512}; EpiE2 E{(bf16_t*)(F.ws + WS_Y)};
              pg8::gemm_phase<EpiE2, SchedMoe, true>(F.lds, F.tid, g, S, E); }
        PHASE_END
    }


    PHASE_BEGIN(PH_FINAL, 15)
        phase_norm<2>(F, (const float*)(F.ws + WS_X), nullptr, (const float*)ARGP(34), nullptr, args.out, (const bf16_t*)(F.ws + WS_Y), (const int*)(F.ws + WS_POS), (const float*)(F.ws + WS_TOKW));
    PHASE_END
#undef PHASE_BEGIN
#undef PHASE_END
}

#ifndef MK_MULTI
#define MK_MULTI 0
#endif
extern "C" void kernel_launch(void* const* d_in, const int* in_sizes, int n_in, void* d_out, int out_size, void* d_ws, size_t ws_size, hipStream_t stream) {
    static int grid = 0;
    if (grid == 0) {
        if (n_in != 35 || out_size != T * DM || ws_size < WS_END) { fprintf(stderr, "kernel_launch: unexpected shapes (n_in %d, out %d, ws %zu, need %zu)\n", n_in, out_size, ws_size, (size_t)WS_END); grid = -1; return; }
        int dev = 0, cus = 0, per_cu = 0;
        if (hipGetDevice(&dev) != hipSuccess || hipDeviceGetAttribute(&cus, hipDeviceAttributeMultiprocessorCount, dev) != hipSuccess) { grid = -1; return; }
        if (hipFuncSetAttribute((const void*)hybrid_fwd, hipFuncAttributeMaxDynamicSharedMemorySize, LDS_BYTES) != hipSuccess) { fprintf(stderr, "kernel_launch: hipFuncSetAttribute failed\n"); grid = -1; return; }
        if (hipOccupancyMaxActiveBlocksPerMultiprocessor(&per_cu, (const void*)hybrid_fwd, NWAVES * 64, LDS_BYTES) != hipSuccess || per_cu < 1)
            fprintf(stderr, "kernel_launch: occupancy query reports %d workgroups per CU\n", per_cu);
        (void)hipGetLastError();
        grid = cus;
    }
    if (grid < 0) return;
    if (hipMemsetAsync((char*)d_ws + WS_CTL, 0, CTL_ZERO_BYTES, stream) != hipSuccess) return;
    Args a{};
    for (int i = 0; i < 35; ++i) a.in[i] = d_in[i];
    a.out = (float*)d_out; a.ws = (unsigned char*)d_ws;
#if MK_MULTI
    for (int p = 0; p < NPHASES; ++p) { a.ph_lo = p; a.ph_hi = p + 1; hipLaunchKernelGGL(hybrid_fwd, dim3(grid), dim3(NWAVES * 64), LDS_BYTES, stream, a); }
#else
    a.ph_lo = 0; a.ph_hi = NPHASES;
    hipLaunchKernelGGL(hybrid_fwd, dim3(grid), dim3(NWAVES * 64), LDS_BYTES, stream, a);
#endif
    const hipError_t le = hipPeekAtLastError();
    if (le != hipSuccess) fprintf(stderr, "kernel_launch: launch failed: %s\n", hipGetErrorName(le));
}
```
